# Optimizing an MI355X kernel written in HIP

```python
import jax, jax.numpy as jnp
from jax import lax
import numpy as np

D_MODEL = 2048
BATCH = 1
SEQ = 16384
DEPTH = 2

N_MIXERS = 2
N_MLSTM_LAYERS = (DEPTH + 1) // 2
N_MLA_LAYERS = DEPTH // 2
D_FF = 5632
RMS_EPS = 1e-6

MLSTM_HEADS = 4
MLSTM_DQK = D_MODEL // (2 * MLSTM_HEADS)
MLSTM_DV = D_MODEL // MLSTM_HEADS
MLSTM_CHUNK = 64
MLSTM_SPLITS = [MLSTM_HEADS * MLSTM_DQK,
                2 * MLSTM_HEADS * MLSTM_DQK,
                2 * MLSTM_HEADS * MLSTM_DQK + MLSTM_HEADS * MLSTM_DV,
                2 * MLSTM_HEADS * MLSTM_DQK + 2 * MLSTM_HEADS * MLSTM_DV,
                2 * MLSTM_HEADS * MLSTM_DQK + 2 * MLSTM_HEADS * MLSTM_DV + MLSTM_HEADS]
MLSTM_IN = MLSTM_SPLITS[-1] + MLSTM_HEADS

MLA_HEADS = 16
MLA_Q_RANK = 512
MLA_KV_RANK = 512
MLA_NOPE = 128
MLA_ROPE = 64
MLA_V = 128
MLA_QK = MLA_NOPE + MLA_ROPE
MLA_IN = MLA_Q_RANK + MLA_KV_RANK + MLA_ROPE
ROPE_THETA = 10000.0
Q_BLOCK = 128

kernel_name = 'hybrid_mlstm_mla_macaron'


def rms_norm(x, g):
    xf = x.astype(jnp.float32)
    y = xf * lax.rsqrt(jnp.mean(xf * xf, axis=-1, keepdims=True) + RMS_EPS)
    return (y * g.astype(jnp.float32)).astype(x.dtype)


def swiglu_ffn(x, w_gate_up, w_down):
    gate, up = jnp.split(x @ w_gate_up, 2, axis=-1)
    return (jax.nn.silu(gate) * up) @ w_down


def mlstm_mixer(x, w_in, gate_bias, head_norm, w_out):
    B, S, _ = x.shape
    H, dqk, dv, L = MLSTM_HEADS, MLSTM_DQK, MLSTM_DV, MLSTM_CHUNK
    nc = S // L
    f32 = jnp.float32
    q, k, v, o, ig, fg = jnp.split(x @ w_in, MLSTM_SPLITS, axis=-1)

    def to_chunks(t, d):
        return t.reshape(B, nc, L, H, d).transpose(1, 0, 3, 2, 4).astype(f32)

    def gate_chunks(t):
        return t.astype(f32).reshape(B, nc, L, H).transpose(1, 0, 3, 2)

    qc = to_chunks(q, dqk) * (dqk ** -0.5)
    kc = to_chunks(k, dqk)
    vc = to_chunks(v, dv)
    igc = gate_chunks(ig + gate_bias[0])
    lfc = jax.nn.log_sigmoid(gate_chunks(fg + gate_bias[1]))
    causal = jnp.tril(jnp.ones((L, L), dtype=bool))

    def step(carry, inp):
        C, n, m = carry
        qb, kb, vb, ib, lfb = inp
        b = jnp.cumsum(lfb, axis=-1)
        dmat = jnp.where(causal, b[..., :, None] - b[..., None, :] + ib[..., None, :], -jnp.inf)
        inter = b + m[..., None]
        m_t = jnp.maximum(inter, jnp.max(dmat, axis=-1))
        w = jnp.einsum('bhtd,bhsd->bhts', qb, kb) * jnp.exp(dmat - m_t[..., None])
        a = jnp.exp(inter - m_t)
        num = a[..., None] * jnp.einsum('bhtd,bhvd->bhtv', qb, C) + jnp.einsum('bhts,bhsv->bhtv', w, vb)
        den = a * jnp.einsum('bhtd,bhd->bht', qb, n) + jnp.sum(w, axis=-1)
        h = num / jnp.maximum(jnp.abs(den), jnp.exp(-m_t))[..., None]
        b_last = b[..., -1]
        g = b_last[..., None] - b + ib
        m_new = jnp.maximum(b_last + m, jnp.max(g, axis=-1))
        decay = jnp.exp(b_last + m - m_new)
        wk = jnp.exp(g - m_new[..., None])
        C = decay[..., None, None] * C + jnp.einsum('bhs,bhsv,bhsd->bhvd', wk, vb, kb)
        n = decay[..., None] * n + jnp.einsum('bhs,bhsd->bhd', wk, kb)
        return (C, n, m_new), h

    init = (jnp.zeros((B, H, dv, dqk), f32), jnp.zeros((B, H, dqk), f32), jnp.zeros((B, H), f32))
    _, hc = lax.scan(step, init, (qc, kc, vc, igc, lfc))
    h = hc.transpose(1, 0, 3, 2, 4).reshape(B, S, H, dv)
    h = rms_norm(h, head_norm.reshape(H, dv)).reshape(B, S, H * dv).astype(x.dtype)
    return (jax.nn.sigmoid(o) * h) @ w_out


def apply_rope(t, cos, sin):
    t1, t2 = jnp.split(t.astype(jnp.float32), 2, axis=-1)
    return jnp.concatenate([t1 * cos - t2 * sin, t2 * cos + t1 * sin], axis=-1).astype(t.dtype)


def mla_mixer(x, positions, w_in, q_norm, kv_norm, w_uq, w_ukv, qk_norm, w_out):
    B, S, _ = x.shape
    H = MLA_HEADS
    c_q, c_kv, k_rope = jnp.split(x @ w_in, [MLA_Q_RANK, MLA_Q_RANK + MLA_KV_RANK], axis=-1)
    q = (rms_norm(c_q, q_norm) @ w_uq).reshape(B, S, H, MLA_QK)
    kv = (rms_norm(c_kv, kv_norm) @ w_ukv).reshape(B, S, H, MLA_NOPE + MLA_V)
    q_nope, q_rope = jnp.split(q, [MLA_NOPE], axis=-1)
    k_nope, v = jnp.split(kv, [MLA_NOPE], axis=-1)
    q_nope = rms_norm(q_nope, qk_norm[0, :MLA_NOPE])
    q_rope = rms_norm(q_rope, qk_norm[0, MLA_NOPE:])
    k_nope = rms_norm(k_nope, qk_norm[1, :MLA_NOPE])
    k_rope = rms_norm(k_rope, qk_norm[1, MLA_NOPE:])
    freqs = ROPE_THETA ** (-jnp.arange(0, MLA_ROPE, 2, dtype=jnp.float32) / MLA_ROPE)
    ang = positions.astype(jnp.float32)[..., None] * freqs
    cos, sin = jnp.cos(ang), jnp.sin(ang)
    q_rope = apply_rope(q_rope, cos[:, :, None, :], sin[:, :, None, :])
    k_rope = apply_rope(k_rope, cos, sin)
    scale = MLA_QK ** -0.5
    nb = S // Q_BLOCK
    qn_blocks = (q_nope * scale).reshape(B, nb, Q_BLOCK, H, MLA_NOPE).transpose(1, 0, 2, 3, 4)
    qr_blocks = (q_rope * scale).reshape(B, nb, Q_BLOCK, H, MLA_ROPE).transpose(1, 0, 2, 3, 4)
    key_pos = jnp.arange(S)

    def attend(args):
        qn, qr, start = args
        s = (jnp.einsum('bqhd,bkhd->bhqk', qn, k_nope)
             + jnp.einsum('bqhr,bkr->bhqk', qr, k_rope)).astype(jnp.float32)
        qpos = start + jnp.arange(Q_BLOCK)
        s = jnp.where(key_pos[None, :] <= qpos[:, None], s, -jnp.inf)
        p = jax.nn.softmax(s, axis=-1).astype(v.dtype)
        return jnp.einsum('bhqk,bkhd->bqhd', p, v)

    o = lax.map(attend, (qn_blocks, qr_blocks, jnp.arange(nb) * Q_BLOCK))
    o = o.transpose(1, 0, 2, 3, 4).reshape(B, S, H * MLA_V)
    return o @ w_out


def setup_inputs(seed: int = 0) -> dict:
    key = jax.random.key(seed)
    ks = jax.random.split(key, 24)
    f32 = jnp.float32

    def w(k, shape, fan_in):
        return jax.random.normal(k, shape, f32) * (fan_in ** -0.5)

    def gain(k, shape):
        return 1.0 + 0.02 * jax.random.normal(k, shape, f32)

    NM, NA = N_MLSTM_LAYERS, N_MLA_LAYERS
    gate_bias = jnp.stack([0.1 * jax.random.normal(ks[12], (NM, MLSTM_HEADS), f32),
                           3.0 + 0.5 * jax.random.normal(ks[13], (NM, MLSTM_HEADS), f32)], axis=1)
    return {
        'x': jax.random.normal(ks[0], (BATCH, SEQ, D_MODEL), f32),
        'positions': jnp.broadcast_to(jnp.arange(SEQ, dtype=jnp.int32), (BATCH, SEQ)),
        'ffn1_norm': gain(ks[1], (DEPTH, D_MODEL)),
        'ffn1_w_gate_up': w(ks[2], (DEPTH, D_MODEL, 2 * D_FF), D_MODEL),
        'ffn1_w_down': w(ks[3], (DEPTH, D_FF, D_MODEL), D_FF),
        'mix_norm': gain(ks[4], (DEPTH, D_MODEL)),
        'ffn2_norm': gain(ks[5], (DEPTH, D_MODEL)),
        'ffn2_w_gate_up': w(ks[6], (DEPTH, D_MODEL, 2 * D_FF), D_MODEL),
        'ffn2_w_down': w(ks[7], (DEPTH, D_FF, D_MODEL), D_FF),
        'mlstm_w_in': w(ks[8], (NM, D_MODEL, MLSTM_IN), D_MODEL),
        'mlstm_gate_bias': gate_bias,
        'mlstm_head_norm': gain(ks[9], (NM, MLSTM_HEADS * MLSTM_DV)),
        'mlstm_w_out': w(ks[10], (NM, MLSTM_HEADS * MLSTM_DV, D_MODEL), MLSTM_HEADS * MLSTM_DV),
        'mla_w_in': w(ks[14], (NA, D_MODEL, MLA_IN), D_MODEL),
        'mla_q_norm': gain(ks[15], (NA, MLA_Q_RANK)),
        'mla_kv_norm': gain(ks[16], (NA, MLA_KV_RANK)),
        'mla_w_uq': w(ks[17], (NA, MLA_Q_RANK, MLA_HEADS * MLA_QK), MLA_Q_RANK),
        'mla_w_ukv': w(ks[18], (NA, MLA_KV_RANK, MLA_HEADS * (MLA_NOPE + MLA_V)), MLA_KV_RANK),
        'mla_qk_norm': gain(ks[19], (NA, 2, MLA_QK)),
        'mla_w_out': w(ks[20], (NA, MLA_HEADS * MLA_V, D_MODEL), MLA_HEADS * MLA_V),
    }


def reference(x, positions, ffn1_norm, ffn1_w_gate_up, ffn1_w_down, mix_norm,
              ffn2_norm, ffn2_w_gate_up, ffn2_w_down,
              mlstm_w_in, mlstm_gate_bias, mlstm_head_norm, mlstm_w_out,
              mla_w_in, mla_q_norm, mla_kv_norm, mla_w_uq, mla_w_ukv, mla_qk_norm, mla_w_out):
    for i in range(DEPTH):
        x = x + 0.5 * swiglu_ffn(rms_norm(x, ffn1_norm[i]), ffn1_w_gate_up[i], ffn1_w_down[i])
        h = rms_norm(x, mix_norm[i])
        j = i // N_MIXERS
        if i % N_MIXERS == 0:
            y = mlstm_mixer(h, mlstm_w_in[j], mlstm_gate_bias[j], mlstm_head_norm[j], mlstm_w_out[j])
        else:
            y = mla_mixer(h, positions, mla_w_in[j], mla_q_norm[j], mla_kv_norm[j],
                          mla_w_uq[j], mla_w_ukv[j], mla_qk_norm[j], mla_w_out[j])
        x = x + y
        x = x + 0.5 * swiglu_ffn(rms_norm(x, ffn2_norm[i]), ffn2_w_gate_up[i], ffn2_w_down[i])
    return x
```

```cpp
#include <hip/hip_runtime.h>
#include <hip/hip_cooperative_groups.h>
#include <cstdio>
#include <cstdint>
namespace cg = cooperative_groups;

#define LAS __attribute__((address_space(3)))
typedef unsigned short bf16_t;
typedef short bf16x8 __attribute__((ext_vector_type(8)));
typedef short s16x4 __attribute__((ext_vector_type(4)));
typedef float f32x4 __attribute__((ext_vector_type(4)));
typedef float f32x16 __attribute__((ext_vector_type(16)));
typedef unsigned u32x4 __attribute__((ext_vector_type(4)));
typedef unsigned u32x2 __attribute__((ext_vector_type(2)));

constexpr int M = 16384, D = 2048, FF = 5632;
constexpr float EPS = 1e-6f;
constexpr int NWAVES = 8;
constexpr int LDS_BYTES = 147456;
#ifndef REP_ATT
#define REP_ATT 1
#endif
#define REP_MLSTM 1
#define REP_CONV 1
#define REP_GU 1
#define REP_NORM 1
#define REP_MA 1
#define REP_MC 1
#define REP_DOWN 1
#define REP_OTHER 1

__device__ __forceinline__ unsigned f2bf(float f) { unsigned u = __float_as_uint(f); return (u + 0x7fffu + ((u >> 16) & 1u)) >> 16; }
__device__ __forceinline__ unsigned pk2(float lo, float hi) { return f2bf(lo) | (f2bf(hi) << 16); }
__device__ __forceinline__ float bf2f(unsigned short b) { return __uint_as_float(((unsigned)b) << 16); }
__device__ __forceinline__ float bflo(unsigned w) { return __uint_as_float(w << 16); }
__device__ __forceinline__ float bfhi(unsigned w) { return __uint_as_float(w & 0xffff0000u); }
__device__ __forceinline__ float wave_sum(float v) {
#pragma unroll
    for (int o = 1; o < 64; o <<= 1) v += __shfl_xor(v, o);
    return v;
}
__device__ __forceinline__ float wave_max(float v) {
#pragma unroll
    for (int o = 1; o < 64; o <<= 1) v = fmaxf(v, __shfl_xor(v, o));
    return v;
}
__device__ __forceinline__ int opaque_tid() { int t = threadIdx.x; asm volatile("" : "+v"(t)); return t; }
__device__ __forceinline__ float sigmoidf_(float x) { return 1.0f / (1.0f + __expf(-x)); }

namespace pg8 {
constexpr int BM = 256, BK = 64, HALF = 128, HTB = HALF * BK * 2, STAGE_BYTES = 8 * HTB, NXCD = 8, WGM = 8;
__host__ __device__ __forceinline__ int lds_byte(int r, int c) { const int st = (r >> 4) * 2 + (c >> 5), rr = r & 15, cc = c & 31, ob = rr * 64 + cc * 2; return st * 1024 + (ob ^ (((ob >> 9) & 1) << 5)); }
__host__ __device__ __forceinline__ void stage_rc(int b, int& R, int& C) { const int st = b / 1024, sb = b % 1024, swz = sb ^ (((sb >> 9) & 1) << 5); R = (st >> 1) * 16 + swz / 64; C = (st & 1) * 32 + (swz % 64) / 2; }
__host__ __device__ __forceinline__ int perm32(int rho) { const int n = rho >> 4, i = rho & 15; return 8 * (i >> 2) + 4 * n + (i & 3); }

struct Unit { int pm, pn; };
struct Gemm { const bf16_t* A; const bf16_t* Bt; int M, N, K; };

struct StaticOrder {
    int nM, nN, nwg, G, c, rev, wgm;
    __device__ void init(int M_, int N_, int G_, int c_, int rev_ = 0, int wgm_ = WGM) { nM = M_ / BM; nN = N_ / BM; nwg = nM * nN; G = G_; c = c_; rev = rev_; wgm = wgm_; }
    __device__ bool next(int i, Unit& u) const {
        const long L = (long)i * G + c; if (L >= nwg) return false;
        int wgid = (int)L; { const int q = nwg / NXCD, r = nwg % NXCD, xcd = wgid % NXCD, off = wgid / NXCD; wgid = (xcd < r ? xcd * (q + 1) : r * (q + 1) + (xcd - r) * q) + off; }
        const int nig = wgm * nN, gid = wgid / nig, fm = gid * wgm, gsz = (nM - fm) < wgm ? (nM - fm) : wgm;
        u.pm = fm + ((wgid % nig) % gsz); u.pn = (wgid % nig) / gsz; if (rev) u.pm = nM - 1 - u.pm; return true;
    }
};

__device__ __forceinline__ unsigned cvt_pk_bf16(float lo, float hi) { unsigned r; asm volatile("v_cvt_pk_bf16_f32 %0, %1, %2" : "=v"(r) : "v"(lo), "v"(hi)); return r; }

__device__ __forceinline__ float rstd_of(float ssq) { return __builtin_amdgcn_rsqf(ssq * (1.0f / 2048.0f) + 1e-6f); }
struct EpiBf16 {
    static constexpr bool PERM = true;
    bf16_t* O; int ldc; const float* cssq; const float* rssq512;
    __device__ __forceinline__ void operator()(const f32x4 (&acc)[2][2][4][2], const Unit& u, int wr, int wc, int fr, int fq) const {
        const int row0 = u.pm * BM + wr * 64 + fr; const int col0 = u.pn * BM + wc * 32 + 8 * fq;
        f32x4 cs[2][2];
#pragma unroll
        for (int bj = 0; bj < 2; ++bj)
#pragma unroll
            for (int n = 0; n < 2; ++n) { if (cssq) { const f32x4 q = *(const f32x4*)(cssq + col0 + bj * HALF + 4 * n); cs[bj][n] = (f32x4){rstd_of(q.x), rstd_of(q.y), rstd_of(q.z), rstd_of(q.w)}; } else cs[bj][n] = (f32x4){1.f, 1.f, 1.f, 1.f}; }
#pragma unroll
        for (int ai = 0; ai < 2; ++ai)
#pragma unroll
            for (int m = 0; m < 4; ++m) { const int row = row0 + ai * HALF + m * 16; bf16_t* rowp = O + (size_t)row * ldc + col0;
                const float rs = rssq512 ? __builtin_amdgcn_rsqf(rssq512[row] * (1.0f / 512.0f) + 1e-6f) : 1.0f;
#pragma unroll
                for (int bj = 0; bj < 2; ++bj) { f32x4 v0 = acc[ai][bj][m][0] * cs[bj][0] * rs, v1 = acc[ai][bj][m][1] * cs[bj][1] * rs;
                    u32x4 w; w.x = cvt_pk_bf16(v0[0], v0[1]); w.y = cvt_pk_bf16(v0[2], v0[3]); w.z = cvt_pk_bf16(v1[0], v1[1]); w.w = cvt_pk_bf16(v1[2], v1[3]);
                    *(u32x4*)(rowp + bj * HALF) = w; } }
    }
};
struct EpiMlstmIn {
    static constexpr bool PERM = true;
    bf16_t* O; float* G; const float* ssq;
    __device__ __forceinline__ void operator()(const f32x4 (&acc)[2][2][4][2], const Unit& u, int wr, int wc, int fr, int fq) const {
        const int row0 = u.pm * BM + wr * 64 + fr;
        if (u.pn < 16) {
            const int col0 = u.pn * BM + wc * 32 + 8 * fq; const float sc0 = (u.pn < 4) ? 0.0625f : 1.f;
#pragma unroll
            for (int ai = 0; ai < 2; ++ai)
#pragma unroll
                for (int m = 0; m < 4; ++m) { const int row = row0 + ai * HALF + m * 16; const float sc = sc0 * rstd_of(ssq[row]); bf16_t* rowp = O + (size_t)row * 4096 + col0;
#pragma unroll
                    for (int bj = 0; bj < 2; ++bj) { f32x4 v0 = acc[ai][bj][m][0] * sc, v1 = acc[ai][bj][m][1] * sc;
                        u32x4 w; w.x = cvt_pk_bf16(v0[0], v0[1]); w.y = cvt_pk_bf16(v0[2], v0[3]); w.z = cvt_pk_bf16(v1[0], v1[1]); w.w = cvt_pk_bf16(v1[2], v1[3]);
                        *(u32x4*)(rowp + bj * HALF) = w; } }
        } else if (wc == 0 && fq == 0) {
#pragma unroll
            for (int ai = 0; ai < 2; ++ai)
#pragma unroll
                for (int m = 0; m < 4; ++m) { const int row = row0 + ai * HALF + m * 16; const float sc = rstd_of(ssq[row]); float* gp = G + (size_t)row * 8;
                    *(f32x4*)gp = acc[ai][0][m][0] * sc; *(f32x4*)(gp + 4) = acc[ai][0][m][1] * sc; }
        }
    }
};
struct EpiMlaIn {
    static constexpr bool PERM = true;
    bf16_t* CQ; bf16_t* CKV; float* KR; const float* ssq; float* ssq_q; float* ssq_kv;
    __device__ __forceinline__ void operator()(const f32x4 (&acc)[2][2][4][2], const Unit& u, int wr, int wc, int fr, int fq) const {
        const int row0 = u.pm * BM + wr * 64 + fr;
        if (u.pn < 4) {
            bf16_t* O = (u.pn < 2) ? CQ : CKV; float* so = (u.pn < 2) ? ssq_q : ssq_kv; const int col0 = (u.pn & 1) * BM + wc * 32 + 8 * fq;
#pragma unroll
            for (int ai = 0; ai < 2; ++ai)
#pragma unroll
                for (int m = 0; m < 4; ++m) { const int row = row0 + ai * HALF + m * 16; const float sc = rstd_of(ssq[row]); bf16_t* rowp = O + (size_t)row * 512 + col0; float ss = 0.f;
#pragma unroll
                    for (int bj = 0; bj < 2; ++bj) { f32x4 v0 = acc[ai][bj][m][0] * sc, v1 = acc[ai][bj][m][1] * sc;
                        u32x4 w; w.x = cvt_pk_bf16(v0[0], v0[1]); w.y = cvt_pk_bf16(v0[2], v0[3]); w.z = cvt_pk_bf16(v1[0], v1[1]); w.w = cvt_pk_bf16(v1[2], v1[3]);
                        *(u32x4*)(rowp + bj * HALF) = w;
                        ss += (v0[0] * v0[0] + v0[1] * v0[1]) + (v0[2] * v0[2] + v0[3] * v0[3]) + (v1[0] * v1[0] + v1[1] * v1[1]) + (v1[2] * v1[2] + v1[3] * v1[3]); }
                    ss += __shfl_xor(ss, 16); ss += __shfl_xor(ss, 32); if (fq == 0) atomicAdd(so + row, ss); }
        } else if (wc < 2) {
#pragma unroll
            for (int ai = 0; ai < 2; ++ai)
#pragma unroll
                for (int m = 0; m < 4; ++m) { const int row = row0 + ai * HALF + m * 16; const float sc = rstd_of(ssq[row]); float* kp = KR + (size_t)row * 64 + wc * 32 + 8 * fq;
                    *(f32x4*)kp = acc[ai][0][m][0] * sc; *(f32x4*)(kp + 4) = acc[ai][0][m][1] * sc; }
        }
    }
};
struct EpiSwiGLU {
    static constexpr bool PERM = true;
    bf16_t* H; const float* ssq;
    __device__ __forceinline__ void operator()(const f32x4 (&acc)[2][2][4][2], const Unit& u, int wr, int wc, int fr, int fq) const {
        const int row0 = u.pm * BM + wr * 64 + fr; const int col0 = u.pn * HALF + wc * 32 + 8 * fq;
#pragma unroll
        for (int ai = 0; ai < 2; ++ai)
#pragma unroll
            for (int m = 0; m < 4; ++m) { const int row = row0 + ai * HALF + m * 16; const float rs = rstd_of(ssq[row]), rs2 = rs * rs, rsc = rs * -1.4426950408889634f; bf16_t* rowp = H + (size_t)row * FF + col0;
                float h[8];
#pragma unroll
                for (int n = 0; n < 2; ++n)
#pragma unroll
                    for (int j = 0; j < 4; ++j) { const float g = acc[ai][0][m][n][j], up = acc[ai][1][m][n][j]; h[n * 4 + j] = (g * up) * rs2 * __builtin_amdgcn_rcpf(1.0f + __builtin_amdgcn_exp2f(g * rsc)); }
                u32x4 w; w.x = cvt_pk_bf16(h[0], h[1]); w.y = cvt_pk_bf16(h[2], h[3]); w.z = cvt_pk_bf16(h[4], h[5]); w.w = cvt_pk_bf16(h[6], h[7]);
                *(u32x4*)rowp = w; }
    }
};
struct EpiRes {
    static constexpr bool PERM = true;
    const bf16_t* base; const float* basef; float* out; int ldc; float scale; bf16_t* xb; float* ssq_out;
    __device__ __forceinline__ void operator()(const f32x4 (&acc)[2][2][4][2], const Unit& u, int wr, int wc, int fr, int fq) const {
        const int col0 = u.pn * BM + wc * 32 + 8 * fq;
        float sc = scale; asm volatile("" : "+v"(sc));
#pragma unroll
        for (int ai = 0; ai < 2; ++ai)
#pragma unroll
            for (int m = 0; m < 4; ++m) { const int row = u.pm * BM + ai * HALF + wr * 64 + m * 16 + fr; const size_t off = (size_t)row * ldc + col0; float ss = 0.f;
#pragma unroll
                for (int bj = 0; bj < 2; ++bj) { f32x4 b0, b1;
                    if (basef) { b0 = *(const f32x4*)(basef + off + bj * HALF); b1 = *(const f32x4*)(basef + off + bj * HALF + 4); }
                    else { const u32x4 bw = *(const u32x4*)(base + off + bj * HALF); b0 = (f32x4){bflo(bw.x), bfhi(bw.x), bflo(bw.y), bfhi(bw.y)}; b1 = (f32x4){bflo(bw.z), bfhi(bw.z), bflo(bw.w), bfhi(bw.w)}; }
                    f32x4 o0 = acc[ai][bj][m][0] * sc + b0;
                    f32x4 o1 = acc[ai][bj][m][1] * sc + b1;
                    if (out) { *(f32x4*)(out + off + bj * HALF) = o0; *(f32x4*)(out + off + bj * HALF + 4) = o1; }
                    if (xb) { u32x4 w; w.x = cvt_pk_bf16(o0[0], o0[1]); w.y = cvt_pk_bf16(o0[2], o0[3]); w.z = cvt_pk_bf16(o1[0], o1[1]); w.w = cvt_pk_bf16(o1[2], o1[3]);
                        *(u32x4*)(xb + off + bj * HALF) = w;
                        ss += (o0[0] * o0[0] + o0[1] * o0[1]) + (o0[2] * o0[2] + o0[3] * o0[3]) + (o1[0] * o1[0] + o1[1] * o1[1]) + (o1[2] * o1[2] + o1[3] * o1[3]); } }
                if (xb) { ss += __shfl_xor(ss, 16); ss += __shfl_xor(ss, 32); if (fq == 0) atomicAdd(ssq_out + row, ss); }
                if (m & 1) asm volatile("" ::: "memory"); }
    }
};

template <class Epi>
__device__ __forceinline__ void gemm_phase(LAS unsigned char* lds, const Gemm g, const StaticOrder& S, const Epi& E) {
    int tid = threadIdx.x; asm volatile("" : "+v"(tid));
    const int wid = __builtin_amdgcn_readfirstlane(tid >> 6), lane = tid & 63, wr = wid >> 2, wc = wid & 3, fr = lane & 15, fq = lane >> 4;
    const int K = g.K, nt = K / BK;
    unsigned voffA[2], voffB[2];
#pragma unroll
    for (int i = 0; i < 2; ++i) { int R, C; stage_rc(tid * 16 + i * 8192, R, C); const int Rb = Epi::PERM ? ((R & ~31) + perm32(R & 31)) : R;
        voffA[i] = (unsigned)(R * K + C) * 2u; voffB[i] = (unsigned)(Rb * K + C) * 2u; }
    const size_t kstep = (size_t)(BK * 2);
    const size_t hstep = (size_t)HALF * K * 2;
    const size_t tstep = 2 * hstep;
    const unsigned ldsw = (unsigned)wid * 1024u;
    const int aoff = lds_byte(wr * 64 + fr, fq * 8), boff = lds_byte(wc * 32 + fr, fq * 8);
#define PG8_SA(b, h) (((b) * 2 + (h)) * HTB)
#define PG8_SB(b, h) ((4 + (b) * 2 + (h)) * HTB)
#define PG8_STAGE(bufoff, gbase, voff) do { _Pragma("unroll") for (int _i = 0; _i < 2; ++_i) \
        __builtin_amdgcn_global_load_lds((const unsigned*)((const char*)(gbase) + (voff)[_i]), (LAS unsigned*)(lds + (bufoff) + ldsw + _i * 8192), 16, 0, 0); } while (0)
#define PG8_LDA(dst, b, h) do { _Pragma("unroll") for (int m = 0; m < 4; ++m) _Pragma("unroll") for (int k = 0; k < 2; ++k) dst[m][k] = *(const LAS bf16x8*)(lds + PG8_SA(b, h) + aoff + m * 2048 + k * 1024); } while (0)
#define PG8_LDB(dst, b, h) do { _Pragma("unroll") for (int n = 0; n < 2; ++n) _Pragma("unroll") for (int k = 0; k < 2; ++k) dst[n][k] = *(const LAS bf16x8*)(lds + PG8_SB(b, h) + boff + n * 2048 + k * 1024); } while (0)
#define PG8_MMA(ai, bj, At, Bt) do { __builtin_amdgcn_s_setprio(1); _Pragma("unroll") for (int m = 0; m < 4; ++m) _Pragma("unroll") for (int n = 0; n < 2; ++n) _Pragma("unroll") for (int k = 0; k < 2; ++k) \
        acc[ai][bj][m][n] = __builtin_amdgcn_mfma_f32_16x16x32_bf16(Bt[n][k], At[m][k], acc[ai][bj][m][n], 0, 0, 0); __builtin_amdgcn_s_setprio(0); } while (0)
#define PG8_WAIT_V(n) asm volatile("s_waitcnt vmcnt(" #n ")" ::: "memory")
#define PG8_WAIT_L(n) asm volatile("s_waitcnt lgkmcnt(" #n ")" ::: "memory")
#define PG8_BAR __builtin_amdgcn_s_barrier()
#define PG8_SCHED __builtin_amdgcn_sched_barrier(0)
    Unit cur, nxt; int ui = 0;
    if (!S.next(0, cur)) return;
    f32x4 acc[2][2][4][2];
#pragma unroll
    for (int a = 0; a < 2; ++a)
#pragma unroll
        for (int b = 0; b < 2; ++b)
#pragma unroll
            for (int m = 0; m < 4; ++m)
#pragma unroll
                for (int n = 0; n < 2; ++n) acc[a][b][m][n] = (f32x4){0.f, 0.f, 0.f, 0.f};
    bf16x8 At[4][2], B0[2][2], B1[2][2];
    const char* cA = (const char*)g.A + (size_t)cur.pm * tstep; const char* cB = (const char*)g.Bt + (size_t)cur.pn * tstep;
    PG8_STAGE(PG8_SB(0, 0), cB, voffB); PG8_STAGE(PG8_SB(0, 1), cB + hstep, voffB); PG8_STAGE(PG8_SA(0, 0), cA, voffA); PG8_STAGE(PG8_SA(0, 1), cA + hstep, voffA);
    if (wr == 1) PG8_BAR;
    PG8_WAIT_V(2); PG8_BAR;
    PG8_STAGE(PG8_SB(1, 0), cB + kstep, voffB); PG8_STAGE(PG8_SA(1, 0), cA + kstep, voffA); PG8_STAGE(PG8_SB(1, 1), cB + hstep + kstep, voffB);
    PG8_WAIT_V(6); PG8_BAR;
    for (;;) {
        const bool has_next = S.next(ui + 1, nxt);
        const char* nA = has_next ? (const char*)g.A + (size_t)nxt.pm * tstep : cA; const char* nB = has_next ? (const char*)g.Bt + (size_t)nxt.pn * tstep : cB;
        for (int t = 0; t < nt; t += 2) {
            const bool last = (t == nt - 2);
            const char* a1 = cA + (size_t)(t + 1) * kstep;
            const char* a2 = last ? nA : cA + (size_t)(t + 2) * kstep; const char* b2 = last ? nB : cB + (size_t)(t + 2) * kstep;
            const char* a3 = a2 + kstep; const char* b3 = b2 + kstep;
            PG8_LDB(B0, 0, 0); PG8_LDB(B1, 0, 1); PG8_SCHED; PG8_LDA(At, 0, 0); PG8_STAGE(PG8_SA(1, 1), a1 + hstep, voffA);
            PG8_WAIT_V(8); PG8_WAIT_L(0); PG8_BAR; PG8_MMA(0, 0, At, B0); PG8_MMA(0, 1, At, B1); PG8_BAR; PG8_SCHED;
            PG8_LDA(At, 0, 1); PG8_STAGE(PG8_SB(0, 0), b2, voffB); PG8_STAGE(PG8_SB(0, 1), b2 + hstep, voffB); PG8_STAGE(PG8_SA(0, 0), a2, voffA);
            PG8_WAIT_V(8); PG8_WAIT_L(0); PG8_BAR; PG8_MMA(1, 0, At, B0); PG8_MMA(1, 1, At, B1); PG8_BAR; PG8_SCHED;
            PG8_LDB(B0, 1, 0); PG8_LDB(B1, 1, 1); PG8_SCHED; PG8_LDA(At, 1, 0); PG8_STAGE(PG8_SA(0, 1), a2 + hstep, voffA);
            PG8_WAIT_V(8); PG8_WAIT_L(0); PG8_BAR; PG8_MMA(0, 0, At, B0); PG8_MMA(0, 1, At, B1); PG8_BAR; PG8_SCHED;
            PG8_LDA(At, 1, 1); PG8_STAGE(PG8_SB(1, 0), b3, voffB); PG8_STAGE(PG8_SB(1, 1), b3 + hstep, voffB); PG8_STAGE(PG8_SA(1, 0), a3, voffA);
            PG8_WAIT_V(8); PG8_WAIT_L(0); PG8_BAR; PG8_MMA(1, 0, At, B0); PG8_MMA(1, 1, At, B1); PG8_BAR; PG8_SCHED;
        }
        if (wr == 0) PG8_BAR;
        { int fr_e = fr, fq_e = fq; asm volatile("" : "+v"(fr_e), "+v"(fq_e));
          E(acc, cur, wr, wc, fr_e, fq_e); }
        if (!has_next) break;
#pragma unroll
        for (int a = 0; a < 2; ++a)
#pragma unroll
            for (int b = 0; b < 2; ++b)
#pragma unroll
                for (int m = 0; m < 4; ++m)
#pragma unroll
                    for (int n = 0; n < 2; ++n) acc[a][b][m][n] = (f32x4){0.f, 0.f, 0.f, 0.f};
        cur = nxt; cA = nA; cB = nB; ++ui;
        if (wr == 1) PG8_BAR;
    }
    PG8_WAIT_V(0);
    PG8_BAR;
#undef PG8_SA
#undef PG8_SB
#undef PG8_STAGE
#undef PG8_LDA
#undef PG8_LDB
#undef PG8_MMA
#undef PG8_WAIT_V
#undef PG8_WAIT_L
#undef PG8_BAR
#undef PG8_SCHED
}
}

__device__ __forceinline__ void conv_matrix(const float* W, int K, int ldn, int c0, int ncols, bf16_t* WT, int drow0, int mode, const float* gain, LAS unsigned char* lds) {
    const int tid = opaque_tid(), lane = tid & 63, wave = __builtin_amdgcn_readfirstlane(tid >> 6), gw = blockIdx.x * NWAVES + wave, ngw = gridDim.x * NWAVES;
    LAS float* scr = (LAS float*)(lds + wave * 16384);
    const int nblk = ncols / 32, nitems = (K / 64) * nblk;
    for (int it = gw; it < nitems; it += ngw) {
        const int kb = it / nblk, nb = it - kb * nblk, k0 = 64 * kb, n0 = c0 + 32 * nb;
        int drow;
        if (mode == 1) { const int up = n0 >= FF ? 1 : 0, j = n0 - up * FF; drow = (j >> 7) * 256 + up * 128 + (j & 127); } else drow = drow0 + 32 * nb;
#pragma unroll 8
        for (int i = 0; i < 32; ++i) { const int kk = 2 * i + (lane >> 5); scr[kk * 33 + (lane & 31)] = W[(size_t)(k0 + kk) * ldn + n0 + (lane & 31)]; }
        asm volatile("s_waitcnt lgkmcnt(0)" ::: "memory");
        const int c = lane & 7;
        f32x4 g0 = {1.f, 1.f, 1.f, 1.f}, g1 = {1.f, 1.f, 1.f, 1.f};
        if (gain) { g0 = *(const f32x4*)(gain + k0 + 8 * c); g1 = *(const f32x4*)(gain + k0 + 8 * c + 4); }
#pragma unroll
        for (int j = 0; j < 4; ++j) { const int n = (lane >> 3) + 8 * j; const LAS float* s = scr + (8 * c) * 33 + n;
            u32x4 o; o.x = pk2(s[0 * 33] * g0.x, s[1 * 33] * g0.y); o.y = pk2(s[2 * 33] * g0.z, s[3 * 33] * g0.w); o.z = pk2(s[4 * 33] * g1.x, s[5 * 33] * g1.y); o.w = pk2(s[6 * 33] * g1.z, s[7 * 33] * g1.w);
            *(u32x4*)(WT + (size_t)(drow + n) * K + k0 + 8 * c) = o; }
        asm volatile("s_waitcnt lgkmcnt(0)" ::: "memory");
    }
}

__device__ __forceinline__ void cast_rows_ssq(const float* X, bf16_t* XB, float* ssq) {
    const int tid = opaque_tid(), lane = tid & 63, gw = blockIdx.x * NWAVES + __builtin_amdgcn_readfirstlane(tid >> 6), ngw = gridDim.x * NWAVES;
    for (int m = gw; m < M; m += ngw) {
        const float* xr = X + (size_t)m * D + 4 * lane; f32x4 v[8]; float s = 0.f;
#pragma unroll
        for (int j = 0; j < 8; ++j) { v[j] = *(const f32x4*)(xr + 256 * j); s += (v[j].x * v[j].x + v[j].y * v[j].y) + (v[j].z * v[j].z + v[j].w * v[j].w); }
        s = wave_sum(s);
        if (lane == 0) ssq[m] = s;
        bf16_t* orow = XB + (size_t)m * D + 4 * lane;
#pragma unroll
        for (int j = 0; j < 8; ++j) { u32x2 w; w.x = pk2(v[j].x, v[j].y); w.y = pk2(v[j].z, v[j].w); *(u32x2*)(orow + 256 * j) = w; }
    }
}

__device__ __forceinline__ float scan_add(float v, int lane) {
#pragma unroll
    for (int o = 1; o < 64; o <<= 1) { const float t = __shfl_up(v, o); if (lane >= o) v += t; }
    return v;
}
__device__ __forceinline__ float scan_max(float v, int lane) {
#pragma unroll
    for (int o = 1; o < 64; o <<= 1) { const float t = __shfl_up(v, o); if (lane >= o) v = fmaxf(v, t); }
    return v;
}
__device__ __forceinline__ float log_sigmoid(float x) { return fminf(x, 0.f) - log1pf(expf(-fabsf(x))); }

__device__ __forceinline__ void mlstm_stage_a(LAS unsigned char* lds, const bf16_t* QKO, const bf16_t* KVT, const float* G, const float* gbias, bf16_t* DC, float* DN, float* SC,
                                              int bid, int nblk, int tid) {
    asm volatile("" : "+v"(tid));
    const int lane = tid & 63, wave = __builtin_amdgcn_readfirstlane(tid >> 6), r32 = lane & 31, hi = lane >> 5;
    LAS float* sWk = (LAS float*)lds;
    LAS unsigned char* sKS = lds + 1024;
    for (int u = bid; u < 1024; u += nblk) {
        const int c = u >> 2, h = u & 3, t0 = c * 64;
        if (wave == 0) {
            const float ig = G[(size_t)(t0 + lane) * 8 + h] + gbias[h];
            const float lf = log_sigmoid(G[(size_t)(t0 + lane) * 8 + 4 + h] + gbias[4 + h]);
            const float b = scan_add(lf, lane);
            const float blast = __shfl(b, 63);
            const float gg = blast - b + ig;
            const float mloc = wave_max(gg);
            sWk[lane] = expf(gg - mloc);
            if (lane == 0) { SC[(c * 4 + h) * 2] = blast; SC[(c * 4 + h) * 2 + 1] = mloc; }
        }
        __syncthreads();
#pragma unroll
        for (int i = 0; i < 4; ++i) { const int q = tid + 512 * i, sidx = q & 63, d8 = q >> 6;
            const u32x4 kv = *(const u32x4*)(QKO + (size_t)(t0 + sidx) * 4096 + 1024 + h * 256 + d8 * 8);
            const float wk = sWk[sidx];
            LAS unsigned short* dst = (LAS unsigned short*)(sKS + (d8 * 8) * 144 + sidx * 2);
            dst[0 * 72] = (unsigned short)f2bf(bflo(kv.x) * wk); dst[1 * 72] = (unsigned short)f2bf(bfhi(kv.x) * wk);
            dst[2 * 72] = (unsigned short)f2bf(bflo(kv.y) * wk); dst[3 * 72] = (unsigned short)f2bf(bfhi(kv.y) * wk);
            dst[4 * 72] = (unsigned short)f2bf(bflo(kv.z) * wk); dst[5 * 72] = (unsigned short)f2bf(bfhi(kv.z) * wk);
            dst[6 * 72] = (unsigned short)f2bf(bflo(kv.w) * wk); dst[7 * 72] = (unsigned short)f2bf(bfhi(kv.w) * wk); }
        __syncthreads();
        if (tid < 256) { float s = 0.f;
#pragma unroll
            for (int j = 0; j < 8; ++j) { const u32x4 w = *(const LAS u32x4*)(sKS + tid * 144 + j * 16);
                s += (bflo(w.x) + bfhi(w.x)) + (bflo(w.y) + bfhi(w.y)) + (bflo(w.z) + bfhi(w.z)) + (bflo(w.w) + bfhi(w.w)); }
            DN[(size_t)(c * 4 + h) * 256 + tid] = s; }
        bf16x8 bfr[2][4];
#pragma unroll
        for (int vb = 0; vb < 2; ++vb)
#pragma unroll
            for (int ks = 0; ks < 4; ++ks) bfr[vb][ks] = *(const bf16x8*)(KVT + (size_t)(h * 512 + (wave * 2 + vb) * 32 + r32) * M + t0 + ks * 16 + hi * 8);
#pragma unroll
        for (int dh = 0; dh < 2; ++dh) {
            f32x16 acc[4][2];
#pragma unroll
            for (int a = 0; a < 4; ++a) { acc[a][0] = f32x16{}; acc[a][1] = f32x16{}; }
#pragma unroll
            for (int db4 = 0; db4 < 4; ++db4)
#pragma unroll
                for (int ks = 0; ks < 4; ++ks) { const bf16x8 a = *(const LAS bf16x8*)(sKS + ((dh * 4 + db4) * 32 + r32) * 144 + ks * 32 + hi * 16);
                    acc[db4][0] = __builtin_amdgcn_mfma_f32_32x32x16_bf16(a, bfr[0][ks], acc[db4][0], 0, 0, 0);
                    acc[db4][1] = __builtin_amdgcn_mfma_f32_32x32x16_bf16(a, bfr[1][ks], acc[db4][1], 0, 0, 0); }
#pragma unroll
            for (int db4 = 0; db4 < 4; ++db4)
#pragma unroll
                for (int vb = 0; vb < 2; ++vb) { const int v = (wave * 2 + vb) * 32 + r32;
                    bf16_t* dp = DC + ((size_t)((c * 4 + h) * 512 + v)) * 256 + (dh * 4 + db4) * 32 + 4 * hi;
#pragma unroll
                    for (int gq = 0; gq < 4; ++gq) { u32x2 w; w.x = pk2(acc[db4][vb][4 * gq], acc[db4][vb][4 * gq + 1]); w.y = pk2(acc[db4][vb][4 * gq + 2], acc[db4][vb][4 * gq + 3]);
                        *(u32x2*)(dp + 8 * gq) = w; } }
        }
        __syncthreads();
    }
}

__device__ __forceinline__ void mlstm_stage_b(bf16_t* DC, float* DN, const float* SC, float* MS, int bid, int nblk, int tid) {
    for (int e4 = bid * 512 + tid; e4 < 131072; e4 += nblk * 512) {
        const int h = __builtin_amdgcn_readfirstlane(e4 >> 15);
        const bool do_n = (e4 & 32767) < 256, do_m = (e4 & 32767) == 0;
        u32x2* p = (u32x2*)DC + e4;
        float* np = DN + (size_t)h * 256 + (e4 & 255);
        float s0 = 0.f, s1 = 0.f, s2 = 0.f, s3 = 0.f, sn = 0.f, m = 0.f;
        u32x2 xa[16]; float na[16];
#pragma unroll
        for (int i = 0; i < 16; ++i) { xa[i] = p[(size_t)i * 131072]; na[i] = do_n ? np[(size_t)i * 1024] : 0.f; }
        for (int c = 0; c < 256; c += 16) {
            u32x2 xb[16]; float nb[16];
            const int cn = (c + 16 < 256) ? c + 16 : c;
#pragma unroll
            for (int i = 0; i < 16; ++i) { xb[i] = p[(size_t)(cn + i) * 131072]; nb[i] = do_n ? np[(size_t)(cn + i) * 1024] : 0.f; }
#pragma unroll
            for (int i = 0; i < 16; ++i) {
                const float blast = SC[((c + i) * 4 + h) * 2], mloc = SC[((c + i) * 4 + h) * 2 + 1];
                const float mn = fmaxf(blast + m, mloc), al = __expf(blast + m - mn), be = __expf(mloc - mn);
                u32x2 w; w.x = pk2(s0, s1); w.y = pk2(s2, s3);
                p[(size_t)(c + i) * 131072] = w;
                if (do_n) np[(size_t)(c + i) * 1024] = sn;
                if (do_m) MS[(c + i) * 4 + h] = m;
                s0 = al * s0 + be * bflo(xa[i].x); s1 = al * s1 + be * bfhi(xa[i].x); s2 = al * s2 + be * bflo(xa[i].y); s3 = al * s3 + be * bfhi(xa[i].y);
                sn = al * sn + be * na[i]; m = mn;
            }
#pragma unroll
            for (int i = 0; i < 16; ++i) { xa[i] = xb[i]; na[i] = nb[i]; }
        }
    }
}

__device__ __forceinline__ void mlstm_stage_c(LAS unsigned char* lds, const bf16_t* QKO, const bf16_t* KVT, const float* G, const float* gbias, const bf16_t* DC, const float* DN,
                                              const float* MS, const float* hnorm, bf16_t* HG, int bid, int nblk, int tid) {
    asm volatile("" : "+v"(tid));
    const int lane = tid & 63, wave = __builtin_amdgcn_readfirstlane(tid >> 6), r32 = lane & 31, hi = lane >> 5;
    LAS float* sB = (LAS float*)lds; LAS float* sI = sB + 64; LAS float* sMt = sB + 128; LAS float* sA = sB + 192; LAS float* sDinv = sB + 256;
    LAS float* sQn = sB + 320;
    LAS float* sSsq = sB + 832;
    LAS unsigned char* sW = lds + 5376;
    for (int u = bid; u < 1024; u += nblk) {
        const int c = u >> 2, h = u & 3, t0 = c * 64;
        if (wave == 0) {
            const float ig = G[(size_t)(t0 + lane) * 8 + h] + gbias[h];
            const float lf = log_sigmoid(G[(size_t)(t0 + lane) * 8 + 4 + h] + gbias[4 + h]);
            const float b = scan_add(lf, lane);
            const float mc = MS[c * 4 + h];
            const float pm = scan_max(ig - b, lane);
            const float mt = b + fmaxf(mc, pm);
            sB[lane] = b; sI[lane] = ig; sMt[lane] = mt; sA[lane] = expf(b + mc - mt);
        }
        { const int t = tid & 63, part = tid >> 6;
          const bf16_t* qp = QKO + (size_t)(t0 + t) * 4096 + h * 256 + part * 32; const float* np = DN + (size_t)(c * 4 + h) * 256 + part * 32;
          float s = 0.f;
#pragma unroll
          for (int j = 0; j < 4; ++j) { const u32x4 qv = *(const u32x4*)(qp + j * 8); const f32x4 n0 = *(const f32x4*)(np + j * 8), n1 = *(const f32x4*)(np + j * 8 + 4);
              s += bflo(qv.x) * n0.x + bfhi(qv.x) * n0.y + bflo(qv.y) * n0.z + bfhi(qv.y) * n0.w + bflo(qv.z) * n1.x + bfhi(qv.z) * n1.y + bflo(qv.w) * n1.z + bfhi(qv.w) * n1.w; }
          sQn[part * 64 + t] = s; }
        __syncthreads();
        if (wave < 4) {
            const int sb = wave >> 1, tb = wave & 1;
            f32x16 acc = f32x16{};
            const bf16_t* kp = QKO + (size_t)(t0 + sb * 32 + r32) * 4096 + 1024 + h * 256 + hi * 8;
            const bf16_t* qp = QKO + (size_t)(t0 + tb * 32 + r32) * 4096 + h * 256 + hi * 8;
#pragma unroll
            for (int ks = 0; ks < 16; ++ks) acc = __builtin_amdgcn_mfma_f32_32x32x16_bf16(*(const bf16x8*)(kp + ks * 16), *(const bf16x8*)(qp + ks * 16), acc, 0, 0, 0);
            const int t = tb * 32 + r32; const float bt = sB[t], mt = sMt[t];
#pragma unroll
            for (int gq = 0; gq < 4; ++gq) { const int s0 = sb * 32 + 8 * gq + 4 * hi; float wv[4];
#pragma unroll
                for (int e = 0; e < 4; ++e) { const int s = s0 + e; wv[e] = (s <= t) ? acc[4 * gq + e] * expf(bt - sB[s] + sI[s] - mt) : 0.f; }
                u32x2 w; w.x = pk2(wv[0], wv[1]); w.y = pk2(wv[2], wv[3]);
                *(LAS u32x2*)(sW + t * 144 + s0 * 2) = w; }
        }
        __syncthreads();
        if (wave == 0) { const int t = lane; float rs = 0.f;
#pragma unroll
            for (int j = 0; j < 8; ++j) { const u32x4 w = *(const LAS u32x4*)(sW + t * 144 + j * 16);
                rs += (bflo(w.x) + bfhi(w.x)) + (bflo(w.y) + bfhi(w.y)) + (bflo(w.z) + bfhi(w.z)) + (bflo(w.w) + bfhi(w.w)); }
            float qn = 0.f;
#pragma unroll
            for (int p = 0; p < 8; ++p) qn += sQn[p * 64 + t];
            const float den = sA[t] * qn + rs;
            sDinv[t] = 1.0f / fmaxf(fabsf(den), expf(-sMt[t])); }
        f32x16 acc[2][2];
#pragma unroll
        for (int a = 0; a < 2; ++a) { acc[a][0] = f32x16{}; acc[a][1] = f32x16{}; }
        { const bf16_t* q0p = QKO + (size_t)(t0 + r32) * 4096 + h * 256 + hi * 8; const bf16_t* q1p = q0p + (size_t)32 * 4096;
          const bf16_t* s0p = DC + ((size_t)((c * 4 + h) * 512 + wave * 64 + r32)) * 256 + hi * 8; const bf16_t* s1p = s0p + 32 * 256;
#pragma unroll
          for (int ks = 0; ks < 16; ++ks) { const bf16x8 b0 = *(const bf16x8*)(q0p + ks * 16), b1 = *(const bf16x8*)(q1p + ks * 16);
              const bf16x8 a0 = *(const bf16x8*)(s0p + ks * 16), a1 = *(const bf16x8*)(s1p + ks * 16);
              acc[0][0] = __builtin_amdgcn_mfma_f32_32x32x16_bf16(a0, b0, acc[0][0], 0, 0, 0); acc[0][1] = __builtin_amdgcn_mfma_f32_32x32x16_bf16(a0, b1, acc[0][1], 0, 0, 0);
              acc[1][0] = __builtin_amdgcn_mfma_f32_32x32x16_bf16(a1, b0, acc[1][0], 0, 0, 0); acc[1][1] = __builtin_amdgcn_mfma_f32_32x32x16_bf16(a1, b1, acc[1][1], 0, 0, 0); } }
        { const float a0 = sA[r32], a1 = sA[32 + r32];
#pragma unroll
          for (int vb = 0; vb < 2; ++vb) { acc[vb][0] *= a0; acc[vb][1] *= a1; } }
        { const bf16_t* v0p = KVT + (size_t)(h * 512 + wave * 64 + r32) * M + t0 + hi * 8; const bf16_t* v1p = v0p + (size_t)32 * M;
#pragma unroll
          for (int ks = 0; ks < 4; ++ks) { const bf16x8 b0 = *(const LAS bf16x8*)(sW + r32 * 144 + ks * 32 + hi * 16), b1 = *(const LAS bf16x8*)(sW + (32 + r32) * 144 + ks * 32 + hi * 16);
              const bf16x8 a0 = *(const bf16x8*)(v0p + ks * 16), a1 = *(const bf16x8*)(v1p + ks * 16);
              acc[0][0] = __builtin_amdgcn_mfma_f32_32x32x16_bf16(a0, b0, acc[0][0], 0, 0, 0); acc[0][1] = __builtin_amdgcn_mfma_f32_32x32x16_bf16(a0, b1, acc[0][1], 0, 0, 0);
              acc[1][0] = __builtin_amdgcn_mfma_f32_32x32x16_bf16(a1, b0, acc[1][0], 0, 0, 0); acc[1][1] = __builtin_amdgcn_mfma_f32_32x32x16_bf16(a1, b1, acc[1][1], 0, 0, 0); } }
        __syncthreads();
#pragma unroll
        for (int tb = 0; tb < 2; ++tb) { const float dinv = sDinv[tb * 32 + r32]; float ss = 0.f;
#pragma unroll
            for (int vb = 0; vb < 2; ++vb) { acc[vb][tb] *= dinv;
#pragma unroll
                for (int r = 0; r < 16; ++r) ss += acc[vb][tb][r] * acc[vb][tb][r]; }
            ss += __shfl_xor(ss, 32);
            if (hi == 0) sSsq[wave * 64 + tb * 32 + r32] = ss; }
        __syncthreads();
#pragma unroll
        for (int tb = 0; tb < 2; ++tb) { const int t = tb * 32 + r32; float tot = 0.f;
#pragma unroll
            for (int w = 0; w < 8; ++w) tot += sSsq[w * 64 + t];
            const float rstd = 1.0f / sqrtf(tot * (1.0f / 512.0f) + EPS);
#pragma unroll
            for (int vb = 0; vb < 2; ++vb)
#pragma unroll
                for (int gq = 0; gq < 4; ++gq) { const int v0 = wave * 64 + vb * 32 + 8 * gq + 4 * hi;
                    const u32x2 ow = *(const u32x2*)(QKO + (size_t)(t0 + t) * 4096 + 2048 + h * 512 + v0);
                    const f32x4 gn = *(const f32x4*)(hnorm + h * 512 + v0);
                    const float o0 = acc[vb][tb][4 * gq] * rstd * gn.x * sigmoidf_(bflo(ow.x)), o1 = acc[vb][tb][4 * gq + 1] * rstd * gn.y * sigmoidf_(bfhi(ow.x));
                    const float o2 = acc[vb][tb][4 * gq + 2] * rstd * gn.z * sigmoidf_(bflo(ow.y)), o3 = acc[vb][tb][4 * gq + 3] * rstd * gn.w * sigmoidf_(bfhi(ow.y));
                    u32x2 w; w.x = pk2(o0, o1); w.y = pk2(o2, o3);
                    *(u32x2*)(HG + (size_t)(t0 + t) * 2048 + h * 512 + v0) = w; } }
        __syncthreads();
    }
}

__device__ __forceinline__ void mla_latent_norm(const float* C, const float* qn, const float* kvn, bf16_t* CQN, bf16_t* CKVN, float* KR) {
    const int tid = opaque_tid(), lane = tid & 63, gw = blockIdx.x * NWAVES + __builtin_amdgcn_readfirstlane(tid >> 6), ngw = gridDim.x * NWAVES;
    for (int m = gw; m < M; m += ngw) {
        KR[(size_t)m * 64 + lane] = C[(size_t)m * 1280 + 1024 + lane];
        const float* cr = C + (size_t)m * 1280 + 4 * lane;
        f32x4 a[2], b[2]; float sa = 0.f, sb = 0.f;
#pragma unroll
        for (int j = 0; j < 2; ++j) { a[j] = *(const f32x4*)(cr + 256 * j); b[j] = *(const f32x4*)(cr + 512 + 256 * j);
            sa += (a[j].x * a[j].x + a[j].y * a[j].y) + (a[j].z * a[j].z + a[j].w * a[j].w); sb += (b[j].x * b[j].x + b[j].y * b[j].y) + (b[j].z * b[j].z + b[j].w * b[j].w); }
        const float ra = 1.0f / sqrtf(wave_sum(sa) * (1.0f / 512.0f) + EPS), rb = 1.0f / sqrtf(wave_sum(sb) * (1.0f / 512.0f) + EPS);
#pragma unroll
        for (int j = 0; j < 2; ++j) { const f32x4 ga = *(const f32x4*)(qn + 4 * lane + 256 * j), gb = *(const f32x4*)(kvn + 4 * lane + 256 * j);
            u32x2 w; w.x = pk2(a[j].x * ra * ga.x, a[j].y * ra * ga.y); w.y = pk2(a[j].z * ra * ga.z, a[j].w * ra * ga.w);
            *(u32x2*)(CQN + (size_t)m * 512 + 4 * lane + 256 * j) = w;
            w.x = pk2(b[j].x * rb * gb.x, b[j].y * rb * gb.y); w.y = pk2(b[j].z * rb * gb.z, b[j].w * rb * gb.w);
            *(u32x2*)(CKVN + (size_t)m * 512 + 4 * lane + 256 * j) = w; }
    }
}
__device__ __forceinline__ void mla_qk_norm_rope(bf16_t* Q, const bf16_t* KVRAW, const float* KR, const int* pos, const float* qkn, bf16_t* KF, LAS unsigned char* lds) {
    const int tid = opaque_tid(), lane = tid & 63, wave = __builtin_amdgcn_readfirstlane(tid >> 6), gw = blockIdx.x * NWAVES + wave, ngw = gridDim.x * NWAVES;
    LAS unsigned short* skr = (LAS unsigned short*)(lds + wave * 512);
    LAS float* scs = (LAS float*)(lds + wave * 512 + 128);
    const float QS = 0.07216878364870322f * 1.4426950408889634f;
    const int i32 = lane & 31;
    const double freq = exp2(-(double)i32 * (13.287712379549449 / 32.0));
    const float gkr = qkn[192 + 128 + lane];
    const int kh = lane >> 2, kp = lane & 3;
    f32x4 gk[8], gq[8], gra[2], grb[2];
#pragma unroll
    for (int e = 0; e < 8; ++e) { gk[e] = *(const f32x4*)(qkn + 192 + kp * 32 + e * 4); gq[e] = *(const f32x4*)(qkn + kp * 32 + e * 4); }
#pragma unroll
    for (int e = 0; e < 2; ++e) { gra[e] = *(const f32x4*)(qkn + 128 + kp * 8 + e * 4); grb[e] = *(const f32x4*)(qkn + 160 + kp * 8 + e * 4); }
    for (int m = gw; m < M; m += ngw) {
        const double ang = (double)pos[m] * freq;
        const double red = ang - 6.283185307179586476925 * rint(ang * 0.15915494309189533577);
        const float sn = sinf((float)red), cs = cosf((float)red);
        scs[lane] = (lane < 32) ? cs : sn;
        { const float x = KR[(size_t)m * 64 + lane]; const float r = 1.0f / sqrtf(wave_sum(x * x) * (1.0f / 64.0f) + EPS);
          const float xn = x * r * gkr; const float pr = __shfl_xor(xn, 32);
          const float kr = (lane < 32) ? (xn * cs - pr * sn) : (xn * cs + pr * sn);
          skr[lane] = (unsigned short)f2bf(kr); }
        { const bf16_t* kp_ = KVRAW + (size_t)m * 4096 + kh * 256 + kp * 32; bf16_t* kf_ = KF + (size_t)m * 3072 + kh * 192;
          u32x4 w[4]; float ss = 0.f;
#pragma unroll
          for (int e = 0; e < 4; ++e) { w[e] = *(const u32x4*)(kp_ + e * 8);
              ss += (bflo(w[e].x) * bflo(w[e].x) + bfhi(w[e].x) * bfhi(w[e].x)) + (bflo(w[e].y) * bflo(w[e].y) + bfhi(w[e].y) * bfhi(w[e].y))
                  + (bflo(w[e].z) * bflo(w[e].z) + bfhi(w[e].z) * bfhi(w[e].z)) + (bflo(w[e].w) * bflo(w[e].w) + bfhi(w[e].w) * bfhi(w[e].w)); }
          ss += __shfl_xor(ss, 1); ss += __shfl_xor(ss, 2);
          const float r3 = 1.0f / sqrtf(ss * (1.0f / 128.0f) + EPS);
#pragma unroll
          for (int e = 0; e < 4; ++e) { const f32x4 g0 = gk[2 * e], g1 = gk[2 * e + 1]; u32x4 o;
              o.x = pk2(bflo(w[e].x) * r3 * g0.x, bfhi(w[e].x) * r3 * g0.y); o.y = pk2(bflo(w[e].y) * r3 * g0.z, bfhi(w[e].y) * r3 * g0.w);
              o.z = pk2(bflo(w[e].z) * r3 * g1.x, bfhi(w[e].z) * r3 * g1.y); o.w = pk2(bflo(w[e].w) * r3 * g1.z, bfhi(w[e].w) * r3 * g1.w);
              *(u32x4*)(kf_ + kp * 32 + e * 8) = o; }
          asm volatile("s_waitcnt lgkmcnt(0)" ::: "memory");
          const u32x4 k0 = *(const LAS u32x4*)(skr + kp * 16), k1 = *(const LAS u32x4*)(skr + kp * 16 + 8);
          *(u32x4*)(kf_ + 128 + kp * 16) = k0; *(u32x4*)(kf_ + 128 + kp * 16 + 8) = k1; }
        { bf16_t* qp_ = Q + (size_t)m * 3072 + kh * 192;
          u32x4 w[4]; float s1 = 0.f;
#pragma unroll
          for (int e = 0; e < 4; ++e) { w[e] = *(const u32x4*)(qp_ + kp * 32 + e * 8);
              s1 += (bflo(w[e].x) * bflo(w[e].x) + bfhi(w[e].x) * bfhi(w[e].x)) + (bflo(w[e].y) * bflo(w[e].y) + bfhi(w[e].y) * bfhi(w[e].y))
                  + (bflo(w[e].z) * bflo(w[e].z) + bfhi(w[e].z) * bfhi(w[e].z)) + (bflo(w[e].w) * bflo(w[e].w) + bfhi(w[e].w) * bfhi(w[e].w)); }
          const u32x4 ra = *(const u32x4*)(qp_ + 128 + kp * 8), rb = *(const u32x4*)(qp_ + 160 + kp * 8);
          const float xa[8] = {bflo(ra.x), bfhi(ra.x), bflo(ra.y), bfhi(ra.y), bflo(ra.z), bfhi(ra.z), bflo(ra.w), bfhi(ra.w)};
          const float xb[8] = {bflo(rb.x), bfhi(rb.x), bflo(rb.y), bfhi(rb.y), bflo(rb.z), bfhi(rb.z), bflo(rb.w), bfhi(rb.w)};
          float s2 = 0.f;
#pragma unroll
          for (int e = 0; e < 8; ++e) s2 += xa[e] * xa[e] + xb[e] * xb[e];
          s1 += __shfl_xor(s1, 1); s1 += __shfl_xor(s1, 2); s2 += __shfl_xor(s2, 1); s2 += __shfl_xor(s2, 2);
          const float r1 = QS / sqrtf(s1 * (1.0f / 128.0f) + EPS), r2 = QS / sqrtf(s2 * (1.0f / 64.0f) + EPS);
#pragma unroll
          for (int e = 0; e < 4; ++e) { const f32x4 g0 = gq[2 * e], g1 = gq[2 * e + 1]; u32x4 o;
              o.x = pk2(bflo(w[e].x) * r1 * g0.x, bfhi(w[e].x) * r1 * g0.y); o.y = pk2(bflo(w[e].y) * r1 * g0.z, bfhi(w[e].y) * r1 * g0.w);
              o.z = pk2(bflo(w[e].z) * r1 * g1.x, bfhi(w[e].z) * r1 * g1.y); o.w = pk2(bflo(w[e].w) * r1 * g1.z, bfhi(w[e].w) * r1 * g1.w);
              *(u32x4*)(qp_ + kp * 32 + e * 8) = o; }
          const f32x4 c0 = *(const LAS f32x4*)(scs + kp * 8), c1 = *(const LAS f32x4*)(scs + kp * 8 + 4), n0 = *(const LAS f32x4*)(scs + 32 + kp * 8), n1 = *(const LAS f32x4*)(scs + 32 + kp * 8 + 4);
          const float cc[8] = {c0.x, c0.y, c0.z, c0.w, c1.x, c1.y, c1.z, c1.w}, nn[8] = {n0.x, n0.y, n0.z, n0.w, n1.x, n1.y, n1.z, n1.w};
          const float ga[8] = {gra[0].x, gra[0].y, gra[0].z, gra[0].w, gra[1].x, gra[1].y, gra[1].z, gra[1].w}, gb[8] = {grb[0].x, grb[0].y, grb[0].z, grb[0].w, grb[1].x, grb[1].y, grb[1].z, grb[1].w};
          float oa[8], ob[8];
#pragma unroll
          for (int e = 0; e < 8; ++e) { const float x1 = xa[e] * r2 * ga[e], x2 = xb[e] * r2 * gb[e]; oa[e] = x1 * cc[e] - x2 * nn[e]; ob[e] = x2 * cc[e] + x1 * nn[e]; }
          u32x4 o1, o2;
          o1.x = pk2(oa[0], oa[1]); o1.y = pk2(oa[2], oa[3]); o1.z = pk2(oa[4], oa[5]); o1.w = pk2(oa[6], oa[7]);
          o2.x = pk2(ob[0], ob[1]); o2.y = pk2(ob[2], ob[3]); o2.z = pk2(ob[4], ob[5]); o2.w = pk2(ob[6], ob[7]);
          *(u32x4*)(qp_ + 128 + kp * 8) = o1; *(u32x4*)(qp_ + 160 + kp * 8) = o2; }
    }
}

namespace att {
constexpr int SHM_V = 16384, SHM_K = 24576, OFF_V = 0, OFF_K = 3 * SHM_V, OFF_WS = OFF_K + 3 * SHM_K;
#define SBAR() __builtin_amdgcn_sched_barrier(0)
__device__ __forceinline__ int v_st(int k, int c) { const int kk = (k & ~0xC) | ((k & 4) << 1) | ((k & 8) >> 1); return ((kk >> 3) * 4 + (c >> 5)) * 512 + ((kk & 7) * 32 + (c & 31)) * 2; }
__device__ __forceinline__ int v_rd_base(int lane) { return ((lane & 3) << 3) | (((lane >> 2) & 3) << 6) | (((lane >> 4) & 1) << 5) | (((lane >> 5) & 1) << 8); }
constexpr int v_rd_off(int d0, int ks, int half) { return d0 * 512 + ks * 4096 + half * 2048; }
__device__ __forceinline__ int crow(int r, int hi) { return (r & 3) + 8 * (r >> 2) + 4 * hi; }
__device__ __forceinline__ unsigned cvtpk(float lo, float hi) { unsigned r; asm volatile("v_cvt_pk_bf16_f32 %0, %1, %2" : "=v"(r) : "v"(lo), "v"(hi)); return r; }
__device__ __forceinline__ void mask_tile(f32x16& p0, f32x16& p1, int dq) {
    const float NEG = -__builtin_inff();
#pragma unroll
    for (int r = 0; r < 16; ++r) { const int c = (r & 3) + 8 * (r >> 2);
        if (dq - c < 0) p0[r] = NEG;
        if (dq - c - 32 < 0) p1[r] = NEG; }
}
__device__ __forceinline__ void partialSM(f32x16& p0, f32x16& p1, float& m_reg, float& alpha) {
    float pmax = p0[0];
#pragma unroll
    for (int r = 1; r < 16; ++r) pmax = fmaxf(pmax, p0[r]);
#pragma unroll
    for (int r = 0; r < 16; ++r) pmax = fmaxf(pmax, p1[r]);
    { auto rr = __builtin_amdgcn_permlane32_swap(__float_as_uint(pmax), __float_as_uint(pmax), false, false);
      pmax = fmaxf(__uint_as_float(rr[0]), __uint_as_float(rr[1])); }
    float mn;
    if (__builtin_expect(__all(pmax - m_reg <= 8.0f), 1)) { mn = m_reg; alpha = 1.f; }
    else { mn = fmaxf(m_reg, pmax); alpha = __builtin_amdgcn_exp2f(m_reg - mn); m_reg = mn; }
#pragma unroll
    for (int r = 0; r < 16; ++r) p0[r] = __builtin_amdgcn_exp2f(p0[r] - mn);
#pragma unroll
    for (int r = 0; r < 16; ++r) p1[r] = __builtin_amdgcn_exp2f(p1[r] - mn);
}
__device__ __forceinline__ void finishSM(f32x16& p0, f32x16& p1, float alpha, float& l_reg, bf16x8& pa0, bf16x8& pa1, bf16x8& pa2, bf16x8& pa3) {
    float ps = 0;
#pragma unroll
    for (int r = 0; r < 16; ++r) ps += p0[r];
#pragma unroll
    for (int r = 0; r < 16; ++r) ps += p1[r];
    { auto rr = __builtin_amdgcn_permlane32_swap(__float_as_uint(ps), __float_as_uint(ps), false, false);
      ps = __uint_as_float(rr[0]) + __uint_as_float(rr[1]); }
    l_reg = l_reg * alpha + ps;
#define PK4(P, B_, OUT) do { unsigned a0 = cvtpk(P[B_+0], P[B_+1]), a1 = cvtpk(P[B_+2], P[B_+3]);                          \
        unsigned b0 = cvtpk(P[B_+4], P[B_+5]), b1 = cvtpk(P[B_+6], P[B_+7]);                                             \
        auto r0 = __builtin_amdgcn_permlane32_swap(a0, b0, false, false); auto r1 = __builtin_amdgcn_permlane32_swap(a1, b1, false, false); \
        u32x4 w = {r0[0], r1[0], r0[1], r1[1]}; OUT = *reinterpret_cast<bf16x8*>(&w); } while (0)
    PK4(p0, 0, pa0); PK4(p0, 8, pa1); PK4(p1, 0, pa2); PK4(p1, 8, pa3);
#undef PK4
}
__device__ __forceinline__ int kswz(int row, int colB) { return row * 384 + (colB ^ (((row >> 1) & 7) << 4)); }
__device__ __forceinline__ void qkt(f32x16& p0, f32x16& p1, const LAS unsigned char* Kb, int r32, int hi, const bf16x8* qr) {
    p0 = f32x16{}; p1 = f32x16{};
    const LAS unsigned char* kb[4];
#pragma unroll
    for (int dd = 0; dd < 4; ++dd) kb[dd] = Kb + kswz(r32, dd * 32 + hi * 16);
#pragma unroll
    for (int d0 = 0; d0 < 12; ++d0) { const LAS unsigned char* a = kb[d0 & 3] + (d0 >> 2) * 128;
        const bf16x8 b0 = *(const LAS bf16x8*)a;
        const bf16x8 b1 = *(const LAS bf16x8*)(a + 32 * 384);
        p0 = __builtin_amdgcn_mfma_f32_32x32x16_bf16(b0, qr[d0], p0, 0, 0, 0);
        p1 = __builtin_amdgcn_mfma_f32_32x32x16_bf16(b1, qr[d0], p1, 0, 0, 0); }
}
__device__ __forceinline__ void pv_tile(f32x16* o, int vb0, bf16x8 pa0, bf16x8 pa1, bf16x8 pa2, bf16x8 pa3) {
#define TRRD(dst, off) asm volatile("ds_read_b64_tr_b16 %0, %1 offset:%2" : "=&v"(dst) : "v"(vb0), "i"(off) : "memory")
#define RD8(S, d0) do { constexpr int b_ = v_rd_off(d0, 0, 0); TRRD(S##l0, b_); TRRD(S##h0, b_ + 2048); TRRD(S##l1, b_ + 4096); TRRD(S##h1, b_ + 6144); \
        TRRD(S##l2, b_ + 8192); TRRD(S##h2, b_ + 10240); TRRD(S##l3, b_ + 12288); TRRD(S##h3, b_ + 14336); } while (0)
#define MM4(S, d0) do { \
        o[d0] = __builtin_amdgcn_mfma_f32_32x32x16_bf16(pa0, (bf16x8){S##l0[0], S##l0[1], S##l0[2], S##l0[3], S##h0[0], S##h0[1], S##h0[2], S##h0[3]}, o[d0], 0, 0, 0); \
        o[d0] = __builtin_amdgcn_mfma_f32_32x32x16_bf16(pa1, (bf16x8){S##l1[0], S##l1[1], S##l1[2], S##l1[3], S##h1[0], S##h1[1], S##h1[2], S##h1[3]}, o[d0], 0, 0, 0); \
        o[d0] = __builtin_amdgcn_mfma_f32_32x32x16_bf16(pa2, (bf16x8){S##l2[0], S##l2[1], S##l2[2], S##l2[3], S##h2[0], S##h2[1], S##h2[2], S##h2[3]}, o[d0], 0, 0, 0); \
        o[d0] = __builtin_amdgcn_mfma_f32_32x32x16_bf16(pa3, (bf16x8){S##l3[0], S##l3[1], S##l3[2], S##l3[3], S##h3[0], S##h3[1], S##h3[2], S##h3[3]}, o[d0], 0, 0, 0); } while (0)
#define WAITL(n) do { asm volatile("s_waitcnt lgkmcnt(" #n ")" ::: "memory"); SBAR(); } while (0)
    s16x4 Al0, Al1, Al2, Al3, Ah0, Ah1, Ah2, Ah3, Bl0, Bl1, Bl2, Bl3, Bh0, Bh1, Bh2, Bh3;
    RD8(A, 0); RD8(B, 1); SBAR();
    WAITL(8); MM4(A, 0); SBAR();
    RD8(A, 2); SBAR();
    WAITL(8); MM4(B, 1); SBAR();
    RD8(B, 3); SBAR();
    WAITL(8); MM4(A, 2); SBAR();
    WAITL(0); MM4(B, 3);
#undef WAITL
#undef MM4
#undef RD8
#undef TRRD
}
__device__ __forceinline__ void attn_unit(unsigned char* ldsg, const bf16_t* QF, const bf16_t* KF, const bf16_t* KVRAW, bf16_t* O, int h, int qb, int tid) {
    asm volatile("" : "+v"(tid));
    LAS unsigned char* lds = (LAS unsigned char*)ldsg;
    const int wid = __builtin_amdgcn_readfirstlane(tid >> 6), lane = tid & 63, r32 = lane & 31, hi = lane >> 5;
    const int q0 = qb * 256, NT = 4 * (qb + 1);
    const int qlo = q0 + wid * 32, qm = qlo + r32 - 4 * hi;
    LAS float* ws = (LAS float*)(lds + OFF_WS) + wid * 64; LAS float* li_l = ws; LAS float* al_l = ws + 32;
    const int sr = tid >> 4, sc = (tid & 15) * 8, vst0 = v_st(sr, sc), vst1 = v_st(32 + sr, sc);
    int kkey[3], kch[3], kls[3];
#pragma unroll
    for (int i = 0; i < 3; ++i) { const int cid = tid + 512 * i; kkey[i] = cid / 24; kch[i] = cid - kkey[i] * 24; kls[i] = kswz(kkey[i], kch[i] * 16); }
    const bf16_t* Kh = KF + h * 192; const bf16_t* Vh = KVRAW + h * 256 + 128;
    const int vb_base = (int)(unsigned)(uintptr_t)(ldsg + OFF_V) + v_rd_base(lane);
    bf16x8 qr[12];
#pragma unroll
    for (int d0 = 0; d0 < 12; ++d0) qr[d0] = *(const bf16x8*)(QF + (size_t)(qlo + r32) * 3072 + h * 192 + d0 * 16 + hi * 8);
    bf16x8 stK[3], stV[2];
#define ALOAD(kb_) do { _Pragma("unroll") for (int i = 0; i < 3; ++i) stK[i] = *(const bf16x8*)(Kh + (size_t)((kb_) + kkey[i]) * 3072 + kch[i] * 8); \
        stV[0] = *(const bf16x8*)(Vh + (size_t)((kb_) + sr) * 4096 + sc); stV[1] = *(const bf16x8*)(Vh + (size_t)((kb_) + 32 + sr) * 4096 + sc); } while (0)
#define AWRITE(bf) do { _Pragma("unroll") for (int i = 0; i < 3; ++i) *(LAS bf16x8*)(lds + OFF_K + (bf) * SHM_K + kls[i]) = stK[i]; \
        *(LAS bf16x8*)(lds + OFF_V + (bf) * SHM_V + vst0) = stV[0]; *(LAS bf16x8*)(lds + OFF_V + (bf) * SHM_V + vst1) = stV[1]; } while (0)
    ALOAD(0); AWRITE(0);
    ALOAD(64);
    __syncthreads();
    float m_reg = -1e30f, l_reg = 0.f; f32x16 o[4];
#pragma unroll
    for (int d = 0; d < 4; ++d) o[d] = f32x16{};
    int sj = 0, sn = 1;
    for (int j = 0; j < NT; ++j) {
        const int kb = j * 64;
        if (j + 1 < NT) { AWRITE(sn); if (j + 2 < NT) ALOAD(kb + 128); }
        if (kb <= qlo + 31) {
            f32x16 p0, p1; float alpha; bf16x8 pa0, pa1, pa2, pa3;
            qkt(p0, p1, lds + OFF_K + sj * SHM_K, r32, hi, qr);
            if (kb + 63 > qlo) mask_tile(p0, p1, qm - kb);
            partialSM(p0, p1, m_reg, alpha);
            finishSM(p0, p1, alpha, l_reg, pa0, pa1, pa2, pa3);
            if (__any(alpha < 1.f)) { if (hi == 0) al_l[r32] = alpha; asm volatile("s_waitcnt lgkmcnt(0)" ::: "memory");
#pragma unroll
                for (int d_ = 0; d_ < 4; ++d_)
#pragma unroll
                    for (int r = 0; r < 16; ++r) o[d_][r] *= al_l[crow(r, hi)]; }
            SBAR();
            pv_tile(o, vb_base + sj * SHM_V, pa0, pa1, pa2, pa3);
        }
        sj = sn; sn = (sn == 2) ? 0 : sn + 1;
        __syncthreads();
    }
#undef ALOAD
#undef AWRITE
    if (hi == 0) li_l[r32] = l_reg; asm volatile("s_waitcnt lgkmcnt(0)" ::: "memory");
    float rli[16];
#pragma unroll
    for (int r = 0; r < 16; ++r) rli[r] = 1.0f / li_l[crow(r, hi)];
    bf16_t* Ow = O + (size_t)qlo * 2048 + h * 128;
#pragma unroll
    for (int r = 0; r < 16; ++r) { const int orow = crow(r, hi);
#pragma unroll
        for (int d0 = 0; d0 < 4; ++d0) { const float v = o[d0][r] * rli[r]; const float vn = __shfl_xor(v, 1);
            if ((r32 & 1) == 0) *(unsigned*)(Ow + (size_t)orow * 2048 + d0 * 32 + r32) = cvtpk(v, vn); } }
    __syncthreads();
}
#undef SBAR
}


#define XB_TMO      128
#define XB_XCNT(j)  (256  + 64 * (j))
#define XB_XSUB(j)  (1280 + 64 * (j))
#define XB_XGEN(j)  (2304 + 64 * (j))
#define XB_TOP      3328
#define XB_TOPGEN   3392
#define XCD_BAR_WORDS 3456
#define XB_SPIN_CAP (1u << 22)
__device__ __forceinline__ unsigned xb_ld(unsigned* p)              { return __hip_atomic_load(p, __ATOMIC_RELAXED, __HIP_MEMORY_SCOPE_AGENT); }
__device__ __forceinline__ unsigned xb_add(unsigned* p, unsigned v) { return __hip_atomic_fetch_add(p, v, __ATOMIC_RELAXED, __HIP_MEMORY_SCOPE_AGENT); }
__device__ __forceinline__ unsigned xb_xcc_id() { return (unsigned)__builtin_amdgcn_s_getreg((3 << 11) | 20) & 0xFu; }
#define XB_SPIN(cond, bar) do { unsigned _sp = 0; while (cond) { __builtin_amdgcn_s_sleep(1); \
    if ((++_sp & 255u) == 0u) { if (xb_ld(&(bar)[XB_TMO])) break; if (_sp > XB_SPIN_CAP) { atomicAdd(&(bar)[XB_TMO], 1u); break; } } } } while (0)
struct XcdBarrier { unsigned* bar; unsigned x; volatile LAS unsigned* st; };
__device__ __forceinline__ XcdBarrier xcd_barrier_post(unsigned* bar, volatile LAS unsigned* st) {
    XcdBarrier b; b.bar = bar; b.x = xb_xcc_id(); b.st = st;
    if (threadIdx.x == 0) (void)xb_add(&bar[XB_XCNT(b.x)], 1u);
    return b;
}
__device__ __forceinline__ void xcd_barrier_complete(unsigned* bar, unsigned x, unsigned& nloc, unsigned& nx) {
    const unsigned G = gridDim.x * gridDim.y * gridDim.z;
    unsigned sum, cnt, mine, sp = 0u;
    for (;;) {
        sum = 0u; cnt = 0u; mine = 0u;
#pragma unroll
        for (unsigned j = 0; j < 16; ++j) { const unsigned c = xb_ld(&bar[XB_XCNT(j)]); sum += c; cnt += (c > 0u) ? 1u : 0u; mine = (j == x) ? c : mine; }
        if (sum == G) break;
        __builtin_amdgcn_s_sleep(1);
        if ((++sp & 255u) == 0u) { if (xb_ld(&bar[XB_TMO])) break; if (sp > XB_SPIN_CAP) { atomicAdd(&bar[XB_TMO], 1u); break; } }
    }
    nloc = mine > 0u ? mine : 1u; nx = cnt > 0u ? cnt : 1u;
}
__device__ __forceinline__ void xcd_barrier(const XcdBarrier& b) {
    asm volatile("s_waitcnt vmcnt(0)" ::: "memory");
    __syncthreads();
    if (threadIdx.x == 0) {
        unsigned* bar = b.bar;
        __builtin_amdgcn_s_waitcnt(0);
        unsigned nloc = b.st[0], nx = b.st[1];
        if (nloc == 0u) { xcd_barrier_complete(bar, b.x, nloc, nx); b.st[0] = nloc; b.st[1] = nx; }
        const unsigned old = xb_add(&bar[XB_XSUB(b.x)], 1u);
        const unsigned gen = old / nloc;
        if (old + 1u == (gen + 1u) * nloc) {
            __builtin_amdgcn_fence(__ATOMIC_RELEASE, "agent");
            asm volatile("s_waitcnt vmcnt(0)" ::: "memory");
            const unsigned og = xb_add(&bar[XB_TOP], 1u);
            const unsigned tg = og / nx;
            if (og + 1u == (tg + 1u) * nx) xb_add(&bar[XB_TOPGEN], 1u);
            else XB_SPIN(xb_ld(&bar[XB_TOPGEN]) == tg, bar);
            __builtin_amdgcn_fence(__ATOMIC_ACQUIRE, "agent");
            xb_add(&bar[XB_XGEN(b.x)], 1u);
            asm volatile("s_waitcnt vmcnt(0)" ::: "memory");
        } else {
            XB_SPIN(xb_ld(&bar[XB_XGEN(b.x)]) == gen, bar);
            __builtin_amdgcn_fence(__ATOMIC_ACQUIRE, "agent");
            asm volatile("s_waitcnt vmcnt(0)" ::: "memory");
        }
    }
    __syncthreads();
}

constexpr size_t MiB = (size_t)1 << 20;
constexpr size_t OFF_XN = 1 * MiB;
constexpr size_t OFF_XB = OFF_XN + 64 * MiB;
constexpr size_t OFF_WGU = OFF_XB + 64 * MiB;
constexpr size_t OFF_WD = OFF_WGU + 44 * MiB;
constexpr size_t OFF_WMIA = OFF_WD + 22 * MiB;
constexpr size_t OFF_WMIB = OFF_WMIA + 17 * MiB;
constexpr size_t OFF_WMO = OFF_WMIB + 12 * MiB;
constexpr size_t OFF_WAI = OFF_WMO + 8 * MiB;
constexpr size_t OFF_WUQ = OFF_WAI + 5 * MiB;
constexpr size_t OFF_WUKV = OFF_WUQ + 3 * MiB;
constexpr size_t OFF_WAO = OFF_WUKV + 4 * MiB;
constexpr size_t OFF_BIG = OFF_WAO + 8 * MiB;
constexpr size_t OFF_H = OFF_BIG;
constexpr size_t OFF_WGU2 = OFF_BIG + 180 * MiB;
constexpr size_t OFF_WD2 = OFF_WGU2 + 44 * MiB;
constexpr size_t OFF_SSQ = 131072;
constexpr size_t OFF_QKO = OFF_BIG;
constexpr size_t OFF_KVT = OFF_QKO + 128 * MiB;
constexpr size_t OFF_DC = OFF_KVT + 96 * MiB;
constexpr size_t OFF_DN = OFF_DC + 256 * MiB;
constexpr size_t OFF_G = OFF_DN + 1 * MiB;
constexpr size_t OFF_SC = OFF_G + 1 * MiB;
constexpr size_t OFF_MS = OFF_SC + 65536;
constexpr size_t END_MLSTM = OFF_MS + 65536;
constexpr size_t OFF_C = OFF_BIG;
constexpr size_t OFF_KF = OFF_C;
constexpr size_t OFF_CQN = OFF_KF + 96 * MiB;
constexpr size_t OFF_CKVN = OFF_CQN + 16 * MiB;
constexpr size_t OFF_Q = OFF_CKVN + 16 * MiB;
constexpr size_t OFF_KVRAW = OFF_Q + 96 * MiB;
constexpr size_t OFF_KR = OFF_KVRAW + 128 * MiB;
constexpr size_t END_MLA = OFF_KR + 4 * MiB;
constexpr size_t WS_NEED = END_MLA > END_MLSTM ? END_MLA : END_MLSTM;

struct Args {
    const float* x; const int* pos;
    const float* ffn1_norm; const float* ffn1_wgu; const float* ffn1_wd; const float* mix_norm; const float* ffn2_norm; const float* ffn2_wgu; const float* ffn2_wd;
    const float* ml_win; const float* ml_gb; const float* ml_hn; const float* ml_wout;
    const float* mla_win; const float* mla_qn; const float* mla_kvn; const float* mla_wuq; const float* mla_wukv; const float* mla_qkn; const float* mla_wout;
    float* out; unsigned char* ws;
};

__global__ void __launch_bounds__(NWAVES * 64, 2) mega_fwd(Args a) {
    extern __shared__ __attribute__((aligned(16))) unsigned char lds_g[];
    cg::grid_group grid = cg::this_grid();
    LAS unsigned char* lds = (LAS unsigned char*)lds_g;
    const int tid = threadIdx.x;
    const int G = gridDim.x, bid = blockIdx.x;
    const int vcu = (G % 8 == 0) ? (bid % 8) * (G / 8) + bid / 8 : bid;
    volatile LAS unsigned* bst = (volatile LAS unsigned*)(lds + LDS_BYTES - 64);
    if (tid < 16) bst[tid] = 0u;
    __syncthreads();
    XcdBarrier xbar = xcd_barrier_post((unsigned*)a.ws + 4096, bst);
#define GSYNC() xcd_barrier(xbar)
    unsigned char* ws = a.ws;
    bf16_t* XN = (bf16_t*)(ws + OFF_XN);
    bf16_t* WGU = (bf16_t*)(ws + OFF_WGU); bf16_t* WD = (bf16_t*)(ws + OFF_WD);
    bf16_t* WMIA = (bf16_t*)(ws + OFF_WMIA); bf16_t* WMIB = (bf16_t*)(ws + OFF_WMIB); bf16_t* WMO = (bf16_t*)(ws + OFF_WMO);
    bf16_t* WAI = (bf16_t*)(ws + OFF_WAI); bf16_t* WUQ = (bf16_t*)(ws + OFF_WUQ); bf16_t* WUKV = (bf16_t*)(ws + OFF_WUKV); bf16_t* WAO = (bf16_t*)(ws + OFF_WAO);
    bf16_t* Hb = (bf16_t*)(ws + OFF_H);
    bf16_t* QKO = (bf16_t*)(ws + OFF_QKO); bf16_t* KVT = (bf16_t*)(ws + OFF_KVT); bf16_t* DC = (bf16_t*)(ws + OFF_DC);
    float* DN = (float*)(ws + OFF_DN); float* Gt = (float*)(ws + OFF_G); float* SC = (float*)(ws + OFF_SC); float* MS = (float*)(ws + OFF_MS);
    float* Cb = (float*)(ws + OFF_C); bf16_t* KF = (bf16_t*)(ws + OFF_KF); bf16_t* CQN = (bf16_t*)(ws + OFF_CQN); bf16_t* CKVN = (bf16_t*)(ws + OFF_CKVN);
    bf16_t* Qb = (bf16_t*)(ws + OFF_Q); bf16_t* KVRAW = (bf16_t*)(ws + OFF_KVRAW); float* KR = (float*)(ws + OFF_KR);

    bf16_t* XB = (bf16_t*)(ws + OFF_XB); bf16_t* WGU2 = (bf16_t*)(ws + OFF_WGU2); bf16_t* WD2 = (bf16_t*)(ws + OFF_WD2);
    float* SSQ = (float*)(ws + OFF_SSQ);
#define SSQ_(i) (SSQ + (size_t)(i) * M)
#define CONV_FFN(wgu_, wd_, norm_, layer, WGU_, WD_) do { for (int rep_ = 0; rep_ < REP_CONV; ++rep_) { \
        conv_matrix((wgu_) + (size_t)(layer) * D * 2 * FF, D, 2 * FF, 0, 2 * FF, (WGU_), 0, 1, (norm_) + (layer) * D, lds); \
        conv_matrix((wd_) + (size_t)(layer) * FF * D, FF, D, 0, D, (WD_), 0, 0, nullptr, lds); } \
        __syncthreads();   } while (0)
#define GEMM_GU(WGU_, ssq_) do { for (int rep_ = 0; rep_ < REP_GU; ++rep_) { pg8::Gemm g{XB, (WGU_), M, 2 * FF, D}; pg8::StaticOrder S; S.init(M, 2 * FF, G, bid); pg8::EpiSwiGLU E{Hb, (ssq_)}; pg8::gemm_phase<pg8::EpiSwiGLU>(lds, g, S, E); } } while (0)
#define GEMM_DOWN(WD_, basef_, out_, xb_, ssqo_) do { pg8::Gemm g{Hb, (WD_), M, D, FF}; pg8::StaticOrder S; S.init(M, D, G, bid, 0, 4); pg8::EpiRes E{XB, (basef_), (out_), D, 0.5f, (xb_), (ssqo_)}; pg8::gemm_phase<pg8::EpiRes>(lds, g, S, E); } while (0)

    CONV_FFN(a.ffn1_wgu, a.ffn1_wd, a.ffn1_norm, 0, WGU, WD);
    conv_matrix(a.ml_win, D, 6152, 0, 2048, WMIA, 0, 0, a.mix_norm, lds);
    conv_matrix(a.ml_win, D, 6152, 4096, 2048, WMIA, 2048, 0, a.mix_norm, lds);
    conv_matrix(a.ml_win, D, 6152, 2048, 2048, WMIB, 0, 0, a.mix_norm, lds);
    { const int gt = bid * 512 + opaque_tid(), ngt = G * 512;
      for (int i = gt; i < 8 * D; i += ngt) { const int k = i >> 3, j = i & 7; WMIA[(size_t)(4096 + j) * D + k] = (bf16_t)f2bf(a.ml_win[(size_t)k * 6152 + 6144 + j] * a.mix_norm[k]); }
      u32x4 z = {0u, 0u, 0u, 0u};
      for (int i = gt; i < 248 * D / 8; i += ngt) *(u32x4*)(WMIA + (size_t)4104 * D + (size_t)i * 8) = z;
      for (int i = gt; i < 192 * D / 8; i += ngt) *(u32x4*)(WAI + (size_t)1088 * D + (size_t)i * 8) = z;
      for (int i = gt; i < 7 * M / 4; i += ngt) *(u32x4*)(SSQ_(1) + (size_t)i * 4) = z; }
    conv_matrix(a.ml_wout, D, D, 0, D, WMO, 0, 0, nullptr, lds);
    conv_matrix(a.mla_win, D, 1088, 0, 1088, WAI, 0, 0, a.mix_norm + D, lds);
    conv_matrix(a.mla_wuq, 512, 3072, 0, 3072, WUQ, 0, 0, a.mla_qn, lds);
    conv_matrix(a.mla_wukv, 512, 4096, 0, 4096, WUKV, 0, 0, a.mla_kvn, lds);
    conv_matrix(a.mla_wout, D, D, 0, D, WAO, 0, 0, nullptr, lds);
    cast_rows_ssq(a.x, XB, SSQ_(0));
    if (a.ws == nullptr) grid.sync();
    GSYNC();

    GEMM_GU(WGU, SSQ_(0)); GSYNC();
    GEMM_DOWN(WD, a.x, nullptr, XB, SSQ_(1)); GSYNC();
    CONV_FFN(a.ffn2_wgu, a.ffn2_wd, a.ffn2_norm, 0, WGU, WD);
    for (int rep_ = 0; rep_ < REP_OTHER; ++rep_) { pg8::Gemm g{XB, WMIA, M, 4352, D}; pg8::StaticOrder S; S.init(M, 4352, G, bid); pg8::EpiMlstmIn E{QKO, Gt, SSQ_(1)}; pg8::gemm_phase<pg8::EpiMlstmIn>(lds, g, S, E); }
    for (int rep_ = 0; rep_ < REP_OTHER; ++rep_) { pg8::Gemm g{WMIB, XB, 2048, M, D}; pg8::StaticOrder S; S.init(2048, M, G, bid); pg8::EpiBf16 E{KVT, M, SSQ_(1), nullptr}; pg8::gemm_phase<pg8::EpiBf16>(lds, g, S, E); }
    GSYNC();
    mlstm_stage_a(lds, QKO, KVT, Gt, a.ml_gb, DC, DN, SC, bid, G, tid);
    GSYNC();
    mlstm_stage_b(DC, DN, SC, MS, bid, G, tid);
    GSYNC();
    mlstm_stage_c(lds, QKO, KVT, Gt, a.ml_gb, DC, DN, MS, a.ml_hn, XN, bid, G, tid);
    GSYNC();
    { pg8::Gemm g{XN, WMO, M, D, D}; pg8::StaticOrder S; S.init(M, D, G, bid); pg8::EpiRes E{XB, nullptr, nullptr, D, 1.0f, XB, SSQ_(2)}; pg8::gemm_phase<pg8::EpiRes>(lds, g, S, E); }
    GSYNC();
    CONV_FFN(a.ffn1_wgu, a.ffn1_wd, a.ffn1_norm, 1, WGU2, WD2);
    GEMM_GU(WGU, SSQ_(2)); GSYNC();
    GEMM_DOWN(WD, nullptr, nullptr, XB, SSQ_(3)); GSYNC();

    GEMM_GU(WGU2, SSQ_(3)); GSYNC();
    GEMM_DOWN(WD2, nullptr, nullptr, XB, SSQ_(4)); GSYNC();
    CONV_FFN(a.ffn2_wgu, a.ffn2_wd, a.ffn2_norm, 1, WGU, WD);
    { pg8::Gemm g{XB, WAI, M, 1280, D}; pg8::StaticOrder S; S.init(M, 1280, G, bid); pg8::EpiMlaIn E{CQN, CKVN, KR, SSQ_(4), SSQ_(6), SSQ_(7)}; pg8::gemm_phase<pg8::EpiMlaIn>(lds, g, S, E); }
    GSYNC();
    for (int rep_ = 0; rep_ < REP_OTHER; ++rep_) { pg8::Gemm g{CQN, WUQ, M, 3072, 512}; pg8::StaticOrder S; S.init(M, 3072, G, bid); pg8::EpiBf16 E{Qb, 3072, nullptr, SSQ_(6)}; pg8::gemm_phase<pg8::EpiBf16>(lds, g, S, E); }
    for (int rep_ = 0; rep_ < REP_OTHER; ++rep_) { pg8::Gemm g{CKVN, WUKV, M, 4096, 512}; pg8::StaticOrder S; S.init(M, 4096, G, bid); pg8::EpiBf16 E{KVRAW, 4096, nullptr, SSQ_(7)}; pg8::gemm_phase<pg8::EpiBf16>(lds, g, S, E); }
    GSYNC();
    mla_qk_norm_rope(Qb, KVRAW, KR, a.pos, a.mla_qkn, KF, lds);
    GSYNC();
    for (int rep = 0; rep < REP_ATT; ++rep)
    for (int it = vcu; it < 256; it += G) {
        const int h = it >> 4, s = it & 15;
        for (int k = 0; k < 4; ++k) { const int qb = (k == 0) ? 63 - s : (k == 1) ? 32 + s : (k == 2) ? 31 - s : s; att::attn_unit(lds_g, Qb, KF, KVRAW, XN, h, qb, tid); }
    }
    GSYNC();
    { pg8::Gemm g{XN, WAO, M, D, D}; pg8::StaticOrder S; S.init(M, D, G, bid); pg8::EpiRes E{XB, nullptr, nullptr, D, 1.0f, XB, SSQ_(5)}; pg8::gemm_phase<pg8::EpiRes>(lds, g, S, E); }
    GSYNC();
    GEMM_GU(WGU, SSQ_(5)); GSYNC();
    GEMM_DOWN(WD, nullptr, a.out, nullptr, nullptr);
#undef CONV_FFN
#undef GEMM_GU
#undef GEMM_DOWN
#undef SSQ_
}

extern "C" void kernel_launch(void* const* d_in, const int* in_sizes, int n_in, void* d_out, int out_size, void* d_ws, size_t ws_size, hipStream_t stream) {
    static int grid_blocks = 0;
    if (grid_blocks == 0) {
        if (n_in != 20 || in_sizes[0] != M * D || out_size != M * D || ws_size < WS_NEED) {
            fprintf(stderr, "kernel_launch: unexpected shapes (n_in %d, in0 %d, out %d, ws %zu, need %zu)\n", n_in, n_in > 0 ? in_sizes[0] : -1, out_size, ws_size, (size_t)WS_NEED);
            grid_blocks = -1; return; }
        int dev = 0, cus = 0, per_cu = 0;
        hipGetDevice(&dev);
        hipDeviceGetAttribute(&cus, hipDeviceAttributeMultiprocessorCount, dev);
        hipFuncSetAttribute((const void*)mega_fwd, hipFuncAttributeMaxDynamicSharedMemorySize, LDS_BYTES);
        hipOccupancyMaxActiveBlocksPerMultiprocessor(&per_cu, (const void*)mega_fwd, NWAVES * 64, LDS_BYTES);
        if (per_cu < 1) per_cu = 1;
        grid_blocks = cus * per_cu;
        if (grid_blocks > 256) grid_blocks = 256;
    }
    if (grid_blocks < 0) return;
    Args a{};
    a.x = (const float*)d_in[0]; a.pos = (const int*)d_in[1];
    a.ffn1_norm = (const float*)d_in[2]; a.ffn1_wgu = (const float*)d_in[3]; a.ffn1_wd = (const float*)d_in[4]; a.mix_norm = (const float*)d_in[5];
    a.ffn2_norm = (const float*)d_in[6]; a.ffn2_wgu = (const float*)d_in[7]; a.ffn2_wd = (const float*)d_in[8];
    a.ml_win = (const float*)d_in[9]; a.ml_gb = (const float*)d_in[10]; a.ml_hn = (const float*)d_in[11]; a.ml_wout = (const float*)d_in[12];
    a.mla_win = (const float*)d_in[13]; a.mla_qn = (const float*)d_in[14]; a.mla_kvn = (const float*)d_in[15]; a.mla_wuq = (const float*)d_in[16];
    a.mla_wukv = (const float*)d_in[17]; a.mla_qkn = (const float*)d_in[18]; a.mla_wout = (const float*)d_in[19];
    a.out = (float*)d_out; a.ws = (unsigned char*)d_ws;
    (void)hipMemsetAsync(d_ws, 0, 65536, stream);
    void* args[] = {&a};
    hipError_t e = hipLaunchCooperativeKernel((const void*)mega_fwd, dim3(grid_blocks), dim3(NWAVES * 64), args, LDS_BYTES, stream);
    if (e != hipSuccess) fprintf(stderr, "cooperative launch failed: %s (grid %d)\n", hipGetErrorString(e), grid_blocks);
}
```

```cpp
#include <hip/hip_runtime.h>
#include <hip/hip_cooperative_groups.h>
#include <cstdio>
#include <cstdint>
namespace cg = cooperative_groups;

#define LAS __attribute__((address_space(3)))
typedef unsigned short bf16_t;
typedef short bf16x8 __attribute__((ext_vector_type(8)));
typedef short s16x4 __attribute__((ext_vector_type(4)));
typedef float f32x4 __attribute__((ext_vector_type(4)));
typedef float f32x16 __attribute__((ext_vector_type(16)));
typedef unsigned u32x4 __attribute__((ext_vector_type(4)));
typedef unsigned u32x2 __attribute__((ext_vector_type(2)));

constexpr int M = 16384, D = 2048, FF = 5632;
constexpr float EPS = 1e-6f;
constexpr int NWAVES = 8;
constexpr int LDS_BYTES = 147456;
#ifndef REP_ATT
#define REP_ATT 1
#endif
#define REP_MLSTM 1
#define REP_CONV 1
#define REP_GU 1
#define REP_NORM 1
#define REP_MA 1
#define REP_MC 1
#define REP_DOWN 1
#define REP_OTHER 1

__device__ __forceinline__ unsigned f2bf(float f) { unsigned u = __float_as_uint(f); return (u + 0x7fffu + ((u >> 16) & 1u)) >> 16; }
__device__ __forceinline__ unsigned pk2(float lo, float hi) { return f2bf(lo) | (f2bf(hi) << 16); }
__device__ __forceinline__ float bf2f(unsigned short b) { return __uint_as_float(((unsigned)b) << 16); }
__device__ __forceinline__ float bflo(unsigned w) { return __uint_as_float(w << 16); }
__device__ __forceinline__ float bfhi(unsigned w) { return __uint_as_float(w & 0xffff0000u); }
__device__ __forceinline__ float wave_sum(float v) {
#pragma unroll
    for (int o = 1; o < 64; o <<= 1) v += __shfl_xor(v, o);
    return v;
}
__device__ __forceinline__ float wave_max(float v) {
#pragma unroll
    for (int o = 1; o < 64; o <<= 1) v = fmaxf(v, __shfl_xor(v, o));
    return v;
}
__device__ __forceinline__ int opaque_tid() { int t = threadIdx.x; asm volatile("" : "+v"(t)); return t; }
__device__ __forceinline__ float sigmoidf_(float x) { return 1.0f / (1.0f + __expf(-x)); }

namespace pg8 {
constexpr int BM = 256, BK = 64, HALF = 128, HTB = HALF * BK * 2, STAGE_BYTES = 8 * HTB, NXCD = 8, WGM = 8;
__host__ __device__ __forceinline__ int lds_byte(int r, int c) { const int st = (r >> 4) * 2 + (c >> 5), rr = r & 15, cc = c & 31, ob = rr * 64 + cc * 2; return st * 1024 + (ob ^ (((ob >> 9) & 1) << 5)); }
__host__ __device__ __forceinline__ void stage_rc(int b, int& R, int& C) { const int st = b / 1024, sb = b % 1024, swz = sb ^ (((sb >> 9) & 1) << 5); R = (st >> 1) * 16 + swz / 64; C = (st & 1) * 32 + (swz % 64) / 2; }
__host__ __device__ __forceinline__ int perm32(int rho) { const int n = rho >> 4, i = rho & 15; return 8 * (i >> 2) + 4 * n + (i & 3); }

struct Unit { int pm, pn; };
struct Gemm { const bf16_t* A; const bf16_t* Bt; int M, N, K; };

struct StaticOrder {
    int nM, nN, nwg, G, c, rev, wgm;
    __device__ void init(int M_, int N_, int G_, int c_, int rev_ = 0, int wgm_ = WGM) { nM = M_ / BM; nN = N_ / BM; nwg = nM * nN; G = G_; c = c_; rev = rev_; wgm = wgm_; }
    __device__ bool next(int i, Unit& u) const {
        const long L = (long)i * G + c; if (L >= nwg) return false;
        int wgid = (int)L; { const int q = nwg / NXCD, r = nwg % NXCD, xcd = wgid % NXCD, off = wgid / NXCD; wgid = (xcd < r ? xcd * (q + 1) : r * (q + 1) + (xcd - r) * q) + off; }
        const int nig = wgm * nN, gid = wgid / nig, fm = gid * wgm, gsz = (nM - fm) < wgm ? (nM - fm) : wgm;
        u.pm = fm + ((wgid % nig) % gsz); u.pn = (wgid % nig) / gsz; if (rev) u.pm = nM - 1 - u.pm; return true;
    }
};

__device__ __forceinline__ unsigned cvt_pk_bf16(float lo, float hi) { unsigned r; asm volatile("v_cvt_pk_bf16_f32 %0, %1, %2" : "=v"(r) : "v"(lo), "v"(hi)); return r; }

__device__ __forceinline__ float rstd_of(float ssq) { return __builtin_amdgcn_rsqf(ssq * (1.0f / 2048.0f) + 1e-6f); }
struct EpiBf16 {
    static constexpr bool PERM = true;
    bf16_t* O; int ldc; const float* cssq; const float* rssq512;
    __device__ __forceinline__ void operator()(const f32x4 (&acc)[2][2][4][2], const Unit& u, int wr, int wc, int fr, int fq) const {
        const int row0 = u.pm * BM + wr * 64 + fr; const int col0 = u.pn * BM + wc * 32 + 8 * fq;
        f32x4 cs[2][2];
#pragma unroll
        for (int bj = 0; bj < 2; ++bj)
#pragma unroll
            for (int n = 0; n < 2; ++n) { if (cssq) { const f32x4 q = *(const f32x4*)(cssq + col0 + bj * HALF + 4 * n); cs[bj][n] = (f32x4){rstd_of(q.x), rstd_of(q.y), rstd_of(q.z), rstd_of(q.w)}; } else cs[bj][n] = (f32x4){1.f, 1.f, 1.f, 1.f}; }
#pragma unroll
        for (int ai = 0; ai < 2; ++ai)
#pragma unroll
            for (int m = 0; m < 4; ++m) { const int row = row0 + ai * HALF + m * 16; bf16_t* rowp = O + (size_t)row * ldc + col0;
                const float rs = rssq512 ? __builtin_amdgcn_rsqf(rssq512[row] * (1.0f / 512.0f) + 1e-6f) : 1.0f;
#pragma unroll
                for (int bj = 0; bj < 2; ++bj) { f32x4 v0 = acc[ai][bj][m][0] * cs[bj][0] * rs, v1 = acc[ai][bj][m][1] * cs[bj][1] * rs;
                    u32x4 w; w.x = cvt_pk_bf16(v0[0], v0[1]); w.y = cvt_pk_bf16(v0[2], v0[3]); w.z = cvt_pk_bf16(v1[0], v1[1]); w.w = cvt_pk_bf16(v1[2], v1[3]);
                    *(u32x4*)(rowp + bj * HALF) = w; } }
    }
};
struct EpiMlstmIn {
    static constexpr bool PERM = true;
    bf16_t* O; float* G; const float* ssq;
    __device__ __forceinline__ void operator()(const f32x4 (&acc)[2][2][4][2], const Unit& u, int wr, int wc, int fr, int fq) const {
        const int row0 = u.pm * BM + wr * 64 + fr;
        if (u.pn < 16) {
            const int col0 = u.pn * BM + wc * 32 + 8 * fq; const float sc0 = (u.pn < 4) ? 0.0625f : 1.f;
#pragma unroll
            for (int ai = 0; ai < 2; ++ai)
#pragma unroll
                for (int m = 0; m < 4; ++m) { const int row = row0 + ai * HALF + m * 16; const float sc = sc0 * rstd_of(ssq[row]); bf16_t* rowp = O + (size_t)row * 4096 + col0;
#pragma unroll
                    for (int bj = 0; bj < 2; ++bj) { f32x4 v0 = acc[ai][bj][m][0] * sc, v1 = acc[ai][bj][m][1] * sc;
                        u32x4 w; w.x = cvt_pk_bf16(v0[0], v0[1]); w.y = cvt_pk_bf16(v0[2], v0[3]); w.z = cvt_pk_bf16(v1[0], v1[1]); w.w = cvt_pk_bf16(v1[2], v1[3]);
                        *(u32x4*)(rowp + bj * HALF) = w; } }
        } else if (wc == 0 && fq == 0) {
#pragma unroll
            for (int ai = 0; ai < 2; ++ai)
#pragma unroll
                for (int m = 0; m < 4; ++m) { const int row = row0 + ai * HALF + m * 16; const float sc = rstd_of(ssq[row]); float* gp = G + (size_t)row * 8;
                    *(f32x4*)gp = acc[ai][0][m][0] * sc; *(f32x4*)(gp + 4) = acc[ai][0][m][1] * sc; }
        }
    }
};
struct EpiMlaIn {
    static constexpr bool PERM = true;
    bf16_t* CQ; bf16_t* CKV; float* KR; const float* ssq; float* ssq_q; float* ssq_kv;
    __device__ __forceinline__ void operator()(const f32x4 (&acc)[2][2][4][2], const Unit& u, int wr, int wc, int fr, int fq) const {
        const int row0 = u.pm * BM + wr * 64 + fr;
        if (u.pn < 4) {
            bf16_t* O = (u.pn < 2) ? CQ : CKV; float* so = (u.pn < 2) ? ssq_q : ssq_kv; const int col0 = (u.pn & 1) * BM + wc * 32 + 8 * fq;
#pragma unroll
            for (int ai = 0; ai < 2; ++ai)
#pragma unroll
                for (int m = 0; m < 4; ++m) { const int row = row0 + ai * HALF + m * 16; const float sc = rstd_of(ssq[row]); bf16_t* rowp = O + (size_t)row * 512 + col0; float ss = 0.f;
#pragma unroll
                    for (int bj = 0; bj < 2; ++bj) { f32x4 v0 = acc[ai][bj][m][0] * sc, v1 = acc[ai][bj][m][1] * sc;
                        u32x4 w; w.x = cvt_pk_bf16(v0[0], v0[1]); w.y = cvt_pk_bf16(v0[2], v0[3]); w.z = cvt_pk_bf16(v1[0], v1[1]); w.w = cvt_pk_bf16(v1[2], v1[3]);
                        *(u32x4*)(rowp + bj * HALF) = w;
                        ss += (v0[0] * v0[0] + v0[1] * v0[1]) + (v0[2] * v0[2] + v0[3] * v0[3]) + (v1[0] * v1[0] + v1[1] * v1[1]) + (v1[2] * v1[2] + v1[3] * v1[3]); }
                    ss += __shfl_xor(ss, 16); ss += __shfl_xor(ss, 32); if (fq == 0) atomicAdd(so + row, ss); }
        } else if (wc < 2) {
#pragma unroll
            for (int ai = 0; ai < 2; ++ai)
#pragma unroll
                for (int m = 0; m < 4; ++m) { const int row = row0 + ai * HALF + m * 16; const float sc = rstd_of(ssq[row]); float* kp = KR + (size_t)row * 64 + wc * 32 + 8 * fq;
                    *(f32x4*)kp = acc[ai][0][m][0] * sc; *(f32x4*)(kp + 4) = acc[ai][0][m][1] * sc; }
        }
    }
};
struct EpiSwiGLU {
    static constexpr bool PERM = true;
    bf16_t* H; const float* ssq;
    __device__ __forceinline__ void operator()(const f32x4 (&acc)[2][2][4][2], const Unit& u, int wr, int wc, int fr, int fq) const {
        const int row0 = u.pm * BM + wr * 64 + fr; const int col0 = u.pn * HALF + wc * 32 + 8 * fq;
#pragma unroll
        for (int ai = 0; ai < 2; ++ai)
#pragma unroll
            for (int m = 0; m < 4; ++m) { const int row = row0 + ai * HALF + m * 16; const float rs = rstd_of(ssq[row]), rs2 = rs * rs, rsc = rs * -1.4426950408889634f; bf16_t* rowp = H + (size_t)row * FF + col0;
                float h[8];
#pragma unroll
                for (int n = 0; n < 2; ++n)
#pragma unroll
                    for (int j = 0; j < 4; ++j) { const float g = acc[ai][0][m][n][j], up = acc[ai][1][m][n][j]; h[n * 4 + j] = (g * up) * rs2 * __builtin_amdgcn_rcpf(1.0f + __builtin_amdgcn_exp2f(g * rsc)); }
                u32x4 w; w.x = cvt_pk_bf16(h[0], h[1]); w.y = cvt_pk_bf16(h[2], h[3]); w.z = cvt_pk_bf16(h[4], h[5]); w.w = cvt_pk_bf16(h[6], h[7]);
                *(u32x4*)rowp = w; }
    }
};
struct EpiRes {
    static constexpr bool PERM = true;
    const bf16_t* base; const float* basef; float* out; int ldc; float scale; bf16_t* xb; float* ssq_out;
    __device__ __forceinline__ void operator()(const f32x4 (&acc)[2][2][4][2], const Unit& u, int wr, int wc, int fr, int fq) const {
        const int col0 = u.pn * BM + wc * 32 + 8 * fq;
        float sc = scale; asm volatile("" : "+v"(sc));
#pragma unroll
        for (int ai = 0; ai < 2; ++ai)
#pragma unroll
            for (int m = 0; m < 4; ++m) { const int row = u.pm * BM + ai * HALF + wr * 64 + m * 16 + fr; const size_t off = (size_t)row * ldc + col0; float ss = 0.f;
#pragma unroll
                for (int bj = 0; bj < 2; ++bj) { f32x4 b0, b1;
                    if (basef) { b0 = *(const f32x4*)(basef + off + bj * HALF); b1 = *(const f32x4*)(basef + off + bj * HALF + 4); }
                    else { const u32x4 bw = *(const u32x4*)(base + off + bj * HALF); b0 = (f32x4){bflo(bw.x), bfhi(bw.x), bflo(bw.y), bfhi(bw.y)}; b1 = (f32x4){bflo(bw.z), bfhi(bw.z), bflo(bw.w), bfhi(bw.w)}; }
                    f32x4 o0 = acc[ai][bj][m][0] * sc + b0;
                    f32x4 o1 = acc[ai][bj][m][1] * sc + b1;
                    if (out) { *(f32x4*)(out + off + bj * HALF) = o0; *(f32x4*)(out + off + bj * HALF + 4) = o1; }
                    if (xb) { u32x4 w; w.x = cvt_pk_bf16(o0[0], o0[1]); w.y = cvt_pk_bf16(o0[2], o0[3]); w.z = cvt_pk_bf16(o1[0], o1[1]); w.w = cvt_pk_bf16(o1[2], o1[3]);
                        *(u32x4*)(xb + off + bj * HALF) = w;
                        ss += (o0[0] * o0[0] + o0[1] * o0[1]) + (o0[2] * o0[2] + o0[3] * o0[3]) + (o1[0] * o1[0] + o1[1] * o1[1]) + (o1[2] * o1[2] + o1[3] * o1[3]); } }
                if (xb) { ss += __shfl_xor(ss, 16); ss += __shfl_xor(ss, 32); if (fq == 0) atomicAdd(ssq_out + row, ss); }
                if (m & 1) asm volatile("" ::: "memory"); }
    }
};

template <class Epi>
__device__ __forceinline__ void gemm_phase(LAS unsigned char* lds, const Gemm g, const StaticOrder& S, const Epi& E) {
    int tid = threadIdx.x; asm volatile("" : "+v"(tid));
    const int wid = __builtin_amdgcn_readfirstlane(tid >> 6), lane = tid & 63, wr = wid >> 2, wc = wid & 3, fr = lane & 15, fq = lane >> 4;
    const int K = g.K, nt = K / BK;
    unsigned voffA[2], voffB[2];
#pragma unroll
    for (int i = 0; i < 2; ++i) { int R, C; stage_rc(tid * 16 + i * 8192, R, C); const int Rb = Epi::PERM ? ((R & ~31) + perm32(R & 31)) : R;
        voffA[i] = (unsigned)(R * K + C) * 2u; voffB[i] = (unsigned)(Rb * K + C) * 2u; }
    const size_t kstep = (size_t)(BK * 2);
    const size_t hstep = (size_t)HALF * K * 2;
    const size_t tstep = 2 * hstep;
    const unsigned ldsw = (unsigned)wid * 1024u;
    const int aoff = lds_byte(wr * 64 + fr, fq * 8), boff = lds_byte(wc * 32 + fr, fq * 8);
#define PG8_SA(b, h) (((b) * 2 + (h)) * HTB)
#define PG8_SB(b, h) ((4 + (b) * 2 + (h)) * HTB)
#define PG8_STAGE(bufoff, gbase, voff) do { _Pragma("unroll") for (int _i = 0; _i < 2; ++_i) \
        __builtin_amdgcn_global_load_lds((const unsigned*)((const char*)(gbase) + (voff)[_i]), (LAS unsigned*)(lds + (bufoff) + ldsw + _i * 8192), 16, 0, 0); } while (0)
#define PG8_LDA(dst, b, h) do { _Pragma("unroll") for (int m = 0; m < 4; ++m) _Pragma("unroll") for (int k = 0; k < 2; ++k) dst[m][k] = *(const LAS bf16x8*)(lds + PG8_SA(b, h) + aoff + m * 2048 + k * 1024); } while (0)
#define PG8_LDB(dst, b, h) do { _Pragma("unroll") for (int n = 0; n < 2; ++n) _Pragma("unroll") for (int k = 0; k < 2; ++k) dst[n][k] = *(const LAS bf16x8*)(lds + PG8_SB(b, h) + boff + n * 2048 + k * 1024); } while (0)
#define PG8_MMA(ai, bj, At, Bt) do { __builtin_amdgcn_s_setprio(1); _Pragma("unroll") for (int m = 0; m < 4; ++m) _Pragma("unroll") for (int n = 0; n < 2; ++n) _Pragma("unroll") for (int k = 0; k < 2; ++k) \
        acc[ai][bj][m][n] = __builtin_amdgcn_mfma_f32_16x16x32_bf16(Bt[n][k], At[m][k], acc[ai][bj][m][n], 0, 0, 0); __builtin_amdgcn_s_setprio(0); } while (0)
#define PG8_WAIT_V(n) asm volatile("s_waitcnt vmcnt(" #n ")" ::: "memory")
#define PG8_WAIT_L(n) asm volatile("s_waitcnt lgkmcnt(" #n ")" ::: "memory")
#define PG8_BAR __builtin_amdgcn_s_barrier()
#define PG8_SCHED __builtin_amdgcn_sched_barrier(0)
    Unit cur, nxt; int ui = 0;
    if (!S.next(0, cur)) return;
    f32x4 acc[2][2][4][2];
#pragma unroll
    for (int a = 0; a < 2; ++a)
#pragma unroll
        for (int b = 0; b < 2; ++b)
#pragma unroll
            for (int m = 0; m < 4; ++m)
#pragma unroll
                for (int n = 0; n < 2; ++n) acc[a][b][m][n] = (f32x4){0.f, 0.f, 0.f, 0.f};
    bf16x8 At[4][2], B0[2][2], B1[2][2];
    const char* cA = (const char*)g.A + (size_t)cur.pm * tstep; const char* cB = (const char*)g.Bt + (size_t)cur.pn * tstep;
    PG8_STAGE(PG8_SB(0, 0), cB, voffB); PG8_STAGE(PG8_SB(0, 1), cB + hstep, voffB); PG8_STAGE(PG8_SA(0, 0), cA, voffA); PG8_STAGE(PG8_SA(0, 1), cA + hstep, voffA);
    if (wr == 1) PG8_BAR;
    PG8_WAIT_V(2); PG8_BAR;
    PG8_STAGE(PG8_SB(1, 0), cB + kstep, voffB); PG8_STAGE(PG8_SA(1, 0), cA + kstep, voffA); PG8_STAGE(PG8_SB(1, 1), cB + hstep + kstep, voffB);
    PG8_WAIT_V(6); PG8_BAR;
    for (;;) {
        const bool has_next = S.next(ui + 1, nxt);
        const char* nA = has_next ? (const char*)g.A + (size_t)nxt.pm * tstep : cA; const char* nB = has_next ? (const char*)g.Bt + (size_t)nxt.pn * tstep : cB;
        for (int t = 0; t < nt; t += 2) {
            const bool last = (t == nt - 2);
            const char* a1 = cA + (size_t)(t + 1) * kstep;
            const char* a2 = last ? nA : cA + (size_t)(t + 2) * kstep; const char* b2 = last ? nB : cB + (size_t)(t + 2) * kstep;
            const char* a3 = a2 + kstep; const char* b3 = b2 + kstep;
            PG8_LDB(B0, 0, 0); PG8_LDB(B1, 0, 1); PG8_SCHED; PG8_LDA(At, 0, 0); PG8_STAGE(PG8_SA(1, 1), a1 + hstep, voffA);
            PG8_WAIT_V(8); PG8_WAIT_L(0); PG8_BAR; PG8_MMA(0, 0, At, B0); PG8_MMA(0, 1, At, B1); PG8_BAR; PG8_SCHED;
            PG8_LDA(At, 0, 1); PG8_STAGE(PG8_SB(0, 0), b2, voffB); PG8_STAGE(PG8_SB(0, 1), b2 + hstep, voffB); PG8_STAGE(PG8_SA(0, 0), a2, voffA);
            PG8_WAIT_V(8); PG8_WAIT_L(0); PG8_BAR; PG8_MMA(1, 0, At, B0); PG8_MMA(1, 1, At, B1); PG8_BAR; PG8_SCHED;
            PG8_LDB(B0, 1, 0); PG8_LDB(B1, 1, 1); PG8_SCHED; PG8_LDA(At, 1, 0); PG8_STAGE(PG8_SA(0, 1), a2 + hstep, voffA);
            PG8_WAIT_V(8); PG8_WAIT_L(0); PG8_BAR; PG8_MMA(0, 0, At, B0); PG8_MMA(0, 1, At, B1); PG8_BAR; PG8_SCHED;
            PG8_LDA(At, 1, 1); PG8_STAGE(PG8_SB(1, 0), b3, voffB); PG8_STAGE(PG8_SB(1, 1), b3 + hstep, voffB); PG8_STAGE(PG8_SA(1, 0), a3, voffA);
            PG8_WAIT_V(8); PG8_WAIT_L(0); PG8_BAR; PG8_MMA(1, 0, At, B0); PG8_MMA(1, 1, At, B1); PG8_BAR; PG8_SCHED;
        }
        if (wr == 0) PG8_BAR;
        { int fr_e = fr, fq_e = fq; asm volatile("" : "+v"(fr_e), "+v"(fq_e));
          E(acc, cur, wr, wc, fr_e, fq_e); }
        if (!has_next) break;
#pragma unroll
        for (int a = 0; a < 2; ++a)
#pragma unroll
            for (int b = 0; b < 2; ++b)
#pragma unroll
                for (int m = 0; m < 4; ++m)
#pragma unroll
                    for (int n = 0; n < 2; ++n) acc[a][b][m][n] = (f32x4){0.f, 0.f, 0.f, 0.f};
        cur = nxt; cA = nA; cB = nB; ++ui;
        if (wr == 1) PG8_BAR;
    }
    PG8_WAIT_V(0);
    PG8_BAR;
#undef PG8_SA
#undef PG8_SB
#undef PG8_STAGE
#undef PG8_LDA
#undef PG8_LDB
#undef PG8_MMA
#undef PG8_WAIT_V
#undef PG8_WAIT_L
#undef PG8_BAR
#undef PG8_SCHED
}
}

__device__ __forceinline__ void conv_matrix(const float* W, int K, int ldn, int c0, int ncols, bf16_t* WT, int drow0, int mode, const float* gain, LAS unsigned char* lds) {
    const int tid = opaque_tid(), lane = tid & 63, wave = __builtin_amdgcn_readfirstlane(tid >> 6), gw = blockIdx.x * NWAVES + wave, ngw = gridDim.x * NWAVES;
    LAS float* scr = (LAS float*)(lds + wave * 16384);
    const int nblk = ncols / 32, nitems = (K / 64) * nblk;
    for (int it = gw; it < nitems; it += ngw) {
        const int kb = it / nblk, nb = it - kb * nblk, k0 = 64 * kb, n0 = c0 + 32 * nb;
        int drow;
        if (mode == 1) { const int up = n0 >= FF ? 1 : 0, j = n0 - up * FF; drow = (j >> 7) * 256 + up * 128 + (j & 127); } else drow = drow0 + 32 * nb;
#pragma unroll 8
        for (int i = 0; i < 32; ++i) { const int kk = 2 * i + (lane >> 5); scr[kk * 33 + (lane & 31)] = W[(size_t)(k0 + kk) * ldn + n0 + (lane & 31)]; }
        asm volatile("s_waitcnt lgkmcnt(0)" ::: "memory");
        const int c = lane & 7;
        f32x4 g0 = {1.f, 1.f, 1.f, 1.f}, g1 = {1.f, 1.f, 1.f, 1.f};
        if (gain) { g0 = *(const f32x4*)(gain + k0 + 8 * c); g1 = *(const f32x4*)(gain + k0 + 8 * c + 4); }
#pragma unroll
        for (int j = 0; j < 4; ++j) { const int n = (lane >> 3) + 8 * j; const LAS float* s = scr + (8 * c) * 33 + n;
            u32x4 o; o.x = pk2(s[0 * 33] * g0.x, s[1 * 33] * g0.y); o.y = pk2(s[2 * 33] * g0.z, s[3 * 33] * g0.w); o.z = pk2(s[4 * 33] * g1.x, s[5 * 33] * g1.y); o.w = pk2(s[6 * 33] * g1.z, s[7 * 33] * g1.w);
            *(u32x4*)(WT + (size_t)(drow + n) * K + k0 + 8 * c) = o; }
        asm volatile("s_waitcnt lgkmcnt(0)" ::: "memory");
    }
}

__device__ __forceinline__ void cast_rows_ssq(const float* X, bf16_t* XB, float* ssq) {
    const int tid = opaque_tid(), lane = tid & 63, gw = blockIdx.x * NWAVES + __builtin_amdgcn_readfirstlane(tid >> 6), ngw = gridDim.x * NWAVES;
    for (int m = gw; m < M; m += ngw) {
        const float* xr = X + (size_t)m * D + 4 * lane; f32x4 v[8]; float s = 0.f;
#pragma unroll
        for (int j = 0; j < 8; ++j) { v[j] = *(const f32x4*)(xr + 256 * j); s += (v[j].x * v[j].x + v[j].y * v[j].y) + (v[j].z * v[j].z + v[j].w * v[j].w); }
        s = wave_sum(s);
        if (lane == 0) ssq[m] = s;
        bf16_t* orow = XB + (size_t)m * D + 4 * lane;
#pragma unroll
        for (int j = 0; j < 8; ++j) { u32x2 w; w.x = pk2(v[j].x, v[j].y); w.y = pk2(v[j].z, v[j].w); *(u32x2*)(orow + 256 * j) = w; }
    }
}

__device__ __forceinline__ float scan_add(float v, int lane) {
#pragma unroll
    for (int o = 1; o < 64; o <<= 1) { const float t = __shfl_up(v, o); if (lane >= o) v += t; }
    return v;
}
__device__ __forceinline__ float scan_max(float v, int lane) {
#pragma unroll
    for (int o = 1; o < 64; o <<= 1) { const float t = __shfl_up(v, o); if (lane >= o) v = fmaxf(v, t); }
    return v;
}
__device__ __forceinline__ float log_sigmoid(float x) { return fminf(x, 0.f) - log1pf(expf(-fabsf(x))); }

__device__ __forceinline__ void mlstm_stage_a(LAS unsigned char* lds, const bf16_t* QKO, const bf16_t* KVT, const float* G, const float* gbias, bf16_t* DC, float* DN, float* SC,
                                              int bid, int nblk, int tid) {
    asm volatile("" : "+v"(tid));
    const int lane = tid & 63, wave = __builtin_amdgcn_readfirstlane(tid >> 6), r32 = lane & 31, hi = lane >> 5;
    LAS float* sWk = (LAS float*)lds;
    LAS unsigned char* sKS = lds + 1024;
    for (int u = bid; u < 1024; u += nblk) {
        const int c = u >> 2, h = u & 3, t0 = c * 64;
        if (wave == 0) {
            const float ig = G[(size_t)(t0 + lane) * 8 + h] + gbias[h];
            const float lf = log_sigmoid(G[(size_t)(t0 + lane) * 8 + 4 + h] + gbias[4 + h]);
            const float b = scan_add(lf, lane);
            const float blast = __shfl(b, 63);
            const float gg = blast - b + ig;
            const float mloc = wave_max(gg);
            sWk[lane] = expf(gg - mloc);
            if (lane == 0) { SC[(c * 4 + h) * 2] = blast; SC[(c * 4 + h) * 2 + 1] = mloc; }
        }
        __syncthreads();
#pragma unroll
        for (int i = 0; i < 4; ++i) { const int q = tid + 512 * i, sidx = q & 63, d8 = q >> 6;
            const u32x4 kv = *(const u32x4*)(QKO + (size_t)(t0 + sidx) * 4096 + 1024 + h * 256 + d8 * 8);
            const float wk = sWk[sidx];
            LAS unsigned short* dst = (LAS unsigned short*)(sKS + (d8 * 8) * 144 + sidx * 2);
            dst[0 * 72] = (unsigned short)f2bf(bflo(kv.x) * wk); dst[1 * 72] = (unsigned short)f2bf(bfhi(kv.x) * wk);
            dst[2 * 72] = (unsigned short)f2bf(bflo(kv.y) * wk); dst[3 * 72] = (unsigned short)f2bf(bfhi(kv.y) * wk);
            dst[4 * 72] = (unsigned short)f2bf(bflo(kv.z) * wk); dst[5 * 72] = (unsigned short)f2bf(bfhi(kv.z) * wk);
            dst[6 * 72] = (unsigned short)f2bf(bflo(kv.w) * wk); dst[7 * 72] = (unsigned short)f2bf(bfhi(kv.w) * wk); }
        __syncthreads();
        if (tid < 256) { float s = 0.f;
#pragma unroll
            for (int j = 0; j < 8; ++j) { const u32x4 w = *(const LAS u32x4*)(sKS + tid * 144 + j * 16);
                s += (bflo(w.x) + bfhi(w.x)) + (bflo(w.y) + bfhi(w.y)) + (bflo(w.z) + bfhi(w.z)) + (bflo(w.w) + bfhi(w.w)); }
            DN[(size_t)(c * 4 + h) * 256 + tid] = s; }
        bf16x8 bfr[2][4];
#pragma unroll
        for (int vb = 0; vb < 2; ++vb)
#pragma unroll
            for (int ks = 0; ks < 4; ++ks) bfr[vb][ks] = *(const bf16x8*)(KVT + (size_t)(h * 512 + (wave * 2 + vb) * 32 + r32) * M + t0 + ks * 16 + hi * 8);
#pragma unroll
        for (int dh = 0; dh < 2; ++dh) {
            f32x16 acc[4][2];
#pragma unroll
            for (int a = 0; a < 4; ++a) { acc[a][0] = f32x16{}; acc[a][1] = f32x16{}; }
#pragma unroll
            for (int db4 = 0; db4 < 4; ++db4)
#pragma unroll
                for (int ks = 0; ks < 4; ++ks) { const bf16x8 a = *(const LAS bf16x8*)(sKS + ((dh * 4 + db4) * 32 + r32) * 144 + ks * 32 + hi * 16);
                    acc[db4][0] = __builtin_amdgcn_mfma_f32_32x32x16_bf16(a, bfr[0][ks], acc[db4][0], 0, 0, 0);
                    acc[db4][1] = __builtin_amdgcn_mfma_f32_32x32x16_bf16(a, bfr[1][ks], acc[db4][1], 0, 0, 0); }
#pragma unroll
            for (int db4 = 0; db4 < 4; ++db4)
#pragma unroll
                for (int vb = 0; vb < 2; ++vb) { const int v = (wave * 2 + vb) * 32 + r32;
                    bf16_t* dp = DC + ((size_t)((c * 4 + h) * 512 + v)) * 256 + (dh * 4 + db4) * 32 + 4 * hi;
#pragma unroll
                    for (int gq = 0; gq < 4; ++gq) { u32x2 w; w.x = pk2(acc[db4][vb][4 * gq], acc[db4][vb][4 * gq + 1]); w.y = pk2(acc[db4][vb][4 * gq + 2], acc[db4][vb][4 * gq + 3]);
                        *(u32x2*)(dp + 8 * gq) = w; } }
        }
        __syncthreads();
    }
}

__device__ __forceinline__ void mlstm_stage_b(bf16_t* DC, float* DN, const float* SC, float* MS, int bid, int nblk, int tid) {
    for (int e4 = bid * 512 + tid; e4 < 131072; e4 += nblk * 512) {
        const int h = __builtin_amdgcn_readfirstlane(e4 >> 15);
        const bool do_n = (e4 & 32767) < 256, do_m = (e4 & 32767) == 0;
        u32x2* p = (u32x2*)DC + e4;
        float* np = DN + (size_t)h * 256 + (e4 & 255);
        float s0 = 0.f, s1 = 0.f, s2 = 0.f, s3 = 0.f, sn = 0.f, m = 0.f;
        u32x2 xa[16]; float na[16];
#pragma unroll
        for (int i = 0; i < 16; ++i) { xa[i] = p[(size_t)i * 131072]; na[i] = do_n ? np[(size_t)i * 1024] : 0.f; }
        for (int c = 0; c < 256; c += 16) {
            u32x2 xb[16]; float nb[16];
            const int cn = (c + 16 < 256) ? c + 16 : c;
#pragma unroll
            for (int i = 0; i < 16; ++i) { xb[i] = p[(size_t)(cn + i) * 131072]; nb[i] = do_n ? np[(size_t)(cn + i) * 1024] : 0.f; }
#pragma unroll
            for (int i = 0; i < 16; ++i) {
                const float blast = SC[((c + i) * 4 + h) * 2], mloc = SC[((c + i) * 4 + h) * 2 + 1];
                const float mn = fmaxf(blast + m, mloc), al = __expf(blast + m - mn), be = __expf(mloc - mn);
                u32x2 w; w.x = pk2(s0, s1); w.y = pk2(s2, s3);
                p[(size_t)(c + i) * 131072] = w;
                if (do_n) np[(size_t)(c + i) * 1024] = sn;
                if (do_m) MS[(c + i) * 4 + h] = m;
                s0 = al * s0 + be * bflo(xa[i].x); s1 = al * s1 + be * bfhi(xa[i].x); s2 = al * s2 + be * bflo(xa[i].y); s3 = al * s3 + be * bfhi(xa[i].y);
                sn = al * sn + be * na[i]; m = mn;
            }
#pragma unroll
            for (int i = 0; i < 16; ++i) { xa[i] = xb[i]; na[i] = nb[i]; }
        }
    }
}

__device__ __forceinline__ void mlstm_stage_c(LAS unsigned char* lds, const bf16_t* QKO, const bf16_t* KVT, const float* G, const float* gbias, const bf16_t* DC, const float* DN,
                                              const float* MS, const float* hnorm, bf16_t* HG, int bid, int nblk, int tid) {
    asm volatile("" : "+v"(tid));
    const int lane = tid & 63, wave = __builtin_amdgcn_readfirstlane(tid >> 6), r32 = lane & 31, hi = lane >> 5;
    LAS float* sB = (LAS float*)lds; LAS float* sI = sB + 64; LAS float* sMt = sB + 128; LAS float* sA = sB + 192; LAS float* sDinv = sB + 256;
    LAS float* sQn = sB + 320;
    LAS float* sSsq = sB + 832;
    LAS unsigned char* sW = lds + 5376;
    for (int u = bid; u < 1024; u += nblk) {
        const int c = u >> 2, h = u & 3, t0 = c * 64;
        if (wave == 0) {
            const float ig = G[(size_t)(t0 + lane) * 8 + h] + gbias[h];
            const float lf = log_sigmoid(G[(size_t)(t0 + lane) * 8 + 4 + h] + gbias[4 + h]);
            const float b = scan_add(lf, lane);
            const float mc = MS[c * 4 + h];
            const float pm = scan_max(ig - b, lane);
            const float mt = b + fmaxf(mc, pm);
            sB[lane] = b; sI[lane] = ig; sMt[lane] = mt; sA[lane] = expf(b + mc - mt);
        }
        { const int t = tid & 63, part = tid >> 6;
          const bf16_t* qp = QKO + (size_t)(t0 + t) * 4096 + h * 256 + part * 32; const float* np = DN + (size_t)(c * 4 + h) * 256 + part * 32;
          float s = 0.f;
#pragma unroll
          for (int j = 0; j < 4; ++j) { const u32x4 qv = *(const u32x4*)(qp + j * 8); const f32x4 n0 = *(const f32x4*)(np + j * 8), n1 = *(const f32x4*)(np + j * 8 + 4);
              s += bflo(qv.x) * n0.x + bfhi(qv.x) * n0.y + bflo(qv.y) * n0.z + bfhi(qv.y) * n0.w + bflo(qv.z) * n1.x + bfhi(qv.z) * n1.y + bflo(qv.w) * n1.z + bfhi(qv.w) * n1.w; }
          sQn[part * 64 + t] = s; }
        __syncthreads();
        if (wave < 4) {
            const int sb = wave >> 1, tb = wave & 1;
            f32x16 acc = f32x16{};
            const bf16_t* kp = QKO + (size_t)(t0 + sb * 32 + r32) * 4096 + 1024 + h * 256 + hi * 8;
            const bf16_t* qp = QKO + (size_t)(t0 + tb * 32 + r32) * 4096 + h * 256 + hi * 8;
#pragma unroll
            for (int ks = 0; ks < 16; ++ks) acc = __builtin_amdgcn_mfma_f32_32x32x16_bf16(*(const bf16x8*)(kp + ks * 16), *(const bf16x8*)(qp + ks * 16), acc, 0, 0, 0);
            const int t = tb * 32 + r32; const float bt = sB[t], mt = sMt[t];
#pragma unroll
            for (int gq = 0; gq < 4; ++gq) { const int s0 = sb * 32 + 8 * gq + 4 * hi; float wv[4];
#pragma unroll
                for (int e = 0; e < 4; ++e) { const int s = s0 + e; wv[e] = (s <= t) ? acc[4 * gq + e] * expf(bt - sB[s] + sI[s] - mt) : 0.f; }
                u32x2 w; w.x = pk2(wv[0], wv[1]); w.y = pk2(wv[2], wv[3]);
                *(LAS u32x2*)(sW + t * 144 + s0 * 2) = w; }
        }
        __syncthreads();
        if (wave == 0) { const int t = lane; float rs = 0.f;
#pragma unroll
            for (int j = 0; j < 8; ++j) { const u32x4 w = *(const LAS u32x4*)(sW + t * 144 + j * 16);
                rs += (bflo(w.x) + bfhi(w.x)) + (bflo(w.y) + bfhi(w.y)) + (bflo(w.z) + bfhi(w.z)) + (bflo(w.w) + bfhi(w.w)); }
            float qn = 0.f;
#pragma unroll
            for (int p = 0; p < 8; ++p) qn += sQn[p * 64 + t];
            const float den = sA[t] * qn + rs;
            sDinv[t] = 1.0f / fmaxf(fabsf(den), expf(-sMt[t])); }
        f32x16 acc[2][2];
#pragma unroll
        for (int a = 0; a < 2; ++a) { acc[a][0] = f32x16{}; acc[a][1] = f32x16{}; }
        { const bf16_t* q0p = QKO + (size_t)(t0 + r32) * 4096 + h * 256 + hi * 8; const bf16_t* q1p = q0p + (size_t)32 * 4096;
          const bf16_t* s0p = DC + ((size_t)((c * 4 + h) * 512 + wave * 64 + r32)) * 256 + hi * 8; const bf16_t* s1p = s0p + 32 * 256;
#pragma unroll
          for (int ks = 0; ks < 16; ++ks) { const bf16x8 b0 = *(const bf16x8*)(q0p + ks * 16), b1 = *(const bf16x8*)(q1p + ks * 16);
              const bf16x8 a0 = *(const bf16x8*)(s0p + ks * 16), a1 = *(const bf16x8*)(s1p + ks * 16);
              acc[0][0] = __builtin_amdgcn_mfma_f32_32x32x16_bf16(a0, b0, acc[0][0], 0, 0, 0); acc[0][1] = __builtin_amdgcn_mfma_f32_32x32x16_bf16(a0, b1, acc[0][1], 0, 0, 0);
              acc[1][0] = __builtin_amdgcn_mfma_f32_32x32x16_bf16(a1, b0, acc[1][0], 0, 0, 0); acc[1][1] = __builtin_amdgcn_mfma_f32_32x32x16_bf16(a1, b1, acc[1][1], 0, 0, 0); } }
        { const float a0 = sA[r32], a1 = sA[32 + r32];
#pragma unroll
          for (int vb = 0; vb < 2; ++vb) { acc[vb][0] *= a0; acc[vb][1] *= a1; } }
        { const bf16_t* v0p = KVT + (size_t)(h * 512 + wave * 64 + r32) * M + t0 + hi * 8; const bf16_t* v1p = v0p + (size_t)32 * M;
#pragma unroll
          for (int ks = 0; ks < 4; ++ks) { const bf16x8 b0 = *(const LAS bf16x8*)(sW + r32 * 144 + ks * 32 + hi * 16), b1 = *(const LAS bf16x8*)(sW + (32 + r32) * 144 + ks * 32 + hi * 16);
              const bf16x8 a0 = *(const bf16x8*)(v0p + ks * 16), a1 = *(const bf16x8*)(v1p + ks * 16);
              acc[0][0] = __builtin_amdgcn_mfma_f32_32x32x16_bf16(a0, b0, acc[0][0], 0, 0, 0); acc[0][1] = __builtin_amdgcn_mfma_f32_32x32x16_bf16(a0, b1, acc[0][1], 0, 0, 0);
              acc[1][0] = __builtin_amdgcn_mfma_f32_32x32x16_bf16(a1, b0, acc[1][0], 0, 0, 0); acc[1][1] = __builtin_amdgcn_mfma_f32_32x32x16_bf16(a1, b1, acc[1][1], 0, 0, 0); } }
        __syncthreads();
#pragma unroll
        for (int tb = 0; tb < 2; ++tb) { const float dinv = sDinv[tb * 32 + r32]; float ss = 0.f;
#pragma unroll
            for (int vb = 0; vb < 2; ++vb) { acc[vb][tb] *= dinv;
#pragma unroll
                for (int r = 0; r < 16; ++r) ss += acc[vb][tb][r] * acc[vb][tb][r]; }
            ss += __shfl_xor(ss, 32);
            if (hi == 0) sSsq[wave * 64 + tb * 32 + r32] = ss; }
        __syncthreads();
#pragma unroll
        for (int tb = 0; tb < 2; ++tb) { const int t = tb * 32 + r32; float tot = 0.f;
#pragma unroll
            for (int w = 0; w < 8; ++w) tot += sSsq[w * 64 + t];
            const float rstd = 1.0f / sqrtf(tot * (1.0f / 512.0f) + EPS);
#pragma unroll
            for (int vb = 0; vb < 2; ++vb)
#pragma unroll
                for (int gq = 0; gq < 4; ++gq) { const int v0 = wave * 64 + vb * 32 + 8 * gq + 4 * hi;
                    const u32x2 ow = *(const u32x2*)(QKO + (size_t)(t0 + t) * 4096 + 2048 + h * 512 + v0);
                    const f32x4 gn = *(const f32x4*)(hnorm + h * 512 + v0);
                    const float o0 = acc[vb][tb][4 * gq] * rstd * gn.x * sigmoidf_(bflo(ow.x)), o1 = acc[vb][tb][4 * gq + 1] * rstd * gn.y * sigmoidf_(bfhi(ow.x));
                    const float o2 = acc[vb][tb][4 * gq + 2] * rstd * gn.z * sigmoidf_(bflo(ow.y)), o3 = acc[vb][tb][4 * gq + 3] * rstd * gn.w * sigmoidf_(bfhi(ow.y));
                    u32x2 w; w.x = pk2(o0, o1); w.y = pk2(o2, o3);
                    *(u32x2*)(HG + (size_t)(t0 + t) * 2048 + h * 512 + v0) = w; } }
        __syncthreads();
    }
}

__device__ __forceinline__ void mla_latent_norm(const float* C, const float* qn, const float* kvn, bf16_t* CQN, bf16_t* CKVN, float* KR) {
    const int tid = opaque_tid(), lane = tid & 63, gw = blockIdx.x * NWAVES + __builtin_amdgcn_readfirstlane(tid >> 6), ngw = gridDim.x * NWAVES;
    for (int m = gw; m < M; m += ngw) {
        KR[(size_t)m * 64 + lane] = C[(size_t)m * 1280 + 1024 + lane];
        const float* cr = C + (size_t)m * 1280 + 4 * lane;
        f32x4 a[2], b[2]; float sa = 0.f, sb = 0.f;
#pragma unroll
        for (int j = 0; j < 2; ++j) { a[j] = *(const f32x4*)(cr + 256 * j); b[j] = *(const f32x4*)(cr + 512 + 256 * j);
            sa += (a[j].x * a[j].x + a[j].y * a[j].y) + (a[j].z * a[j].z + a[j].w * a[j].w); sb += (b[j].x * b[j].x + b[j].y * b[j].y) + (b[j].z * b[j].z + b[j].w * b[j].w); }
        const float ra = 1.0f / sqrtf(wave_sum(sa) * (1.0f / 512.0f) + EPS), rb = 1.0f / sqrtf(wave_sum(sb) * (1.0f / 512.0f) + EPS);
#pragma unroll
        for (int j = 0; j < 2; ++j) { const f32x4 ga = *(const f32x4*)(qn + 4 * lane + 256 * j), gb = *(const f32x4*)(kvn + 4 * lane + 256 * j);
            u32x2 w; w.x = pk2(a[j].x * ra * ga.x, a[j].y * ra * ga.y); w.y = pk2(a[j].z * ra * ga.z, a[j].w * ra * ga.w);
            *(u32x2*)(CQN + (size_t)m * 512 + 4 * lane + 256 * j) = w;
            w.x = pk2(b[j].x * rb * gb.x, b[j].y * rb * gb.y); w.y = pk2(b[j].z * rb * gb.z, b[j].w * rb * gb.w);
            *(u32x2*)(CKVN + (size_t)m * 512 + 4 * lane + 256 * j) = w; }
    }
}
__device__ __forceinline__ void mla_qk_norm_rope(bf16_t* Q, const bf16_t* KVRAW, const float* KR, const int* pos, const float* qkn, bf16_t* KF, LAS unsigned char* lds) {
    const int tid = opaque_tid(), lane = tid & 63, wave = __builtin_amdgcn_readfirstlane(tid >> 6), gw = blockIdx.x * NWAVES + wave, ngw = gridDim.x * NWAVES;
    LAS unsigned short* skr = (LAS unsigned short*)(lds + wave * 256);
    const float QS = 0.07216878364870322f * 1.4426950408889634f;
    const int i32 = lane & 31;
    const double freq = exp2(-(double)i32 * (13.287712379549449 / 32.0));
    const float gqn0 = qkn[2 * lane], gqn1 = qkn[2 * lane + 1], gqr = qkn[128 + lane], gkr = qkn[192 + 128 + lane];
    const int kh = lane >> 2, kp = lane & 3;
    f32x4 gk[8];
#pragma unroll
    for (int e = 0; e < 8; ++e) gk[e] = *(const f32x4*)(qkn + 192 + kp * 32 + e * 4);
    for (int m = gw; m < M; m += ngw) {
        const double ang = (double)pos[m] * freq;
        const double red = ang - 6.283185307179586476925 * rint(ang * 0.15915494309189533577);
        const float sn = sinf((float)red), cs = cosf((float)red);
        { const float x = KR[(size_t)m * 64 + lane]; const float r = 1.0f / sqrtf(wave_sum(x * x) * (1.0f / 64.0f) + EPS);
          const float xn = x * r * gkr; const float pr = __shfl_xor(xn, 32);
          const float kr = (lane < 32) ? (xn * cs - pr * sn) : (xn * cs + pr * sn);
          skr[lane] = (unsigned short)f2bf(kr); }
        { const bf16_t* kp_ = KVRAW + (size_t)m * 4096 + kh * 256 + kp * 32; bf16_t* kf_ = KF + (size_t)m * 3072 + kh * 192;
          u32x4 w[4]; float ss = 0.f;
#pragma unroll
          for (int e = 0; e < 4; ++e) { w[e] = *(const u32x4*)(kp_ + e * 8);
              ss += (bflo(w[e].x) * bflo(w[e].x) + bfhi(w[e].x) * bfhi(w[e].x)) + (bflo(w[e].y) * bflo(w[e].y) + bfhi(w[e].y) * bfhi(w[e].y))
                  + (bflo(w[e].z) * bflo(w[e].z) + bfhi(w[e].z) * bfhi(w[e].z)) + (bflo(w[e].w) * bflo(w[e].w) + bfhi(w[e].w) * bfhi(w[e].w)); }
          ss += __shfl_xor(ss, 1); ss += __shfl_xor(ss, 2);
          const float r3 = 1.0f / sqrtf(ss * (1.0f / 128.0f) + EPS);
#pragma unroll
          for (int e = 0; e < 4; ++e) { const f32x4 g0 = gk[2 * e], g1 = gk[2 * e + 1]; u32x4 o;
              o.x = pk2(bflo(w[e].x) * r3 * g0.x, bfhi(w[e].x) * r3 * g0.y); o.y = pk2(bflo(w[e].y) * r3 * g0.z, bfhi(w[e].y) * r3 * g0.w);
              o.z = pk2(bflo(w[e].z) * r3 * g1.x, bfhi(w[e].z) * r3 * g1.y); o.w = pk2(bflo(w[e].w) * r3 * g1.z, bfhi(w[e].w) * r3 * g1.w);
              *(u32x4*)(kf_ + kp * 32 + e * 8) = o; }
          asm volatile("s_waitcnt lgkmcnt(0)" ::: "memory");
          const u32x4 k0 = *(const LAS u32x4*)(skr + kp * 16), k1 = *(const LAS u32x4*)(skr + kp * 16 + 8);
          *(u32x4*)(kf_ + 128 + kp * 16) = k0; *(u32x4*)(kf_ + 128 + kp * 16 + 8) = k1; }
        bf16_t* qrow = Q + (size_t)m * 3072;
#pragma unroll 4
        for (int hh = 0; hh < 16; ++hh) {
            const unsigned qw = *(const unsigned*)(qrow + hh * 192 + 2 * lane);
            const float qr_ = bf2f(qrow[hh * 192 + 128 + lane]);
            const float q0 = bflo(qw), q1 = bfhi(qw);
            float s1 = q0 * q0 + q1 * q1, s2 = qr_ * qr_;
#pragma unroll
            for (int o = 1; o < 64; o <<= 1) { s1 += __shfl_xor(s1, o); s2 += __shfl_xor(s2, o); }
            const float r1 = QS / sqrtf(s1 * (1.0f / 128.0f) + EPS), r2 = 1.0f / sqrtf(s2 * (1.0f / 64.0f) + EPS);
            *(unsigned*)(qrow + hh * 192 + 2 * lane) = pk2(q0 * r1 * gqn0, q1 * r1 * gqn1);
            const float xn = qr_ * r2 * gqr; const float pr = __shfl_xor(xn, 32);
            const float qo = ((lane < 32) ? (xn * cs - pr * sn) : (xn * cs + pr * sn)) * QS;
            qrow[hh * 192 + 128 + lane] = (unsigned short)f2bf(qo);
        }
    }
}

namespace att {
constexpr int SHM_V = 16384, SHM_K = 24576, OFF_V = 0, OFF_K = 3 * SHM_V, OFF_WS = OFF_K + 3 * SHM_K;
#define SBAR() __builtin_amdgcn_sched_barrier(0)
__device__ __forceinline__ int v_st(int k, int c) { const int kk = (k & ~0xC) | ((k & 4) << 1) | ((k & 8) >> 1); return ((kk >> 3) * 4 + (c >> 5)) * 512 + ((kk & 7) * 32 + (c & 31)) * 2; }
__device__ __forceinline__ int v_rd_base(int lane) { return ((lane & 3) << 3) | (((lane >> 2) & 3) << 6) | (((lane >> 4) & 1) << 5) | (((lane >> 5) & 1) << 8); }
constexpr int v_rd_off(int d0, int ks, int half) { return d0 * 512 + ks * 4096 + half * 2048; }
__device__ __forceinline__ int crow(int r, int hi) { return (r & 3) + 8 * (r >> 2) + 4 * hi; }
__device__ __forceinline__ unsigned cvtpk(float lo, float hi) { unsigned r; asm volatile("v_cvt_pk_bf16_f32 %0, %1, %2" : "=v"(r) : "v"(lo), "v"(hi)); return r; }
__device__ __forceinline__ void mask_tile(f32x16& p0, f32x16& p1, int dq) {
    const float NEG = -__builtin_inff();
#pragma unroll
    for (int r = 0; r < 16; ++r) { const int c = (r & 3) + 8 * (r >> 2);
        if (dq - c < 0) p0[r] = NEG;
        if (dq - c - 32 < 0) p1[r] = NEG; }
}
__device__ __forceinline__ void partialSM(f32x16& p0, f32x16& p1, float& m_reg, float& alpha, f32x16& negm) {
    float pmax = p0[0];
#pragma unroll
    for (int r = 1; r < 16; ++r) pmax = fmaxf(pmax, p0[r]);
#pragma unroll
    for (int r = 0; r < 16; ++r) pmax = fmaxf(pmax, p1[r]);
    { auto rr = __builtin_amdgcn_permlane32_swap(__float_as_uint(pmax), __float_as_uint(pmax), false, false);
      pmax = fmaxf(__uint_as_float(rr[0]), __uint_as_float(rr[1])); }
    if (__builtin_expect(__all(pmax <= 8.0f), 1)) { alpha = 1.f; }
    else { const float dl = fmaxf(pmax, 0.f); m_reg += dl; alpha = __builtin_amdgcn_exp2f(-dl);
#pragma unroll
        for (int r = 0; r < 16; ++r) { p0[r] -= dl; p1[r] -= dl; }
#pragma unroll
        for (int r = 0; r < 16; ++r) negm[r] = -m_reg; }
#pragma unroll
    for (int r = 0; r < 16; ++r) p0[r] = __builtin_amdgcn_exp2f(p0[r]);
#pragma unroll
    for (int r = 0; r < 16; ++r) p1[r] = __builtin_amdgcn_exp2f(p1[r]);
}
__device__ __forceinline__ void finishSM(f32x16& p0, f32x16& p1, float alpha, float& l_reg, bf16x8& pa0, bf16x8& pa1, bf16x8& pa2, bf16x8& pa3) {
    float ps = 0;
#pragma unroll
    for (int r = 0; r < 16; ++r) ps += p0[r];
#pragma unroll
    for (int r = 0; r < 16; ++r) ps += p1[r];
    { auto rr = __builtin_amdgcn_permlane32_swap(__float_as_uint(ps), __float_as_uint(ps), false, false);
      ps = __uint_as_float(rr[0]) + __uint_as_float(rr[1]); }
    l_reg = l_reg * alpha + ps;
#define PK4(P, B_, OUT) do { unsigned a0 = cvtpk(P[B_+0], P[B_+1]), a1 = cvtpk(P[B_+2], P[B_+3]);                          \
        unsigned b0 = cvtpk(P[B_+4], P[B_+5]), b1 = cvtpk(P[B_+6], P[B_+7]);                                             \
        auto r0 = __builtin_amdgcn_permlane32_swap(a0, b0, false, false); auto r1 = __builtin_amdgcn_permlane32_swap(a1, b1, false, false); \
        u32x4 w = {r0[0], r1[0], r0[1], r1[1]}; OUT = *reinterpret_cast<bf16x8*>(&w); } while (0)
    PK4(p0, 0, pa0); PK4(p0, 8, pa1); PK4(p1, 0, pa2); PK4(p1, 8, pa3);
#undef PK4
}
__device__ __forceinline__ int kswz(int row, int colB) { return row * 384 + (colB ^ (((row >> 1) & 7) << 4)); }
__device__ __forceinline__ void qkt(f32x16& p0, f32x16& p1, const LAS unsigned char* Kb, int r32, int hi, const bf16x8* qr, const f32x16& negm) {
    const LAS unsigned char* kb[4];
#pragma unroll
    for (int dd = 0; dd < 4; ++dd) kb[dd] = Kb + kswz(r32, dd * 32 + hi * 16);
#pragma unroll
    for (int d0 = 0; d0 < 12; ++d0) { const LAS unsigned char* a = kb[d0 & 3] + (d0 >> 2) * 128;
        const bf16x8 b0 = *(const LAS bf16x8*)a;
        const bf16x8 b1 = *(const LAS bf16x8*)(a + 32 * 384);
        p0 = __builtin_amdgcn_mfma_f32_32x32x16_bf16(b0, qr[d0], d0 == 0 ? negm : p0, 0, 0, 0);
        p1 = __builtin_amdgcn_mfma_f32_32x32x16_bf16(b1, qr[d0], d0 == 0 ? negm : p1, 0, 0, 0); }
}
__device__ __forceinline__ void pv_tile(f32x16* o, int vb0, bf16x8 pa0, bf16x8 pa1, bf16x8 pa2, bf16x8 pa3) {
#define TRRD(dst, off) asm volatile("ds_read_b64_tr_b16 %0, %1 offset:%2" : "=&v"(dst) : "v"(vb0), "i"(off) : "memory")
#define RD8(S, d0) do { constexpr int b_ = v_rd_off(d0, 0, 0); TRRD(S##l0, b_); TRRD(S##h0, b_ + 2048); TRRD(S##l1, b_ + 4096); TRRD(S##h1, b_ + 6144); \
        TRRD(S##l2, b_ + 8192); TRRD(S##h2, b_ + 10240); TRRD(S##l3, b_ + 12288); TRRD(S##h3, b_ + 14336); } while (0)
#define MM4(S, d0) do { \
        o[d0] = __builtin_amdgcn_mfma_f32_32x32x16_bf16(pa0, (bf16x8){S##l0[0], S##l0[1], S##l0[2], S##l0[3], S##h0[0], S##h0[1], S##h0[2], S##h0[3]}, o[d0], 0, 0, 0); \
        o[d0] = __builtin_amdgcn_mfma_f32_32x32x16_bf16(pa1, (bf16x8){S##l1[0], S##l1[1], S##l1[2], S##l1[3], S##h1[0], S##h1[1], S##h1[2], S##h1[3]}, o[d0], 0, 0, 0); \
        o[d0] = __builtin_amdgcn_mfma_f32_32x32x16_bf16(pa2, (bf16x8){S##l2[0], S##l2[1], S##l2[2], S##l2[3], S##h2[0], S##h2[1], S##h2[2], S##h2[3]}, o[d0], 0, 0, 0); \
        o[d0] = __builtin_amdgcn_mfma_f32_32x32x16_bf16(pa3, (bf16x8){S##l3[0], S##l3[1], S##l3[2], S##l3[3], S##h3[0], S##h3[1], S##h3[2], S##h3[3]}, o[d0], 0, 0, 0); } while (0)
#define WAITL(n) do { asm volatile("s_waitcnt lgkmcnt(" #n ")" ::: "memory"); SBAR(); } while (0)
    s16x4 Al0, Al1, Al2, Al3, Ah0, Ah1, Ah2, Ah3, Bl0, Bl1, Bl2, Bl3, Bh0, Bh1, Bh2, Bh3;
    RD8(A, 0); RD8(B, 1); SBAR();
    WAITL(8); MM4(A, 0); SBAR();
    RD8(A, 2); SBAR();
    WAITL(8); MM4(B, 1); SBAR();
    RD8(B, 3); SBAR();
    WAITL(8); MM4(A, 2); SBAR();
    WAITL(0); MM4(B, 3);
#undef WAITL
#undef MM4
#undef RD8
#undef TRRD
}
__device__ __forceinline__ void attn_unit(unsigned char* ldsg, const bf16_t* QF, const bf16_t* KF, const bf16_t* KVRAW, bf16_t* O, int h, int qb, int tid) {
    asm volatile("" : "+v"(tid));
    LAS unsigned char* lds = (LAS unsigned char*)ldsg;
    const int wid = __builtin_amdgcn_readfirstlane(tid >> 6), lane = tid & 63, r32 = lane & 31, hi = lane >> 5;
    const int q0 = qb * 256, NT = 4 * (qb + 1);
    const int qlo = q0 + wid * 32, qm = qlo + r32 - 4 * hi;
    LAS float* ws = (LAS float*)(lds + OFF_WS) + wid * 64; LAS float* li_l = ws; LAS float* al_l = ws + 32;
    const int sr = tid >> 4, sc = (tid & 15) * 8, vst0 = v_st(sr, sc), vst1 = v_st(32 + sr, sc);
    int kkey[3], kch[3], kls[3];
#pragma unroll
    for (int i = 0; i < 3; ++i) { const int cid = tid + 512 * i; kkey[i] = cid / 24; kch[i] = cid - kkey[i] * 24; kls[i] = kswz(kkey[i], kch[i] * 16); }
    const bf16_t* Kh = KF + h * 192; const bf16_t* Vh = KVRAW + h * 256 + 128;
    const int vb_base = (int)(unsigned)(uintptr_t)(ldsg + OFF_V) + v_rd_base(lane);
    bf16x8 qr[12];
#pragma unroll
    for (int d0 = 0; d0 < 12; ++d0) qr[d0] = *(const bf16x8*)(QF + (size_t)(qlo + r32) * 3072 + h * 192 + d0 * 16 + hi * 8);
    bf16x8 stK[3], stV[2];
#define ALOAD(kb_) do { _Pragma("unroll") for (int i = 0; i < 3; ++i) stK[i] = *(const bf16x8*)(Kh + (size_t)((kb_) + kkey[i]) * 3072 + kch[i] * 8); \
        stV[0] = *(const bf16x8*)(Vh + (size_t)((kb_) + sr) * 4096 + sc); stV[1] = *(const bf16x8*)(Vh + (size_t)((kb_) + 32 + sr) * 4096 + sc); } while (0)
#define AWRITE(bf) do { _Pragma("unroll") for (int i = 0; i < 3; ++i) *(LAS bf16x8*)(lds + OFF_K + (bf) * SHM_K + kls[i]) = stK[i]; \
        *(LAS bf16x8*)(lds + OFF_V + (bf) * SHM_V + vst0) = stV[0]; *(LAS bf16x8*)(lds + OFF_V + (bf) * SHM_V + vst1) = stV[1]; } while (0)
    ALOAD(0); AWRITE(0);
    ALOAD(64);
    __syncthreads();
    float m_reg = 0.f, l_reg = 0.f; f32x16 o[4];
    f32x16 negm = f32x16{}; asm volatile("" : "+v"(negm));
#pragma unroll
    for (int d = 0; d < 4; ++d) o[d] = f32x16{};
    int sj = 0, sn = 1;
    for (int j = 0; j < NT; ++j) {
        const int kb = j * 64;
        if (j + 1 < NT) { AWRITE(sn); if (j + 2 < NT) ALOAD(kb + 128); }
        if (kb <= qlo + 31) {
            f32x16 p0, p1; float alpha; bf16x8 pa0, pa1, pa2, pa3;
            qkt(p0, p1, lds + OFF_K + sj * SHM_K, r32, hi, qr, negm);
            if (kb + 63 > qlo) mask_tile(p0, p1, qm - kb);
            partialSM(p0, p1, m_reg, alpha, negm);
            finishSM(p0, p1, alpha, l_reg, pa0, pa1, pa2, pa3);
            if (__any(alpha < 1.f)) { if (hi == 0) al_l[r32] = alpha; asm volatile("s_waitcnt lgkmcnt(0)" ::: "memory");
#pragma unroll
                for (int d_ = 0; d_ < 4; ++d_)
#pragma unroll
                    for (int r = 0; r < 16; ++r) o[d_][r] *= al_l[crow(r, hi)]; }
            SBAR();
            pv_tile(o, vb_base + sj * SHM_V, pa0, pa1, pa2, pa3);
        }
        sj = sn; sn = (sn == 2) ? 0 : sn + 1;
        __syncthreads();
    }
#undef ALOAD
#undef AWRITE
    if (hi == 0) li_l[r32] = l_reg; asm volatile("s_waitcnt lgkmcnt(0)" ::: "memory");
    float rli[16];
#pragma unroll
    for (int r = 0; r < 16; ++r) rli[r] = 1.0f / li_l[crow(r, hi)];
    bf16_t* Ow = O + (size_t)qlo * 2048 + h * 128;
#pragma unroll
    for (int r = 0; r < 16; ++r) { const int orow = crow(r, hi);
#pragma unroll
        for (int d0 = 0; d0 < 4; ++d0) { const float v = o[d0][r] * rli[r]; const float vn = __shfl_xor(v, 1);
            if ((r32 & 1) == 0) *(unsigned*)(Ow + (size_t)orow * 2048 + d0 * 32 + r32) = cvtpk(v, vn); } }
    __syncthreads();
}
#undef SBAR
}


#define XB_TMO      128
#define XB_XCNT(j)  (256  + 64 * (j))
#define XB_XSUB(j)  (1280 + 64 * (j))
#define XB_XGEN(j)  (2304 + 64 * (j))
#define XB_TOP      3328
#define XB_TOPGEN   3392
#define XCD_BAR_WORDS 3456
#define XB_SPIN_CAP (1u << 22)
__device__ __forceinline__ unsigned xb_ld(unsigned* p)              { return __hip_atomic_load(p, __ATOMIC_RELAXED, __HIP_MEMORY_SCOPE_AGENT); }
__device__ __forceinline__ unsigned xb_add(unsigned* p, unsigned v) { return __hip_atomic_fetch_add(p, v, __ATOMIC_RELAXED, __HIP_MEMORY_SCOPE_AGENT); }
__device__ __forceinline__ unsigned xb_xcc_id() { return (unsigned)__builtin_amdgcn_s_getreg((3 << 11) | 20) & 0xFu; }
#define XB_SPIN(cond, bar) do { unsigned _sp = 0; while (cond) { __builtin_amdgcn_s_sleep(1); \
    if ((++_sp & 255u) == 0u) { if (xb_ld(&(bar)[XB_TMO])) break; if (_sp > XB_SPIN_CAP) { atomicAdd(&(bar)[XB_TMO], 1u); break; } } } } while (0)
struct XcdBarrier { unsigned* bar; unsigned x; volatile LAS unsigned* st; };
__device__ __forceinline__ XcdBarrier xcd_barrier_post(unsigned* bar, volatile LAS unsigned* st) {
    XcdBarrier b; b.bar = bar; b.x = xb_xcc_id(); b.st = st;
    if (threadIdx.x == 0) (void)xb_add(&bar[XB_XCNT(b.x)], 1u);
    return b;
}
__device__ __forceinline__ void xcd_barrier_complete(unsigned* bar, unsigned x, unsigned& nloc, unsigned& nx) {
    const unsigned G = gridDim.x * gridDim.y * gridDim.z;
    unsigned sum, cnt, mine, sp = 0u;
    for (;;) {
        sum = 0u; cnt = 0u; mine = 0u;
#pragma unroll
        for (unsigned j = 0; j < 16; ++j) { const unsigned c = xb_ld(&bar[XB_XCNT(j)]); sum += c; cnt += (c > 0u) ? 1u : 0u; mine = (j == x) ? c : mine; }
        if (sum == G) break;
        __builtin_amdgcn_s_sleep(1);
        if ((++sp & 255u) == 0u) { if (xb_ld(&bar[XB_TMO])) break; if (sp > XB_SPIN_CAP) { atomicAdd(&bar[XB_TMO], 1u); break; } }
    }
    nloc = mine > 0u ? mine : 1u; nx = cnt > 0u ? cnt : 1u;
}
__device__ __forceinline__ void xcd_barrier(const XcdBarrier& b) {
    asm volatile("s_waitcnt vmcnt(0)" ::: "memory");
    __syncthreads();
    if (threadIdx.x == 0) {
        unsigned* bar = b.bar;
        __builtin_amdgcn_s_waitcnt(0);
        unsigned nloc = b.st[0], nx = b.st[1];
        if (nloc == 0u) { xcd_barrier_complete(bar, b.x, nloc, nx); b.st[0] = nloc; b.st[1] = nx; }
        const unsigned old = xb_add(&bar[XB_XSUB(b.x)], 1u);
        const unsigned gen = old / nloc;
        if (old + 1u == (gen + 1u) * nloc) {
            __builtin_amdgcn_fence(__ATOMIC_RELEASE, "agent");
            asm volatile("s_waitcnt vmcnt(0)" ::: "memory");
            const unsigned og = xb_add(&bar[XB_TOP], 1u);
            const unsigned tg = og / nx;
            if (og + 1u == (tg + 1u) * nx) xb_add(&bar[XB_TOPGEN], 1u);
            else XB_SPIN(xb_ld(&bar[XB_TOPGEN]) == tg, bar);
            __builtin_amdgcn_fence(__ATOMIC_ACQUIRE, "agent");
            xb_add(&bar[XB_XGEN(b.x)], 1u);
            asm volatile("s_waitcnt vmcnt(0)" ::: "memory");
        } else {
            XB_SPIN(xb_ld(&bar[XB_XGEN(b.x)]) == gen, bar);
            __builtin_amdgcn_fence(__ATOMIC_ACQUIRE, "agent");
            asm volatile("s_waitcnt vmcnt(0)" ::: "memory");
        }
    }
    __syncthreads();
}

constexpr size_t MiB = (size_t)1 << 20;
constexpr size_t OFF_XN = 1 * MiB;
constexpr size_t OFF_XB = OFF_XN + 64 * MiB;
constexpr size_t OFF_WGU = OFF_XB + 64 * MiB;
constexpr size_t OFF_WD = OFF_WGU + 44 * MiB;
constexpr size_t OFF_WMIA = OFF_WD + 22 * MiB;
constexpr size_t OFF_WMIB = OFF_WMIA + 17 * MiB;
constexpr size_t OFF_WMO = OFF_WMIB + 12 * MiB;
constexpr size_t OFF_WAI = OFF_WMO + 8 * MiB;
constexpr size_t OFF_WUQ = OFF_WAI + 5 * MiB;
constexpr size_t OFF_WUKV = OFF_WUQ + 3 * MiB;
constexpr size_t OFF_WAO = OFF_WUKV + 4 * MiB;
constexpr size_t OFF_BIG = OFF_WAO + 8 * MiB;
constexpr size_t OFF_H = OFF_BIG;
constexpr size_t OFF_WGU2 = OFF_BIG + 180 * MiB;
constexpr size_t OFF_WD2 = OFF_WGU2 + 44 * MiB;
constexpr size_t OFF_SSQ = 131072;
constexpr size_t OFF_QKO = OFF_BIG;
constexpr size_t OFF_KVT = OFF_QKO + 128 * MiB;
constexpr size_t OFF_DC = OFF_KVT + 96 * MiB;
constexpr size_t OFF_DN = OFF_DC + 256 * MiB;
constexpr size_t OFF_G = OFF_DN + 1 * MiB;
constexpr size_t OFF_SC = OFF_G + 1 * MiB;
constexpr size_t OFF_MS = OFF_SC + 65536;
constexpr size_t END_MLSTM = OFF_MS + 65536;
constexpr size_t OFF_C = OFF_BIG;
constexpr size_t OFF_KF = OFF_C;
constexpr size_t OFF_CQN = OFF_KF + 96 * MiB;
constexpr size_t OFF_CKVN = OFF_CQN + 16 * MiB;
constexpr size_t OFF_Q = OFF_CKVN + 16 * MiB;
constexpr size_t OFF_KVRAW = OFF_Q + 96 * MiB;
constexpr size_t OFF_KR = OFF_KVRAW + 128 * MiB;
constexpr size_t END_MLA = OFF_KR + 4 * MiB;
constexpr size_t WS_NEED = END_MLA > END_MLSTM ? END_MLA : END_MLSTM;

struct Args {
    const float* x; const int* pos;
    const float* ffn1_norm; const float* ffn1_wgu; const float* ffn1_wd; const float* mix_norm; const float* ffn2_norm; const float* ffn2_wgu; const float* ffn2_wd;
    const float* ml_win; const float* ml_gb; const float* ml_hn; const float* ml_wout;
    const float* mla_win; const float* mla_qn; const float* mla_kvn; const float* mla_wuq; const float* mla_wukv; const float* mla_qkn; const float* mla_wout;
    float* out; unsigned char* ws;
};

__global__ void __launch_bounds__(NWAVES * 64, 2) mega_fwd(Args a) {
    extern __shared__ __attribute__((aligned(16))) unsigned char lds_g[];
    cg::grid_group grid = cg::this_grid();
    LAS unsigned char* lds = (LAS unsigned char*)lds_g;
    const int tid = threadIdx.x;
    const int G = gridDim.x, bid = blockIdx.x;
    const int vcu = (G % 8 == 0) ? (bid % 8) * (G / 8) + bid / 8 : bid;
    volatile LAS unsigned* bst = (volatile LAS unsigned*)(lds + LDS_BYTES - 64);
    if (tid < 16) bst[tid] = 0u;
    __syncthreads();
    XcdBarrier xbar = xcd_barrier_post((unsigned*)a.ws + 4096, bst);
#define GSYNC() xcd_barrier(xbar)
    unsigned char* ws = a.ws;
    bf16_t* XN = (bf16_t*)(ws + OFF_XN);
    bf16_t* WGU = (bf16_t*)(ws + OFF_WGU); bf16_t* WD = (bf16_t*)(ws + OFF_WD);
    bf16_t* WMIA = (bf16_t*)(ws + OFF_WMIA); bf16_t* WMIB = (bf16_t*)(ws + OFF_WMIB); bf16_t* WMO = (bf16_t*)(ws + OFF_WMO);
    bf16_t* WAI = (bf16_t*)(ws + OFF_WAI); bf16_t* WUQ = (bf16_t*)(ws + OFF_WUQ); bf16_t* WUKV = (bf16_t*)(ws + OFF_WUKV); bf16_t* WAO = (bf16_t*)(ws + OFF_WAO);
    bf16_t* Hb = (bf16_t*)(ws + OFF_H);
    bf16_t* QKO = (bf16_t*)(ws + OFF_QKO); bf16_t* KVT = (bf16_t*)(ws + OFF_KVT); bf16_t* DC = (bf16_t*)(ws + OFF_DC);
    float* DN = (float*)(ws + OFF_DN); float* Gt = (float*)(ws + OFF_G); float* SC = (float*)(ws + OFF_SC); float* MS = (float*)(ws + OFF_MS);
    float* Cb = (float*)(ws + OFF_C); bf16_t* KF = (bf16_t*)(ws + OFF_KF); bf16_t* CQN = (bf16_t*)(ws + OFF_CQN); bf16_t* CKVN = (bf16_t*)(ws + OFF_CKVN);
    bf16_t* Qb = (bf16_t*)(ws + OFF_Q); bf16_t* KVRAW = (bf16_t*)(ws + OFF_KVRAW); float* KR = (float*)(ws + OFF_KR);

    bf16_t* XB = (bf16_t*)(ws + OFF_XB); bf16_t* WGU2 = (bf16_t*)(ws + OFF_WGU2); bf16_t* WD2 = (bf16_t*)(ws + OFF_WD2);
    float* SSQ = (float*)(ws + OFF_SSQ);
#define SSQ_(i) (SSQ + (size_t)(i) * M)
#define CONV_FFN(wgu_, wd_, norm_, layer, WGU_, WD_) do { for (int rep_ = 0; rep_ < REP_CONV; ++rep_) { \
        conv_matrix((wgu_) + (size_t)(layer) * D * 2 * FF, D, 2 * FF, 0, 2 * FF, (WGU_), 0, 1, (norm_) + (layer) * D, lds); \
        conv_matrix((wd_) + (size_t)(layer) * FF * D, FF, D, 0, D, (WD_), 0, 0, nullptr, lds); } \
        __syncthreads();   } while (0)
#define GEMM_GU(WGU_, ssq_) do { for (int rep_ = 0; rep_ < REP_GU; ++rep_) { pg8::Gemm g{XB, (WGU_), M, 2 * FF, D}; pg8::StaticOrder S; S.init(M, 2 * FF, G, bid); pg8::EpiSwiGLU E{Hb, (ssq_)}; pg8::gemm_phase<pg8::EpiSwiGLU>(lds, g, S, E); } } while (0)
#define GEMM_DOWN(WD_, basef_, out_, xb_, ssqo_) do { pg8::Gemm g{Hb, (WD_), M, D, FF}; pg8::StaticOrder S; S.init(M, D, G, bid, 0, 4); pg8::EpiRes E{XB, (basef_), (out_), D, 0.5f, (xb_), (ssqo_)}; pg8::gemm_phase<pg8::EpiRes>(lds, g, S, E); } while (0)

    CONV_FFN(a.ffn1_wgu, a.ffn1_wd, a.ffn1_norm, 0, WGU, WD);
    conv_matrix(a.ml_win, D, 6152, 0, 2048, WMIA, 0, 0, a.mix_norm, lds);
    conv_matrix(a.ml_win, D, 6152, 4096, 2048, WMIA, 2048, 0, a.mix_norm, lds);
    conv_matrix(a.ml_win, D, 6152, 2048, 2048, WMIB, 0, 0, a.mix_norm, lds);
    { const int gt = bid * 512 + opaque_tid(), ngt = G * 512;
      for (int i = gt; i < 8 * D; i += ngt) { const int k = i >> 3, j = i & 7; WMIA[(size_t)(4096 + j) * D + k] = (bf16_t)f2bf(a.ml_win[(size_t)k * 6152 + 6144 + j] * a.mix_norm[k]); }
      u32x4 z = {0u, 0u, 0u, 0u};
      for (int i = gt; i < 248 * D / 8; i += ngt) *(u32x4*)(WMIA + (size_t)4104 * D + (size_t)i * 8) = z;
      for (int i = gt; i < 192 * D / 8; i += ngt) *(u32x4*)(WAI + (size_t)1088 * D + (size_t)i * 8) = z;
      for (int i = gt; i < 7 * M / 4; i += ngt) *(u32x4*)(SSQ_(1) + (size_t)i * 4) = z; }
    conv_matrix(a.ml_wout, D, D, 0, D, WMO, 0, 0, nullptr, lds);
    conv_matrix(a.mla_win, D, 1088, 0, 1088, WAI, 0, 0, a.mix_norm + D, lds);
    conv_matrix(a.mla_wuq, 512, 3072, 0, 3072, WUQ, 0, 0, a.mla_qn, lds);
    conv_matrix(a.mla_wukv, 512, 4096, 0, 4096, WUKV, 0, 0, a.mla_kvn, lds);
    conv_matrix(a.mla_wout, D, D, 0, D, WAO, 0, 0, nullptr, lds);
    cast_rows_ssq(a.x, XB, SSQ_(0));
    if (a.ws == nullptr) grid.sync();
    GSYNC();

    GEMM_GU(WGU, SSQ_(0)); GSYNC();
    GEMM_DOWN(WD, a.x, nullptr, XB, SSQ_(1)); GSYNC();
    CONV_FFN(a.ffn2_wgu, a.ffn2_wd, a.ffn2_norm, 0, WGU, WD);
    for (int rep_ = 0; rep_ < REP_OTHER; ++rep_) { pg8::Gemm g{XB, WMIA, M, 4352, D}; pg8::StaticOrder S; S.init(M, 4352, G, bid); pg8::EpiMlstmIn E{QKO, Gt, SSQ_(1)}; pg8::gemm_phase<pg8::EpiMlstmIn>(lds, g, S, E); }
    for (int rep_ = 0; rep_ < REP_OTHER; ++rep_) { pg8::Gemm g{WMIB, XB, 2048, M, D}; pg8::StaticOrder S; S.init(2048, M, G, bid); pg8::EpiBf16 E{KVT, M, SSQ_(1), nullptr}; pg8::gemm_phase<pg8::EpiBf16>(lds, g, S, E); }
    GSYNC();
    mlstm_stage_a(lds, QKO, KVT, Gt, a.ml_gb, DC, DN, SC, bid, G, tid);
    GSYNC();
    mlstm_stage_b(DC, DN, SC, MS, bid, G, tid);
    GSYNC();
    mlstm_stage_c(lds, QKO, KVT, Gt, a.ml_gb, DC, DN, MS, a.ml_hn, XN, bid, G, tid);
    GSYNC();
    { pg8::Gemm g{XN, WMO, M, D, D}; pg8::StaticOrder S; S.init(M, D, G, bid); pg8::EpiRes E{XB, nullptr, nullptr, D, 1.0f, XB, SSQ_(2)}; pg8::gemm_phase<pg8::EpiRes>(lds, g, S, E); }
    GSYNC();
    CONV_FFN(a.ffn1_wgu, a.ffn1_wd, a.ffn1_norm, 1, WGU2, WD2);
    GEMM_GU(WGU, SSQ_(2)); GSYNC();
    GEMM_DOWN(WD, nullptr, nullptr, XB, SSQ_(3)); GSYNC();

    GEMM_GU(WGU2, SSQ_(3)); GSYNC();
    GEMM_DOWN(WD2, nullptr, nullptr, XB, SSQ_(4)); GSYNC();
    CONV_FFN(a.ffn2_wgu, a.ffn2_wd, a.ffn2_norm, 1, WGU, WD);
    { pg8::Gemm g{XB, WAI, M, 1280, D}; pg8::StaticOrder S; S.init(M, 1280, G, bid); pg8::EpiMlaIn E{CQN, CKVN, KR, SSQ_(4), SSQ_(6), SSQ_(7)}; pg8::gemm_phase<pg8::EpiMlaIn>(lds, g, S, E); }
    GSYNC();
    for (int rep_ = 0; rep_ < REP_OTHER; ++rep_) { pg8::Gemm g{CQN, WUQ, M, 3072, 512}; pg8::StaticOrder S; S.init(M, 3072, G, bid); pg8::EpiBf16 E{Qb, 3072, nullptr, SSQ_(6)}; pg8::gemm_phase<pg8::EpiBf16>(lds, g, S, E); }
    for (int rep_ = 0; rep_ < REP_OTHER; ++rep_) { pg8::Gemm g{CKVN, WUKV, M, 4096, 512}; pg8::StaticOrder S; S.init(M, 4096, G, bid); pg8::EpiBf16 E{KVRAW, 4096, nullptr, SSQ_(7)}; pg8::gemm_phase<pg8::EpiBf16>(lds, g, S, E); }
    GSYNC();
    mla_qk_norm_rope(Qb, KVRAW, KR, a.pos, a.mla_qkn, KF, lds);
    GSYNC();
    for (int rep = 0; rep < REP_ATT; ++rep)
    for (int it = vcu; it < 256; it += G) {
        const int h = it >> 4, s = it & 15;
        for (int k = 0; k < 4; ++k) { const int qb = (k == 0) ? 63 - s : (k == 1) ? 32 + s : (k == 2) ? 31 - s : s; att::attn_unit(lds_g, Qb, KF, KVRAW, XN, h, qb, tid); }
    }
    GSYNC();
    { pg8::Gemm g{XN, WAO, M, D, D}; pg8::StaticOrder S; S.init(M, D, G, bid); pg8::EpiRes E{XB, nullptr, nullptr, D, 1.0f, XB, SSQ_(5)}; pg8::gemm_phase<pg8::EpiRes>(lds, g, S, E); }
    GSYNC();
    GEMM_GU(WGU, SSQ_(5)); GSYNC();
    GEMM_DOWN(WD, nullptr, a.out, nullptr, nullptr);
#undef CONV_FFN
#undef GEMM_GU
#undef GEMM_DOWN
#undef SSQ_
}

extern "C" void kernel_launch(void* const* d_in, const int* in_sizes, int n_in, void* d_out, int out_size, void* d_ws, size_t ws_size, hipStream_t stream) {
    static int grid_blocks = 0;
    if (grid_blocks == 0) {
        if (n_in != 20 || in_sizes[0] != M * D || out_size != M * D || ws_size < WS_NEED) {
            fprintf(stderr, "kernel_launch: unexpected shapes (n_in %d, in0 %d, out %d, ws %zu, need %zu)\n", n_in, n_in > 0 ? in_sizes[0] : -1, out_size, ws_size, (size_t)WS_NEED);
            grid_blocks = -1; return; }
        int dev = 0, cus = 0, per_cu = 0;
        hipGetDevice(&dev);
        hipDeviceGetAttribute(&cus, hipDeviceAttributeMultiprocessorCount, dev);
        hipFuncSetAttribute((const void*)mega_fwd, hipFuncAttributeMaxDynamicSharedMemorySize, LDS_BYTES);
        hipOccupancyMaxActiveBlocksPerMultiprocessor(&per_cu, (const void*)mega_fwd, NWAVES * 64, LDS_BYTES);
        if (per_cu < 1) per_cu = 1;
        grid_blocks = cus * per_cu;
        if (grid_blocks > 256) grid_blocks = 256;
    }
    if (grid_blocks < 0) return;
    Args a{};
    a.x = (const float*)d_in[0]; a.pos = (const int*)d_in[1];
    a.ffn1_norm = (const float*)d_in[2]; a.ffn1_wgu = (const float*)d_in[3]; a.ffn1_wd = (const float*)d_in[4]; a.mix_norm = (const float*)d_in[5];
    a.ffn2_norm = (const float*)d_in[6]; a.ffn2_wgu = (const float*)d_in[7]; a.ffn2_wd = (const float*)d_in[8];
    a.ml_win = (const float*)d_in[9]; a.ml_gb = (const float*)d_in[10]; a.ml_hn = (const float*)d_in[11]; a.ml_wout = (const float*)d_in[12];
    a.mla_win = (const float*)d_in[13]; a.mla_qn = (const float*)d_in[14]; a.mla_kvn = (const float*)d_in[15]; a.mla_wuq = (const float*)d_in[16];
    a.mla_wukv = (const float*)d_in[17]; a.mla_qkn = (const float*)d_in[18]; a.mla_wout = (const float*)d_in[19];
    a.out = (float*)d_out; a.ws = (unsigned char*)d_ws;
    (void)hipMemsetAsync(d_ws, 0, 65536, stream);
    void* args[] = {&a};
    hipError_t e = hipLaunchCooperativeKernel((const void*)mega_fwd, dim3(grid_blocks), dim3(NWAVES * 64), args, LDS_BYTES, stream);
    if (e != hipSuccess) fprintf(stderr, "cooperative launch failed: %s (grid %d)\n", hipGetErrorString(e), grid_blocks);
}
```

```cpp
#include <hip/hip_runtime.h>
#include <hip/hip_cooperative_groups.h>
#include <cstdio>
#include <cstdint>
namespace cg = cooperative_groups;

#define LAS __attribute__((address_space(3)))
typedef unsigned short bf16_t;
typedef short bf16x8 __attribute__((ext_vector_type(8)));
typedef short s16x4 __attribute__((ext_vector_type(4)));
typedef float f32x4 __attribute__((ext_vector_type(4)));
typedef float f32x16 __attribute__((ext_vector_type(16)));
typedef unsigned u32x4 __attribute__((ext_vector_type(4)));
typedef unsigned u32x2 __attribute__((ext_vector_type(2)));

constexpr int M = 16384, D = 2048, FF = 5632;
constexpr float EPS = 1e-6f;
constexpr int NWAVES = 8;
constexpr int LDS_BYTES = 147456;
#ifndef REP_ATT
#define REP_ATT 1
#endif
#define REP_MLSTM 1
#define REP_CONV 1
#define REP_GU 1
#define REP_NORM 1
#define REP_MA 1
#define REP_MC 1
#define REP_DOWN 1
#define REP_OTHER 1

__device__ __forceinline__ unsigned f2bf(float f) { unsigned u = __float_as_uint(f); return (u + 0x7fffu + ((u >> 16) & 1u)) >> 16; }
__device__ __forceinline__ unsigned pk2(float lo, float hi) { return f2bf(lo) | (f2bf(hi) << 16); }
__device__ __forceinline__ float bf2f(unsigned short b) { return __uint_as_float(((unsigned)b) << 16); }
__device__ __forceinline__ float bflo(unsigned w) { return __uint_as_float(w << 16); }
__device__ __forceinline__ float bfhi(unsigned w) { return __uint_as_float(w & 0xffff0000u); }
__device__ __forceinline__ float wave_sum(float v) {
#pragma unroll
    for (int o = 1; o < 64; o <<= 1) v += __shfl_xor(v, o);
    return v;
}
__device__ __forceinline__ float wave_max(float v) {
#pragma unroll
    for (int o = 1; o < 64; o <<= 1) v = fmaxf(v, __shfl_xor(v, o));
    return v;
}
__device__ __forceinline__ int opaque_tid() { int t = threadIdx.x; asm volatile("" : "+v"(t)); return t; }
__device__ __forceinline__ float sigmoidf_(float x) { return 1.0f / (1.0f + __expf(-x)); }

namespace pg8 {
constexpr int BM = 256, BK = 64, HALF = 128, HTB = HALF * BK * 2, STAGE_BYTES = 8 * HTB, NXCD = 8, WGM = 8;
__host__ __device__ __forceinline__ int lds_byte(int r, int c) { const int st = (r >> 4) * 2 + (c >> 5), rr = r & 15, cc = c & 31, ob = rr * 64 + cc * 2; return st * 1024 + (ob ^ (((ob >> 9) & 1) << 5)); }
__host__ __device__ __forceinline__ void stage_rc(int b, int& R, int& C) { const int st = b / 1024, sb = b % 1024, swz = sb ^ (((sb >> 9) & 1) << 5); R = (st >> 1) * 16 + swz / 64; C = (st & 1) * 32 + (swz % 64) / 2; }
__host__ __device__ __forceinline__ int perm32(int rho) { const int n = rho >> 4, i = rho & 15; return 8 * (i >> 2) + 4 * n + (i & 3); }

struct Unit { int pm, pn; };
struct Gemm { const bf16_t* A; const bf16_t* Bt; int M, N, K; };

struct StaticOrder {
    int nM, nN, nwg, G, c, rev, wgm;
    __device__ void init(int M_, int N_, int G_, int c_, int rev_ = 0, int wgm_ = WGM) { nM = M_ / BM; nN = N_ / BM; nwg = nM * nN; G = G_; c = c_; rev = rev_; wgm = wgm_; }
    __device__ bool next(int i, Unit& u) const {
        const long L = (long)i * G + c; if (L >= nwg) return false;
        int wgid = (int)L; { const int q = nwg / NXCD, r = nwg % NXCD, xcd = wgid % NXCD, off = wgid / NXCD; wgid = (xcd < r ? xcd * (q + 1) : r * (q + 1) + (xcd - r) * q) + off; }
        const int nig = wgm * nN, gid = wgid / nig, fm = gid * wgm, gsz = (nM - fm) < wgm ? (nM - fm) : wgm;
        u.pm = fm + ((wgid % nig) % gsz); u.pn = (wgid % nig) / gsz; if (rev) u.pm = nM - 1 - u.pm; return true;
    }
};

__device__ __forceinline__ unsigned cvt_pk_bf16(float lo, float hi) { unsigned r; asm volatile("v_cvt_pk_bf16_f32 %0, %1, %2" : "=v"(r) : "v"(lo), "v"(hi)); return r; }

__device__ __forceinline__ float rstd_of(float ssq) { return __builtin_amdgcn_rsqf(ssq * (1.0f / 2048.0f) + 1e-6f); }
struct EpiBf16 {
    static constexpr bool PERM = true;
    bf16_t* O; int ldc; const float* cssq; const float* rssq512;
    __device__ __forceinline__ void operator()(const f32x4 (&acc)[2][2][4][2], const Unit& u, int wr, int wc, int fr, int fq) const {
        const int row0 = u.pm * BM + wr * 64 + fr; const int col0 = u.pn * BM + wc * 32 + 8 * fq;
        f32x4 cs[2][2];
#pragma unroll
        for (int bj = 0; bj < 2; ++bj)
#pragma unroll
            for (int n = 0; n < 2; ++n) { if (cssq) { const f32x4 q = *(const f32x4*)(cssq + col0 + bj * HALF + 4 * n); cs[bj][n] = (f32x4){rstd_of(q.x), rstd_of(q.y), rstd_of(q.z), rstd_of(q.w)}; } else cs[bj][n] = (f32x4){1.f, 1.f, 1.f, 1.f}; }
#pragma unroll
        for (int ai = 0; ai < 2; ++ai)
#pragma unroll
            for (int m = 0; m < 4; ++m) { const int row = row0 + ai * HALF + m * 16; bf16_t* rowp = O + (size_t)row * ldc + col0;
                const float rs = rssq512 ? __builtin_amdgcn_rsqf(rssq512[row] * (1.0f / 512.0f) + 1e-6f) : 1.0f;
#pragma unroll
                for (int bj = 0; bj < 2; ++bj) { f32x4 v0 = acc[ai][bj][m][0] * cs[bj][0] * rs, v1 = acc[ai][bj][m][1] * cs[bj][1] * rs;
                    u32x4 w; w.x = cvt_pk_bf16(v0[0], v0[1]); w.y = cvt_pk_bf16(v0[2], v0[3]); w.z = cvt_pk_bf16(v1[0], v1[1]); w.w = cvt_pk_bf16(v1[2], v1[3]);
                    *(u32x4*)(rowp + bj * HALF) = w; } }
    }
};
struct EpiMlstmIn {
    static constexpr bool PERM = true;
    bf16_t* O; float* G; const float* ssq;
    __device__ __forceinline__ void operator()(const f32x4 (&acc)[2][2][4][2], const Unit& u, int wr, int wc, int fr, int fq) const {
        const int row0 = u.pm * BM + wr * 64 + fr;
        if (u.pn < 16) {
            const int col0 = u.pn * BM + wc * 32 + 8 * fq; const float sc0 = (u.pn < 4) ? 0.0625f : 1.f;
#pragma unroll
            for (int ai = 0; ai < 2; ++ai)
#pragma unroll
                for (int m = 0; m < 4; ++m) { const int row = row0 + ai * HALF + m * 16; const float sc = sc0 * rstd_of(ssq[row]); bf16_t* rowp = O + (size_t)row * 4096 + col0;
#pragma unroll
                    for (int bj = 0; bj < 2; ++bj) { f32x4 v0 = acc[ai][bj][m][0] * sc, v1 = acc[ai][bj][m][1] * sc;
                        u32x4 w; w.x = cvt_pk_bf16(v0[0], v0[1]); w.y = cvt_pk_bf16(v0[2], v0[3]); w.z = cvt_pk_bf16(v1[0], v1[1]); w.w = cvt_pk_bf16(v1[2], v1[3]);
                        *(u32x4*)(rowp + bj * HALF) = w; } }
        } else if (wc == 0 && fq == 0) {
#pragma unroll
            for (int ai = 0; ai < 2; ++ai)
#pragma unroll
                for (int m = 0; m < 4; ++m) { const int row = row0 + ai * HALF + m * 16; const float sc = rstd_of(ssq[row]); float* gp = G + (size_t)row * 8;
                    *(f32x4*)gp = acc[ai][0][m][0] * sc; *(f32x4*)(gp + 4) = acc[ai][0][m][1] * sc; }
        }
    }
};
struct EpiMlaIn {
    static constexpr bool PERM = true;
    bf16_t* CQ; bf16_t* CKV; float* KR; const float* ssq; float* ssq_q; float* ssq_kv;
    __device__ __forceinline__ void operator()(const f32x4 (&acc)[2][2][4][2], const Unit& u, int wr, int wc, int fr, int fq) const {
        const int row0 = u.pm * BM + wr * 64 + fr;
        if (u.pn < 4) {
            bf16_t* O = (u.pn < 2) ? CQ : CKV; float* so = (u.pn < 2) ? ssq_q : ssq_kv; const int col0 = (u.pn & 1) * BM + wc * 32 + 8 * fq;
#pragma unroll
            for (int ai = 0; ai < 2; ++ai)
#pragma unroll
                for (int m = 0; m < 4; ++m) { const int row = row0 + ai * HALF + m * 16; const float sc = rstd_of(ssq[row]); bf16_t* rowp = O + (size_t)row * 512 + col0; float ss = 0.f;
#pragma unroll
                    for (int bj = 0; bj < 2; ++bj) { f32x4 v0 = acc[ai][bj][m][0] * sc, v1 = acc[ai][bj][m][1] * sc;
                        u32x4 w; w.x = cvt_pk_bf16(v0[0], v0[1]); w.y = cvt_pk_bf16(v0[2], v0[3]); w.z = cvt_pk_bf16(v1[0], v1[1]); w.w = cvt_pk_bf16(v1[2], v1[3]);
                        *(u32x4*)(rowp + bj * HALF) = w;
                        ss += (v0[0] * v0[0] + v0[1] * v0[1]) + (v0[2] * v0[2] + v0[3] * v0[3]) + (v1[0] * v1[0] + v1[1] * v1[1]) + (v1[2] * v1[2] + v1[3] * v1[3]); }
                    ss += __shfl_xor(ss, 16); ss += __shfl_xor(ss, 32); if (fq == 0) atomicAdd(so + row, ss); }
        } else if (wc < 2) {
#pragma unroll
            for (int ai = 0; ai < 2; ++ai)
#pragma unroll
                for (int m = 0; m < 4; ++m) { const int row = row0 + ai * HALF + m * 16; const float sc = rstd_of(ssq[row]); float* kp = KR + (size_t)row * 64 + wc * 32 + 8 * fq;
                    *(f32x4*)kp = acc[ai][0][m][0] * sc; *(f32x4*)(kp + 4) = acc[ai][0][m][1] * sc; }
        }
    }
};
struct EpiSwiGLU {
    static constexpr bool PERM = true;
    bf16_t* H; const float* ssq;
    __device__ __forceinline__ void operator()(const f32x4 (&acc)[2][2][4][2], const Unit& u, int wr, int wc, int fr, int fq) const {
        const int row0 = u.pm * BM + wr * 64 + fr; const int col0 = u.pn * HALF + wc * 32 + 8 * fq;
#pragma unroll
        for (int ai = 0; ai < 2; ++ai)
#pragma unroll
            for (int m = 0; m < 4; ++m) { const int row = row0 + ai * HALF + m * 16; const float rs = rstd_of(ssq[row]), rs2 = rs * rs, rsc = rs * -1.4426950408889634f; bf16_t* rowp = H + (size_t)row * FF + col0;
                float h[8];
#pragma unroll
                for (int n = 0; n < 2; ++n)
#pragma unroll
                    for (int j = 0; j < 4; ++j) { const float g = acc[ai][0][m][n][j], up = acc[ai][1][m][n][j]; h[n * 4 + j] = (g * up) * rs2 * __builtin_amdgcn_rcpf(1.0f + __builtin_amdgcn_exp2f(g * rsc)); }
                u32x4 w; w.x = cvt_pk_bf16(h[0], h[1]); w.y = cvt_pk_bf16(h[2], h[3]); w.z = cvt_pk_bf16(h[4], h[5]); w.w = cvt_pk_bf16(h[6], h[7]);
                *(u32x4*)rowp = w; }
    }
};
struct EpiRes {
    static constexpr bool PERM = true;
    const bf16_t* base; const float* basef; float* out; int ldc; float scale; bf16_t* xb; float* ssq_out;
    __device__ __forceinline__ void operator()(const f32x4 (&acc)[2][2][4][2], const Unit& u, int wr, int wc, int fr, int fq) const {
        const int col0 = u.pn * BM + wc * 32 + 8 * fq;
        float sc = scale; asm volatile("" : "+v"(sc));
#pragma unroll
        for (int ai = 0; ai < 2; ++ai)
#pragma unroll
            for (int m = 0; m < 4; ++m) { const int row = u.pm * BM + ai * HALF + wr * 64 + m * 16 + fr; const size_t off = (size_t)row * ldc + col0; float ss = 0.f;
#pragma unroll
                for (int bj = 0; bj < 2; ++bj) { f32x4 b0, b1;
                    if (basef) { b0 = *(const f32x4*)(basef + off + bj * HALF); b1 = *(const f32x4*)(basef + off + bj * HALF + 4); }
                    else { const u32x4 bw = *(const u32x4*)(base + off + bj * HALF); b0 = (f32x4){bflo(bw.x), bfhi(bw.x), bflo(bw.y), bfhi(bw.y)}; b1 = (f32x4){bflo(bw.z), bfhi(bw.z), bflo(bw.w), bfhi(bw.w)}; }
                    f32x4 o0 = acc[ai][bj][m][0] * sc + b0;
                    f32x4 o1 = acc[ai][bj][m][1] * sc + b1;
                    if (out) { *(f32x4*)(out + off + bj * HALF) = o0; *(f32x4*)(out + off + bj * HALF + 4) = o1; }
                    if (xb) { u32x4 w; w.x = cvt_pk_bf16(o0[0], o0[1]); w.y = cvt_pk_bf16(o0[2], o0[3]); w.z = cvt_pk_bf16(o1[0], o1[1]); w.w = cvt_pk_bf16(o1[2], o1[3]);
                        *(u32x4*)(xb + off + bj * HALF) = w;
                        ss += (o0[0] * o0[0] + o0[1] * o0[1]) + (o0[2] * o0[2] + o0[3] * o0[3]) + (o1[0] * o1[0] + o1[1] * o1[1]) + (o1[2] * o1[2] + o1[3] * o1[3]); } }
                if (xb) { ss += __shfl_xor(ss, 16); ss += __shfl_xor(ss, 32); if (fq == 0) atomicAdd(ssq_out + row, ss); }
                if (m & 1) asm volatile("" ::: "memory"); }
    }
};

template <class Epi>
__device__ __forceinline__ void gemm_phase(LAS unsigned char* lds, const Gemm g, const StaticOrder& S, const Epi& E) {
    int tid = threadIdx.x; asm volatile("" : "+v"(tid));
    const int wid = __builtin_amdgcn_readfirstlane(tid >> 6), lane = tid & 63, wr = wid >> 2, wc = wid & 3, fr = lane & 15, fq = lane >> 4;
    const int K = g.K, nt = K / BK;
    unsigned voffA[2], voffB[2];
#pragma unroll
    for (int i = 0; i < 2; ++i) { int R, C; stage_rc(tid * 16 + i * 8192, R, C); const int Rb = Epi::PERM ? ((R & ~31) + perm32(R & 31)) : R;
        voffA[i] = (unsigned)(R * K + C) * 2u; voffB[i] = (unsigned)(Rb * K + C) * 2u; }
    const size_t kstep = (size_t)(BK * 2);
    const size_t hstep = (size_t)HALF * K * 2;
    const size_t tstep = 2 * hstep;
    const unsigned ldsw = (unsigned)wid * 1024u;
    const int aoff = lds_byte(wr * 64 + fr, fq * 8), boff = lds_byte(wc * 32 + fr, fq * 8);
#define PG8_SA(b, h) (((b) * 2 + (h)) * HTB)
#define PG8_SB(b, h) ((4 + (b) * 2 + (h)) * HTB)
#define PG8_STAGE(bufoff, gbase, voff) do { _Pragma("unroll") for (int _i = 0; _i < 2; ++_i) \
        __builtin_amdgcn_global_load_lds((const unsigned*)((const char*)(gbase) + (voff)[_i]), (LAS unsigned*)(lds + (bufoff) + ldsw + _i * 8192), 16, 0, 0); } while (0)
#define PG8_LDA(dst, b, h) do { _Pragma("unroll") for (int m = 0; m < 4; ++m) _Pragma("unroll") for (int k = 0; k < 2; ++k) dst[m][k] = *(const LAS bf16x8*)(lds + PG8_SA(b, h) + aoff + m * 2048 + k * 1024); } while (0)
#define PG8_LDB(dst, b, h) do { _Pragma("unroll") for (int n = 0; n < 2; ++n) _Pragma("unroll") for (int k = 0; k < 2; ++k) dst[n][k] = *(const LAS bf16x8*)(lds + PG8_SB(b, h) + boff + n * 2048 + k * 1024); } while (0)
#define PG8_MMA(ai, bj, At, Bt) do { __builtin_amdgcn_s_setprio(1); _Pragma("unroll") for (int m = 0; m < 4; ++m) _Pragma("unroll") for (int n = 0; n < 2; ++n) _Pragma("unroll") for (int k = 0; k < 2; ++k) \
        acc[ai][bj][m][n] = __builtin_amdgcn_mfma_f32_16x16x32_bf16(Bt[n][k], At[m][k], acc[ai][bj][m][n], 0, 0, 0); __builtin_amdgcn_s_setprio(0); } while (0)
#define PG8_WAIT_V(n) asm volatile("s_waitcnt vmcnt(" #n ")" ::: "memory")
#define PG8_WAIT_L(n) asm volatile("s_waitcnt lgkmcnt(" #n ")" ::: "memory")
#define PG8_BAR __builtin_amdgcn_s_barrier()
#define PG8_SCHED __builtin_amdgcn_sched_barrier(0)
    Unit cur, nxt; int ui = 0;
    if (!S.next(0, cur)) return;
    f32x4 acc[2][2][4][2];
#pragma unroll
    for (int a = 0; a < 2; ++a)
#pragma unroll
        for (int b = 0; b < 2; ++b)
#pragma unroll
            for (int m = 0; m < 4; ++m)
#pragma unroll
                for (int n = 0; n < 2; ++n) acc[a][b][m][n] = (f32x4){0.f, 0.f, 0.f, 0.f};
    bf16x8 At[4][2], B0[2][2], B1[2][2];
    const char* cA = (const char*)g.A + (size_t)cur.pm * tstep; const char* cB = (const char*)g.Bt + (size_t)cur.pn * tstep;
    PG8_STAGE(PG8_SB(0, 0), cB, voffB); PG8_STAGE(PG8_SB(0, 1), cB + hstep, voffB); PG8_STAGE(PG8_SA(0, 0), cA, voffA); PG8_STAGE(PG8_SA(0, 1), cA + hstep, voffA);
    if (wr == 1) PG8_BAR;
    PG8_WAIT_V(2); PG8_BAR;
    PG8_STAGE(PG8_SB(1, 0), cB + kstep, voffB); PG8_STAGE(PG8_SA(1, 0), cA + kstep, voffA); PG8_STAGE(PG8_SB(1, 1), cB + hstep + kstep, voffB);
    PG8_WAIT_V(6); PG8_BAR;
    for (;;) {
        const bool has_next = S.next(ui + 1, nxt);
        const char* nA = has_next ? (const char*)g.A + (size_t)nxt.pm * tstep : cA; const char* nB = has_next ? (const char*)g.Bt + (size_t)nxt.pn * tstep : cB;
        for (int t = 0; t < nt; t += 2) {
            const bool last = (t == nt - 2);
            const char* a1 = cA + (size_t)(t + 1) * kstep;
            const char* a2 = last ? nA : cA + (size_t)(t + 2) * kstep; const char* b2 = last ? nB : cB + (size_t)(t + 2) * kstep;
            const char* a3 = a2 + kstep; const char* b3 = b2 + kstep;
            PG8_LDB(B0, 0, 0); PG8_LDB(B1, 0, 1); PG8_SCHED; PG8_LDA(At, 0, 0); PG8_STAGE(PG8_SA(1, 1), a1 + hstep, voffA);
            PG8_WAIT_V(8); PG8_WAIT_L(0); PG8_BAR; PG8_MMA(0, 0, At, B0); PG8_MMA(0, 1, At, B1); PG8_BAR; PG8_SCHED;
            PG8_LDA(At, 0, 1); PG8_STAGE(PG8_SB(0, 0), b2, voffB); PG8_STAGE(PG8_SB(0, 1), b2 + hstep, voffB); PG8_STAGE(PG8_SA(0, 0), a2, voffA);
            PG8_WAIT_V(8); PG8_WAIT_L(0); PG8_BAR; PG8_MMA(1, 0, At, B0); PG8_MMA(1, 1, At, B1); PG8_BAR; PG8_SCHED;
            PG8_LDB(B0, 1, 0); PG8_LDB(B1, 1, 1); PG8_SCHED; PG8_LDA(At, 1, 0); PG8_STAGE(PG8_SA(0, 1), a2 + hstep, voffA);
            PG8_WAIT_V(8); PG8_WAIT_L(0); PG8_BAR; PG8_MMA(0, 0, At, B0); PG8_MMA(0, 1, At, B1); PG8_BAR; PG8_SCHED;
            PG8_LDA(At, 1, 1); PG8_STAGE(PG8_SB(1, 0), b3, voffB); PG8_STAGE(PG8_SB(1, 1), b3 + hstep, voffB); PG8_STAGE(PG8_SA(1, 0), a3, voffA);
            PG8_WAIT_V(8); PG8_WAIT_L(0); PG8_BAR; PG8_MMA(1, 0, At, B0); PG8_MMA(1, 1, At, B1); PG8_BAR; PG8_SCHED;
        }
        if (wr == 0) PG8_BAR;
        { int fr_e = fr, fq_e = fq; asm volatile("" : "+v"(fr_e), "+v"(fq_e));
          E(acc, cur, wr, wc, fr_e, fq_e); }
        if (!has_next) break;
#pragma unroll
        for (int a = 0; a < 2; ++a)
#pragma unroll
            for (int b = 0; b < 2; ++b)
#pragma unroll
                for (int m = 0; m < 4; ++m)
#pragma unroll
                    for (int n = 0; n < 2; ++n) acc[a][b][m][n] = (f32x4){0.f, 0.f, 0.f, 0.f};
        cur = nxt; cA = nA; cB = nB; ++ui;
        if (wr == 1) PG8_BAR;
    }
    PG8_WAIT_V(0);
    PG8_BAR;
#undef PG8_SA
#undef PG8_SB
#undef PG8_STAGE
#undef PG8_LDA
#undef PG8_LDB
#undef PG8_MMA
#undef PG8_WAIT_V
#undef PG8_WAIT_L
#undef PG8_BAR
#undef PG8_SCHED
}
}

__device__ __forceinline__ void conv_matrix(const float* W, int K, int ldn, int c0, int ncols, bf16_t* WT, int drow0, int mode, const float* gain, LAS unsigned char* lds) {
    const int tid = opaque_tid(), lane = tid & 63, wave = __builtin_amdgcn_readfirstlane(tid >> 6), gw = blockIdx.x * NWAVES + wave, ngw = gridDim.x * NWAVES;
    LAS float* scr = (LAS float*)(lds + wave * 16384);
    const int nblk = ncols / 32, nitems = (K / 64) * nblk;
    for (int it = gw; it < nitems; it += ngw) {
        const int kb = it / nblk, nb = it - kb * nblk, k0 = 64 * kb, n0 = c0 + 32 * nb;
        int drow;
        if (mode == 1) { const int up = n0 >= FF ? 1 : 0, j = n0 - up * FF; drow = (j >> 7) * 256 + up * 128 + (j & 127); } else drow = drow0 + 32 * nb;
#pragma unroll 8
        for (int i = 0; i < 32; ++i) { const int kk = 2 * i + (lane >> 5); scr[kk * 33 + (lane & 31)] = W[(size_t)(k0 + kk) * ldn + n0 + (lane & 31)]; }
        asm volatile("s_waitcnt lgkmcnt(0)" ::: "memory");
        const int c = lane & 7;
        f32x4 g0 = {1.f, 1.f, 1.f, 1.f}, g1 = {1.f, 1.f, 1.f, 1.f};
        if (gain) { g0 = *(const f32x4*)(gain + k0 + 8 * c); g1 = *(const f32x4*)(gain + k0 + 8 * c + 4); }
#pragma unroll
        for (int j = 0; j < 4; ++j) { const int n = (lane >> 3) + 8 * j; const LAS float* s = scr + (8 * c) * 33 + n;
            u32x4 o; o.x = pk2(s[0 * 33] * g0.x, s[1 * 33] * g0.y); o.y = pk2(s[2 * 33] * g0.z, s[3 * 33] * g0.w); o.z = pk2(s[4 * 33] * g1.x, s[5 * 33] * g1.y); o.w = pk2(s[6 * 33] * g1.z, s[7 * 33] * g1.w);
            *(u32x4*)(WT + (size_t)(drow + n) * K + k0 + 8 * c) = o; }
        asm volatile("s_waitcnt lgkmcnt(0)" ::: "memory");
    }
}

__device__ __forceinline__ void cast_rows_ssq(const float* X, bf16_t* XB, float* ssq) {
    const int tid = opaque_tid(), lane = tid & 63, gw = blockIdx.x * NWAVES + __builtin_amdgcn_readfirstlane(tid >> 6), ngw = gridDim.x * NWAVES;
    for (int m = gw; m < M; m += ngw) {
        const float* xr = X + (size_t)m * D + 4 * lane; f32x4 v[8]; float s = 0.f;
#pragma unroll
        for (int j = 0; j < 8; ++j) { v[j] = *(const f32x4*)(xr + 256 * j); s += (v[j].x * v[j].x + v[j].y * v[j].y) + (v[j].z * v[j].z + v[j].w * v[j].w); }
        s = wave_sum(s);
        if (lane == 0) ssq[m] = s;
        bf16_t* orow = XB + (size_t)m * D + 4 * lane;
#pragma unroll
        for (int j = 0; j < 8; ++j) { u32x2 w; w.x = pk2(v[j].x, v[j].y); w.y = pk2(v[j].z, v[j].w); *(u32x2*)(orow + 256 * j) = w; }
    }
}

__device__ __forceinline__ float scan_add(float v, int lane) {
#pragma unroll
    for (int o = 1; o < 64; o <<= 1) { const float t = __shfl_up(v, o); if (lane >= o) v += t; }
    return v;
}
__device__ __forceinline__ float scan_max(float v, int lane) {
#pragma unroll
    for (int o = 1; o < 64; o <<= 1) { const float t = __shfl_up(v, o); if (lane >= o) v = fmaxf(v, t); }
    return v;
}
__device__ __forceinline__ float log_sigmoid(float x) { return fminf(x, 0.f) - log1pf(expf(-fabsf(x))); }

__device__ __forceinline__ void mlstm_stage_a(LAS unsigned char* lds, const bf16_t* QKO, const bf16_t* KVT, const float* G, const float* gbias, bf16_t* DC, float* DN, float* SC,
                                              int bid, int nblk, int tid) {
    asm volatile("" : "+v"(tid));
    const int lane = tid & 63, wave = __builtin_amdgcn_readfirstlane(tid >> 6), r32 = lane & 31, hi = lane >> 5;
    LAS float* sWk = (LAS float*)lds;
    LAS unsigned char* sKS = lds + 1024;
    for (int u = bid; u < 1024; u += nblk) {
        const int c = u >> 2, h = u & 3, t0 = c * 64;
        if (wave == 0) {
            const float ig = G[(size_t)(t0 + lane) * 8 + h] + gbias[h];
            const float lf = log_sigmoid(G[(size_t)(t0 + lane) * 8 + 4 + h] + gbias[4 + h]);
            const float b = scan_add(lf, lane);
            const float blast = __shfl(b, 63);
            const float gg = blast - b + ig;
            const float mloc = wave_max(gg);
            sWk[lane] = expf(gg - mloc);
            if (lane == 0) { SC[(c * 4 + h) * 2] = blast; SC[(c * 4 + h) * 2 + 1] = mloc; }
        }
        __syncthreads();
#pragma unroll
        for (int i = 0; i < 4; ++i) { const int q = tid + 512 * i, sidx = q & 63, d8 = q >> 6;
            const u32x4 kv = *(const u32x4*)(QKO + (size_t)(t0 + sidx) * 4096 + 1024 + h * 256 + d8 * 8);
            const float wk = sWk[sidx];
            LAS unsigned short* dst = (LAS unsigned short*)(sKS + (d8 * 8) * 144 + sidx * 2);
            dst[0 * 72] = (unsigned short)f2bf(bflo(kv.x) * wk); dst[1 * 72] = (unsigned short)f2bf(bfhi(kv.x) * wk);
            dst[2 * 72] = (unsigned short)f2bf(bflo(kv.y) * wk); dst[3 * 72] = (unsigned short)f2bf(bfhi(kv.y) * wk);
            dst[4 * 72] = (unsigned short)f2bf(bflo(kv.z) * wk); dst[5 * 72] = (unsigned short)f2bf(bfhi(kv.z) * wk);
            dst[6 * 72] = (unsigned short)f2bf(bflo(kv.w) * wk); dst[7 * 72] = (unsigned short)f2bf(bfhi(kv.w) * wk); }
        __syncthreads();
        if (tid < 256) { float s = 0.f;
#pragma unroll
            for (int j = 0; j < 8; ++j) { const u32x4 w = *(const LAS u32x4*)(sKS + tid * 144 + j * 16);
                s += (bflo(w.x) + bfhi(w.x)) + (bflo(w.y) + bfhi(w.y)) + (bflo(w.z) + bfhi(w.z)) + (bflo(w.w) + bfhi(w.w)); }
            DN[(size_t)(c * 4 + h) * 256 + tid] = s; }
        bf16x8 bfr[2][4];
#pragma unroll
        for (int vb = 0; vb < 2; ++vb)
#pragma unroll
            for (int ks = 0; ks < 4; ++ks) bfr[vb][ks] = *(const bf16x8*)(KVT + (size_t)(h * 512 + (wave * 2 + vb) * 32 + r32) * M + t0 + ks * 16 + hi * 8);
#pragma unroll
        for (int dh = 0; dh < 2; ++dh) {
            f32x16 acc[4][2];
#pragma unroll
            for (int a = 0; a < 4; ++a) { acc[a][0] = f32x16{}; acc[a][1] = f32x16{}; }
#pragma unroll
            for (int db4 = 0; db4 < 4; ++db4)
#pragma unroll
                for (int ks = 0; ks < 4; ++ks) { const bf16x8 a = *(const LAS bf16x8*)(sKS + ((dh * 4 + db4) * 32 + r32) * 144 + ks * 32 + hi * 16);
                    acc[db4][0] = __builtin_amdgcn_mfma_f32_32x32x16_bf16(a, bfr[0][ks], acc[db4][0], 0, 0, 0);
                    acc[db4][1] = __builtin_amdgcn_mfma_f32_32x32x16_bf16(a, bfr[1][ks], acc[db4][1], 0, 0, 0); }
#pragma unroll
            for (int db4 = 0; db4 < 4; ++db4)
#pragma unroll
                for (int vb = 0; vb < 2; ++vb) { const int v = (wave * 2 + vb) * 32 + r32;
                    bf16_t* dp = DC + ((size_t)((c * 4 + h) * 512 + v)) * 256 + (dh * 4 + db4) * 32 + 4 * hi;
#pragma unroll
                    for (int gq = 0; gq < 4; ++gq) { u32x2 w; w.x = pk2(acc[db4][vb][4 * gq], acc[db4][vb][4 * gq + 1]); w.y = pk2(acc[db4][vb][4 * gq + 2], acc[db4][vb][4 * gq + 3]);
                        *(u32x2*)(dp + 8 * gq) = w; } }
        }
        __syncthreads();
    }
}

__device__ __forceinline__ void mlstm_stage_b(bf16_t* DC, float* DN, const float* SC, float* MS, int bid, int nblk, int tid) {
    for (int e4 = bid * 512 + tid; e4 < 131072; e4 += nblk * 512) {
        const int h = __builtin_amdgcn_readfirstlane(e4 >> 15);
        const bool do_n = (e4 & 32767) < 256, do_m = (e4 & 32767) == 0;
        u32x2* p = (u32x2*)DC + e4;
        float* np = DN + (size_t)h * 256 + (e4 & 255);
        float s0 = 0.f, s1 = 0.f, s2 = 0.f, s3 = 0.f, sn = 0.f, m = 0.f;
        u32x2 xa[16]; float na[16];
#pragma unroll
        for (int i = 0; i < 16; ++i) { xa[i] = p[(size_t)i * 131072]; na[i] = do_n ? np[(size_t)i * 1024] : 0.f; }
        for (int c = 0; c < 256; c += 16) {
            u32x2 xb[16]; float nb[16];
            const int cn = (c + 16 < 256) ? c + 16 : c;
#pragma unroll
            for (int i = 0; i < 16; ++i) { xb[i] = p[(size_t)(cn + i) * 131072]; nb[i] = do_n ? np[(size_t)(cn + i) * 1024] : 0.f; }
#pragma unroll
            for (int i = 0; i < 16; ++i) {
                const float blast = SC[((c + i) * 4 + h) * 2], mloc = SC[((c + i) * 4 + h) * 2 + 1];
                const float mn = fmaxf(blast + m, mloc), al = __expf(blast + m - mn), be = __expf(mloc - mn);
                u32x2 w; w.x = pk2(s0, s1); w.y = pk2(s2, s3);
                p[(size_t)(c + i) * 131072] = w;
                if (do_n) np[(size_t)(c + i) * 1024] = sn;
                if (do_m) MS[(c + i) * 4 + h] = m;
                s0 = al * s0 + be * bflo(xa[i].x); s1 = al * s1 + be * bfhi(xa[i].x); s2 = al * s2 + be * bflo(xa[i].y); s3 = al * s3 + be * bfhi(xa[i].y);
                sn = al * sn + be * na[i]; m = mn;
            }
#pragma unroll
            for (int i = 0; i < 16; ++i) { xa[i] = xb[i]; na[i] = nb[i]; }
        }
    }
}

__device__ __forceinline__ void mlstm_stage_c(LAS unsigned char* lds, const bf16_t* QKO, const bf16_t* KVT, const float* G, const float* gbias, const bf16_t* DC, const float* DN,
                                              const float* MS, const float* hnorm, bf16_t* HG, int bid, int nblk, int tid) {
    asm volatile("" : "+v"(tid));
    const int lane = tid & 63, wave = __builtin_amdgcn_readfirstlane(tid >> 6), r32 = lane & 31, hi = lane >> 5;
    LAS float* sB = (LAS float*)lds; LAS float* sI = sB + 64; LAS float* sMt = sB + 128; LAS float* sA = sB + 192; LAS float* sDinv = sB + 256;
    LAS float* sQn = sB + 320;
    LAS float* sSsq = sB + 832;
    LAS unsigned char* sW = lds + 5376;
    for (int u = bid; u < 1024; u += nblk) {
        const int c = u >> 2, h = u & 3, t0 = c * 64;
        if (wave == 0) {
            const float ig = G[(size_t)(t0 + lane) * 8 + h] + gbias[h];
            const float lf = log_sigmoid(G[(size_t)(t0 + lane) * 8 + 4 + h] + gbias[4 + h]);
            const float b = scan_add(lf, lane);
            const float mc = MS[c * 4 + h];
            const float pm = scan_max(ig - b, lane);
            const float mt = b + fmaxf(mc, pm);
            sB[lane] = b; sI[lane] = ig; sMt[lane] = mt; sA[lane] = expf(b + mc - mt);
        }
        { const int t = tid & 63, part = tid >> 6;
          const bf16_t* qp = QKO + (size_t)(t0 + t) * 4096 + h * 256 + part * 32; const float* np = DN + (size_t)(c * 4 + h) * 256 + part * 32;
          float s = 0.f;
#pragma unroll
          for (int j = 0; j < 4; ++j) { const u32x4 qv = *(const u32x4*)(qp + j * 8); const f32x4 n0 = *(const f32x4*)(np + j * 8), n1 = *(const f32x4*)(np + j * 8 + 4);
              s += bflo(qv.x) * n0.x + bfhi(qv.x) * n0.y + bflo(qv.y) * n0.z + bfhi(qv.y) * n0.w + bflo(qv.z) * n1.x + bfhi(qv.z) * n1.y + bflo(qv.w) * n1.z + bfhi(qv.w) * n1.w; }
          sQn[part * 64 + t] = s; }
        __syncthreads();
        if (wave < 4) {
            const int sb = wave >> 1, tb = wave & 1;
            f32x16 acc = f32x16{};
            const bf16_t* kp = QKO + (size_t)(t0 + sb * 32 + r32) * 4096 + 1024 + h * 256 + hi * 8;
            const bf16_t* qp = QKO + (size_t)(t0 + tb * 32 + r32) * 4096 + h * 256 + hi * 8;
#pragma unroll
            for (int ks = 0; ks < 16; ++ks) acc = __builtin_amdgcn_mfma_f32_32x32x16_bf16(*(const bf16x8*)(kp + ks * 16), *(const bf16x8*)(qp + ks * 16), acc, 0, 0, 0);
            const int t = tb * 32 + r32; const float bt = sB[t], mt = sMt[t];
#pragma unroll
            for (int gq = 0; gq < 4; ++gq) { const int s0 = sb * 32 + 8 * gq + 4 * hi; float wv[4];
#pragma unroll
                for (int e = 0; e < 4; ++e) { const int s = s0 + e; wv[e] = (s <= t) ? acc[4 * gq + e] * expf(bt - sB[s] + sI[s] - mt) : 0.f; }
                u32x2 w; w.x = pk2(wv[0], wv[1]); w.y = pk2(wv[2], wv[3]);
                *(LAS u32x2*)(sW + t * 144 + s0 * 2) = w; }
        }
        __syncthreads();
        if (wave == 0) { const int t = lane; float rs = 0.f;
#pragma unroll
            for (int j = 0; j < 8; ++j) { const u32x4 w = *(const LAS u32x4*)(sW + t * 144 + j * 16);
                rs += (bflo(w.x) + bfhi(w.x)) + (bflo(w.y) + bfhi(w.y)) + (bflo(w.z) + bfhi(w.z)) + (bflo(w.w) + bfhi(w.w)); }
            float qn = 0.f;
#pragma unroll
            for (int p = 0; p < 8; ++p) qn += sQn[p * 64 + t];
            const float den = sA[t] * qn + rs;
            sDinv[t] = 1.0f / fmaxf(fabsf(den), expf(-sMt[t])); }
        f32x16 acc[2][2];
#pragma unroll
        for (int a = 0; a < 2; ++a) { acc[a][0] = f32x16{}; acc[a][1] = f32x16{}; }
        { const bf16_t* q0p = QKO + (size_t)(t0 + r32) * 4096 + h * 256 + hi * 8; const bf16_t* q1p = q0p + (size_t)32 * 4096;
          const bf16_t* s0p = DC + ((size_t)((c * 4 + h) * 512 + wave * 64 + r32)) * 256 + hi * 8; const bf16_t* s1p = s0p + 32 * 256;
#pragma unroll
          for (int ks = 0; ks < 16; ++ks) { const bf16x8 b0 = *(const bf16x8*)(q0p + ks * 16), b1 = *(const bf16x8*)(q1p + ks * 16);
              const bf16x8 a0 = *(const bf16x8*)(s0p + ks * 16), a1 = *(const bf16x8*)(s1p + ks * 16);
              acc[0][0] = __builtin_amdgcn_mfma_f32_32x32x16_bf16(a0, b0, acc[0][0], 0, 0, 0); acc[0][1] = __builtin_amdgcn_mfma_f32_32x32x16_bf16(a0, b1, acc[0][1], 0, 0, 0);
              acc[1][0] = __builtin_amdgcn_mfma_f32_32x32x16_bf16(a1, b0, acc[1][0], 0, 0, 0); acc[1][1] = __builtin_amdgcn_mfma_f32_32x32x16_bf16(a1, b1, acc[1][1], 0, 0, 0); } }
        { const float a0 = sA[r32], a1 = sA[32 + r32];
#pragma unroll
          for (int vb = 0; vb < 2; ++vb) { acc[vb][0] *= a0; acc[vb][1] *= a1; } }
        { const bf16_t* v0p = KVT + (size_t)(h * 512 + wave * 64 + r32) * M + t0 + hi * 8; const bf16_t* v1p = v0p + (size_t)32 * M;
#pragma unroll
          for (int ks = 0; ks < 4; ++ks) { const bf16x8 b0 = *(const LAS bf16x8*)(sW + r32 * 144 + ks * 32 + hi * 16), b1 = *(const LAS bf16x8*)(sW + (32 + r32) * 144 + ks * 32 + hi * 16);
              const bf16x8 a0 = *(const bf16x8*)(v0p + ks * 16), a1 = *(const bf16x8*)(v1p + ks * 16);
              acc[0][0] = __builtin_amdgcn_mfma_f32_32x32x16_bf16(a0, b0, acc[0][0], 0, 0, 0); acc[0][1] = __builtin_amdgcn_mfma_f32_32x32x16_bf16(a0, b1, acc[0][1], 0, 0, 0);
              acc[1][0] = __builtin_amdgcn_mfma_f32_32x32x16_bf16(a1, b0, acc[1][0], 0, 0, 0); acc[1][1] = __builtin_amdgcn_mfma_f32_32x32x16_bf16(a1, b1, acc[1][1], 0, 0, 0); } }
        __syncthreads();
#pragma unroll
        for (int tb = 0; tb < 2; ++tb) { const float dinv = sDinv[tb * 32 + r32]; float ss = 0.f;
#pragma unroll
            for (int vb = 0; vb < 2; ++vb) { acc[vb][tb] *= dinv;
#pragma unroll
                for (int r = 0; r < 16; ++r) ss += acc[vb][tb][r] * acc[vb][tb][r]; }
            ss += __shfl_xor(ss, 32);
            if (hi == 0) sSsq[wave * 64 + tb * 32 + r32] = ss; }
        __syncthreads();
#pragma unroll
        for (int tb = 0; tb < 2; ++tb) { const int t = tb * 32 + r32; float tot = 0.f;
#pragma unroll
            for (int w = 0; w < 8; ++w) tot += sSsq[w * 64 + t];
            const float rstd = 1.0f / sqrtf(tot * (1.0f / 512.0f) + EPS);
#pragma unroll
            for (int vb = 0; vb < 2; ++vb)
#pragma unroll
                for (int gq = 0; gq < 4; ++gq) { const int v0 = wave * 64 + vb * 32 + 8 * gq + 4 * hi;
                    const u32x2 ow = *(const u32x2*)(QKO + (size_t)(t0 + t) * 4096 + 2048 + h * 512 + v0);
                    const f32x4 gn = *(const f32x4*)(hnorm + h * 512 + v0);
                    const float o0 = acc[vb][tb][4 * gq] * rstd * gn.x * sigmoidf_(bflo(ow.x)), o1 = acc[vb][tb][4 * gq + 1] * rstd * gn.y * sigmoidf_(bfhi(ow.x));
                    const float o2 = acc[vb][tb][4 * gq + 2] * rstd * gn.z * sigmoidf_(bflo(ow.y)), o3 = acc[vb][tb][4 * gq + 3] * rstd * gn.w * sigmoidf_(bfhi(ow.y));
                    u32x2 w; w.x = pk2(o0, o1); w.y = pk2(o2, o3);
                    *(u32x2*)(HG + (size_t)(t0 + t) * 2048 + h * 512 + v0) = w; } }
        __syncthreads();
    }
}

__device__ __forceinline__ void mla_latent_norm(const float* C, const float* qn, const float* kvn, bf16_t* CQN, bf16_t* CKVN, float* KR) {
    const int tid = opaque_tid(), lane = tid & 63, gw = blockIdx.x * NWAVES + __builtin_amdgcn_readfirstlane(tid >> 6), ngw = gridDim.x * NWAVES;
    for (int m = gw; m < M; m += ngw) {
        KR[(size_t)m * 64 + lane] = C[(size_t)m * 1280 + 1024 + lane];
        const float* cr = C + (size_t)m * 1280 + 4 * lane;
        f32x4 a[2], b[2]; float sa = 0.f, sb = 0.f;
#pragma unroll
        for (int j = 0; j < 2; ++j) { a[j] = *(const f32x4*)(cr + 256 * j); b[j] = *(const f32x4*)(cr + 512 + 256 * j);
            sa += (a[j].x * a[j].x + a[j].y * a[j].y) + (a[j].z * a[j].z + a[j].w * a[j].w); sb += (b[j].x * b[j].x + b[j].y * b[j].y) + (b[j].z * b[j].z + b[j].w * b[j].w); }
        const float ra = 1.0f / sqrtf(wave_sum(sa) * (1.0f / 512.0f) + EPS), rb = 1.0f / sqrtf(wave_sum(sb) * (1.0f / 512.0f) + EPS);
#pragma unroll
        for (int j = 0; j < 2; ++j) { const f32x4 ga = *(const f32x4*)(qn + 4 * lane + 256 * j), gb = *(const f32x4*)(kvn + 4 * lane + 256 * j);
            u32x2 w; w.x = pk2(a[j].x * ra * ga.x, a[j].y * ra * ga.y); w.y = pk2(a[j].z * ra * ga.z, a[j].w * ra * ga.w);
            *(u32x2*)(CQN + (size_t)m * 512 + 4 * lane + 256 * j) = w;
            w.x = pk2(b[j].x * rb * gb.x, b[j].y * rb * gb.y); w.y = pk2(b[j].z * rb * gb.z, b[j].w * rb * gb.w);
            *(u32x2*)(CKVN + (size_t)m * 512 + 4 * lane + 256 * j) = w; }
    }
}
__device__ __forceinline__ void mla_qk_norm_rope(bf16_t* Q, const bf16_t* KVRAW, const float* KR, const int* pos, const float* qkn, bf16_t* KF, LAS unsigned char* lds) {
    const int tid = opaque_tid(), lane = tid & 63, wave = __builtin_amdgcn_readfirstlane(tid >> 6), gw = blockIdx.x * NWAVES + wave, ngw = gridDim.x * NWAVES;
    LAS unsigned short* skr = (LAS unsigned short*)(lds + wave * 256);
    const float QS = 0.07216878364870322f * 1.4426950408889634f;
    const int i32 = lane & 31;
    const double freq = exp2(-(double)i32 * (13.287712379549449 / 32.0));
    const float gqn0 = qkn[2 * lane], gqn1 = qkn[2 * lane + 1], gqr = qkn[128 + lane], gkr = qkn[192 + 128 + lane];
    const int kh = lane >> 2, kp = lane & 3;
    f32x4 gk[8];
#pragma unroll
    for (int e = 0; e < 8; ++e) gk[e] = *(const f32x4*)(qkn + 192 + kp * 32 + e * 4);
    for (int m = gw; m < M; m += ngw) {
        const double ang = (double)pos[m] * freq;
        const double red = ang - 6.283185307179586476925 * rint(ang * 0.15915494309189533577);
        const float sn = sinf((float)red), cs = cosf((float)red);
        { const float x = KR[(size_t)m * 64 + lane]; const float r = 1.0f / sqrtf(wave_sum(x * x) * (1.0f / 64.0f) + EPS);
          const float xn = x * r * gkr; const float pr = __shfl_xor(xn, 32);
          const float kr = (lane < 32) ? (xn * cs - pr * sn) : (xn * cs + pr * sn);
          skr[lane] = (unsigned short)f2bf(kr); }
        { const bf16_t* kp_ = KVRAW + (size_t)m * 4096 + kh * 256 + kp * 32; bf16_t* kf_ = KF + (size_t)m * 3072 + kh * 192;
          u32x4 w[4]; float ss = 0.f;
#pragma unroll
          for (int e = 0; e < 4; ++e) { w[e] = *(const u32x4*)(kp_ + e * 8);
              ss += (bflo(w[e].x) * bflo(w[e].x) + bfhi(w[e].x) * bfhi(w[e].x)) + (bflo(w[e].y) * bflo(w[e].y) + bfhi(w[e].y) * bfhi(w[e].y))
                  + (bflo(w[e].z) * bflo(w[e].z) + bfhi(w[e].z) * bfhi(w[e].z)) + (bflo(w[e].w) * bflo(w[e].w) + bfhi(w[e].w) * bfhi(w[e].w)); }
          ss += __shfl_xor(ss, 1); ss += __shfl_xor(ss, 2);
          const float r3 = 1.0f / sqrtf(ss * (1.0f / 128.0f) + EPS);
#pragma unroll
          for (int e = 0; e < 4; ++e) { const f32x4 g0 = gk[2 * e], g1 = gk[2 * e + 1]; u32x4 o;
              o.x = pk2(bflo(w[e].x) * r3 * g0.x, bfhi(w[e].x) * r3 * g0.y); o.y = pk2(bflo(w[e].y) * r3 * g0.z, bfhi(w[e].y) * r3 * g0.w);
              o.z = pk2(bflo(w[e].z) * r3 * g1.x, bfhi(w[e].z) * r3 * g1.y); o.w = pk2(bflo(w[e].w) * r3 * g1.z, bfhi(w[e].w) * r3 * g1.w);
              *(u32x4*)(kf_ + kp * 32 + e * 8) = o; }
          asm volatile("s_waitcnt lgkmcnt(0)" ::: "memory");
          const u32x4 k0 = *(const LAS u32x4*)(skr + kp * 16), k1 = *(const LAS u32x4*)(skr + kp * 16 + 8);
          *(u32x4*)(kf_ + 128 + kp * 16) = k0; *(u32x4*)(kf_ + 128 + kp * 16 + 8) = k1; }
        bf16_t* qrow = Q + (size_t)m * 3072;
#pragma unroll 4
        for (int hh = 0; hh < 16; ++hh) {
            const unsigned qw = *(const unsigned*)(qrow + hh * 192 + 2 * lane);
            const float qr_ = bf2f(qrow[hh * 192 + 128 + lane]);
            const float q0 = bflo(qw), q1 = bfhi(qw);
            float s1 = q0 * q0 + q1 * q1, s2 = qr_ * qr_;
#pragma unroll
            for (int o = 1; o < 64; o <<= 1) { s1 += __shfl_xor(s1, o); s2 += __shfl_xor(s2, o); }
            const float r1 = QS / sqrtf(s1 * (1.0f / 128.0f) + EPS), r2 = 1.0f / sqrtf(s2 * (1.0f / 64.0f) + EPS);
            *(unsigned*)(qrow + hh * 192 + 2 * lane) = pk2(q0 * r1 * gqn0, q1 * r1 * gqn1);
            const float xn = qr_ * r2 * gqr; const float pr = __shfl_xor(xn, 32);
            const float qo = ((lane < 32) ? (xn * cs - pr * sn) : (xn * cs + pr * sn)) * QS;
            qrow[hh * 192 + 128 + lane] = (unsigned short)f2bf(qo);
        }
    }
}

namespace att {
constexpr int SHM_V = 16384, SHM_K = 24576, OFF_V = 0, OFF_K = 3 * SHM_V, OFF_WS = OFF_K + 3 * SHM_K;
#define SBAR() __builtin_amdgcn_sched_barrier(0)
__device__ __forceinline__ int v_st(int k, int c) { const int kk = (k & ~0xC) | ((k & 4) << 1) | ((k & 8) >> 1); return ((kk >> 3) * 4 + (c >> 5)) * 512 + ((kk & 7) * 32 + (c & 31)) * 2; }
__device__ __forceinline__ int v_rd_base(int lane) { return ((lane & 3) << 3) | (((lane >> 2) & 3) << 6) | (((lane >> 4) & 1) << 5) | (((lane >> 5) & 1) << 8); }
constexpr int v_rd_off(int d0, int ks, int half) { return d0 * 512 + ks * 4096 + half * 2048; }
__device__ __forceinline__ int crow(int r, int hi) { return (r & 3) + 8 * (r >> 2) + 4 * hi; }
__device__ __forceinline__ unsigned cvtpk(float lo, float hi) { unsigned r; asm volatile("v_cvt_pk_bf16_f32 %0, %1, %2" : "=v"(r) : "v"(lo), "v"(hi)); return r; }
__device__ __forceinline__ void mask_tile(f32x16& p0, f32x16& p1, int dq) {
    const float NEG = -__builtin_inff();
#pragma unroll
    for (int r = 0; r < 16; ++r) { const int c = (r & 3) + 8 * (r >> 2);
        if (dq - c < 0) p0[r] = NEG;
        if (dq - c - 32 < 0) p1[r] = NEG; }
}
__device__ __forceinline__ void partialSM(f32x16& p0, f32x16& p1, float& m_reg, float& alpha, f32x16& negm) {
    float pmax = p0[0];
#pragma unroll
    for (int r = 1; r < 16; ++r) pmax = fmaxf(pmax, p0[r]);
#pragma unroll
    for (int r = 0; r < 16; ++r) pmax = fmaxf(pmax, p1[r]);
    { auto rr = __builtin_amdgcn_permlane32_swap(__float_as_uint(pmax), __float_as_uint(pmax), false, false);
      pmax = fmaxf(__uint_as_float(rr[0]), __uint_as_float(rr[1])); }
    if (__builtin_expect(__all(pmax <= 8.0f), 1)) { alpha = 1.f; }
    else { const float dl = fmaxf(pmax, 0.f); m_reg += dl; alpha = __builtin_amdgcn_exp2f(-dl);
#pragma unroll
        for (int r = 0; r < 16; ++r) { p0[r] -= dl; p1[r] -= dl; }
#pragma unroll
        for (int r = 0; r < 16; ++r) negm[r] = -m_reg; }
#pragma unroll
    for (int r = 0; r < 16; ++r) p0[r] = __builtin_amdgcn_exp2f(p0[r]);
#pragma unroll
    for (int r = 0; r < 16; ++r) p1[r] = __builtin_amdgcn_exp2f(p1[r]);
}
__device__ __forceinline__ void finishSM(f32x16& p0, f32x16& p1, float alpha, float& l_reg, bf16x8& pa0, bf16x8& pa1, bf16x8& pa2, bf16x8& pa3) {
    float ps = 0;
#pragma unroll
    for (int r = 0; r < 16; ++r) ps += p0[r];
#pragma unroll
    for (int r = 0; r < 16; ++r) ps += p1[r];
    { auto rr = __builtin_amdgcn_permlane32_swap(__float_as_uint(ps), __float_as_uint(ps), false, false);
      ps = __uint_as_float(rr[0]) + __uint_as_float(rr[1]); }
    l_reg = l_reg * alpha + ps;
#define PK4(P, B_, OUT) do { unsigned a0 = cvtpk(P[B_+0], P[B_+1]), a1 = cvtpk(P[B_+2], P[B_+3]);                          \
        unsigned b0 = cvtpk(P[B_+4], P[B_+5]), b1 = cvtpk(P[B_+6], P[B_+7]);                                             \
        auto r0 = __builtin_amdgcn_permlane32_swap(a0, b0, false, false); auto r1 = __builtin_amdgcn_permlane32_swap(a1, b1, false, false); \
        u32x4 w = {r0[0], r1[0], r0[1], r1[1]}; OUT = *reinterpret_cast<bf16x8*>(&w); } while (0)
    PK4(p0, 0, pa0); PK4(p0, 8, pa1); PK4(p1, 0, pa2); PK4(p1, 8, pa3);
#undef PK4
}
__device__ __forceinline__ int kswz(int row, int colB) { return row * 384 + (colB ^ (((row >> 1) & 7) << 4)); }
__device__ __forceinline__ void qkt(f32x16& p0, f32x16& p1, const LAS unsigned char* Kb, int r32, int hi, const bf16x8* qr, const f32x16& negm) {
    const LAS unsigned char* kb[4];
#pragma unroll
    for (int dd = 0; dd < 4; ++dd) kb[dd] = Kb + kswz(r32, dd * 32 + hi * 16);
#pragma unroll
    for (int d0 = 0; d0 < 12; ++d0) { const LAS unsigned char* a = kb[d0 & 3] + (d0 >> 2) * 128;
        const bf16x8 b0 = *(const LAS bf16x8*)a;
        const bf16x8 b1 = *(const LAS bf16x8*)(a + 32 * 384);
        p0 = __builtin_amdgcn_mfma_f32_32x32x16_bf16(b0, qr[d0], d0 == 0 ? negm : p0, 0, 0, 0);
        p1 = __builtin_amdgcn_mfma_f32_32x32x16_bf16(b1, qr[d0], d0 == 0 ? negm : p1, 0, 0, 0); }
}
__device__ __forceinline__ void pv_tile(f32x16* o, int vb0, bf16x8 pa0, bf16x8 pa1, bf16x8 pa2, bf16x8 pa3) {
#define TRRD(dst, off) asm volatile("ds_read_b64_tr_b16 %0, %1 offset:%2" : "=&v"(dst) : "v"(vb0), "i"(off) : "memory")
#define RD8(S, d0) do { constexpr int b_ = v_rd_off(d0, 0, 0); TRRD(S##l0, b_); TRRD(S##h0, b_ + 2048); TRRD(S##l1, b_ + 4096); TRRD(S##h1, b_ + 6144); \
        TRRD(S##l2, b_ + 8192); TRRD(S##h2, b_ + 10240); TRRD(S##l3, b_ + 12288); TRRD(S##h3, b_ + 14336); } while (0)
#define MM4(S, d0) do { \
        o[d0] = __builtin_amdgcn_mfma_f32_32x32x16_bf16(pa0, (bf16x8){S##l0[0], S##l0[1], S##l0[2], S##l0[3], S##h0[0], S##h0[1], S##h0[2], S##h0[3]}, o[d0], 0, 0, 0); \
        o[d0] = __builtin_amdgcn_mfma_f32_32x32x16_bf16(pa1, (bf16x8){S##l1[0], S##l1[1], S##l1[2], S##l1[3], S##h1[0], S##h1[1], S##h1[2], S##h1[3]}, o[d0], 0, 0, 0); \
        o[d0] = __builtin_amdgcn_mfma_f32_32x32x16_bf16(pa2, (bf16x8){S##l2[0], S##l2[1], S##l2[2], S##l2[3], S##h2[0], S##h2[1], S##h2[2], S##h2[3]}, o[d0], 0, 0, 0); \
        o[d0] = __builtin_amdgcn_mfma_f32_32x32x16_bf16(pa3, (bf16x8){S##l3[0], S##l3[1], S##l3[2], S##l3[3], S##h3[0], S##h3[1], S##h3[2], S##h3[3]}, o[d0], 0, 0, 0); } while (0)
#define WAITL(n) do { asm volatile("s_waitcnt lgkmcnt(" #n ")" ::: "memory"); SBAR(); } while (0)
    s16x4 Al0, Al1, Al2, Al3, Ah0, Ah1, Ah2, Ah3, Bl0, Bl1, Bl2, Bl3, Bh0, Bh1, Bh2, Bh3;
    RD8(A, 0); RD8(B, 1); SBAR();
    WAITL(8); MM4(A, 0); SBAR();
    RD8(A, 2); SBAR();
    WAITL(8); MM4(B, 1); SBAR();
    RD8(B, 3); SBAR();
    WAITL(8); MM4(A, 2); SBAR();
    WAITL(0); MM4(B, 3);
#undef WAITL
#undef MM4
#undef RD8
#undef TRRD
}
__device__ __forceinline__ void attn_unit(unsigned char* ldsg, const bf16_t* QF, const bf16_t* KF, const bf16_t* KVRAW, bf16_t* O, int h, int qb, int tid) {
    asm volatile("" : "+v"(tid));
    LAS unsigned char* lds = (LAS unsigned char*)ldsg;
    const int wid = __builtin_amdgcn_readfirstlane(tid >> 6), lane = tid & 63, r32 = lane & 31, hi = lane >> 5;
    const int q0 = qb * 256, NT = 4 * (qb + 1);
    const int qlo = q0 + wid * 32, qm = qlo + r32 - 4 * hi;
    LAS float* ws = (LAS float*)(lds + OFF_WS) + wid * 64; LAS float* li_l = ws; LAS float* al_l = ws + 32;
    int kgo[3], vgo[2];
#pragma unroll
    for (int i = 0; i < 3; ++i) { const int off = ((wid * 3 + i) * 64 + lane) * 16, row = off / 384, c1 = (off - row * 384) >> 4, ch = (c1 & ~7) | ((c1 & 7) ^ ((row >> 1) & 7)); kgo[i] = row * 3072 + ch * 8; }
#pragma unroll
    for (int i = 0; i < 2; ++i) { const int off = ((wid * 2 + i) * 64 + lane) * 16, sub = off >> 9, kkh = sub >> 2, cb = sub & 3, w = (off & 511) >> 1, kk = kkh * 8 + (w >> 5), cc = w & 31;
        const int k = (kk & ~0xC) | ((kk & 4) << 1) | ((kk & 8) >> 1); vgo[i] = k * 4096 + cb * 32 + cc; }
    const bf16_t* Kh = KF + h * 192; const bf16_t* Vh = KVRAW + h * 256 + 128;
    const int vb_base = (int)(unsigned)(uintptr_t)(ldsg + OFF_V) + v_rd_base(lane);
    bf16x8 qr[12];
#pragma unroll
    for (int d0 = 0; d0 < 12; ++d0) qr[d0] = *(const bf16x8*)(QF + (size_t)(qlo + r32) * 3072 + h * 192 + d0 * 16 + hi * 8);
#define ADMA(kb_, slot_) do { \
        _Pragma("unroll") for (int i = 0; i < 3; ++i) __builtin_amdgcn_global_load_lds((const unsigned*)(Kh + (size_t)(kb_) * 3072 + kgo[i]), (LAS unsigned*)(lds + OFF_K + (slot_) * SHM_K + (wid * 3 + i) * 1024), 16, 0, 0); \
        _Pragma("unroll") for (int i = 0; i < 2; ++i) __builtin_amdgcn_global_load_lds((const unsigned*)(Vh + (size_t)(kb_) * 4096 + vgo[i]), (LAS unsigned*)(lds + OFF_V + (slot_) * SHM_V + (wid * 2 + i) * 1024), 16, 0, 0); } while (0)
    ADMA(0, 0); ADMA(64, 1);
    __syncthreads();
    float m_reg = 0.f, l_reg = 0.f; f32x16 o[4];
    f32x16 negm = f32x16{}; asm volatile("" : "+v"(negm));
#pragma unroll
    for (int d = 0; d < 4; ++d) o[d] = f32x16{};
    int sj = 0, sn = 1, s2 = 2;
    for (int j = 0; j < NT; ++j) {
        const int kb = j * 64;
        if (j + 2 < NT) ADMA(kb + 128, s2);
        if (kb <= qlo + 31) {
            f32x16 p0, p1; float alpha; bf16x8 pa0, pa1, pa2, pa3;
            qkt(p0, p1, lds + OFF_K + sj * SHM_K, r32, hi, qr, negm);
            if (kb + 63 > qlo) mask_tile(p0, p1, qm - kb);
            partialSM(p0, p1, m_reg, alpha, negm);
            finishSM(p0, p1, alpha, l_reg, pa0, pa1, pa2, pa3);
            if (__any(alpha < 1.f)) { if (hi == 0) al_l[r32] = alpha; asm volatile("s_waitcnt lgkmcnt(0)" ::: "memory");
#pragma unroll
                for (int d_ = 0; d_ < 4; ++d_)
#pragma unroll
                    for (int r = 0; r < 16; ++r) o[d_][r] *= al_l[crow(r, hi)]; }
            SBAR();
            pv_tile(o, vb_base + sj * SHM_V, pa0, pa1, pa2, pa3);
        }
        { const int t_ = sj; sj = sn; sn = s2; s2 = t_; }
        __syncthreads();
    }
#undef ADMA
    if (hi == 0) li_l[r32] = l_reg; asm volatile("s_waitcnt lgkmcnt(0)" ::: "memory");
    float rli[16];
#pragma unroll
    for (int r = 0; r < 16; ++r) rli[r] = 1.0f / li_l[crow(r, hi)];
    bf16_t* Ow = O + (size_t)qlo * 2048 + h * 128;
#pragma unroll
    for (int r = 0; r < 16; ++r) { const int orow = crow(r, hi);
#pragma unroll
        for (int d0 = 0; d0 < 4; ++d0) { const float v = o[d0][r] * rli[r]; const float vn = __shfl_xor(v, 1);
            if ((r32 & 1) == 0) *(unsigned*)(Ow + (size_t)orow * 2048 + d0 * 32 + r32) = cvtpk(v, vn); } }
    __syncthreads();
}
#undef SBAR
}


#define XB_TMO      128
#define XB_XCNT(j)  (256  + 64 * (j))
#define XB_XSUB(j)  (1280 + 64 * (j))
#define XB_XGEN(j)  (2304 + 64 * (j))
#define XB_TOP      3328
#define XB_TOPGEN   3392
#define XCD_BAR_WORDS 3456
#define XB_SPIN_CAP (1u << 22)
__device__ __forceinline__ unsigned xb_ld(unsigned* p)              { return __hip_atomic_load(p, __ATOMIC_RELAXED, __HIP_MEMORY_SCOPE_AGENT); }
__device__ __forceinline__ unsigned xb_add(unsigned* p, unsigned v) { return __hip_atomic_fetch_add(p, v, __ATOMIC_RELAXED, __HIP_MEMORY_SCOPE_AGENT); }
__device__ __forceinline__ unsigned xb_xcc_id() { return (unsigned)__builtin_amdgcn_s_getreg((3 << 11) | 20) & 0xFu; }
#define XB_SPIN(cond, bar) do { unsigned _sp = 0; while (cond) { __builtin_amdgcn_s_sleep(1); \
    if ((++_sp & 255u) == 0u) { if (xb_ld(&(bar)[XB_TMO])) break; if (_sp > XB_SPIN_CAP) { atomicAdd(&(bar)[XB_TMO], 1u); break; } } } } while (0)
struct XcdBarrier { unsigned* bar; unsigned x; volatile LAS unsigned* st; };
__device__ __forceinline__ XcdBarrier xcd_barrier_post(unsigned* bar, volatile LAS unsigned* st) {
    XcdBarrier b; b.bar = bar; b.x = xb_xcc_id(); b.st = st;
    if (threadIdx.x == 0) (void)xb_add(&bar[XB_XCNT(b.x)], 1u);
    return b;
}
__device__ __forceinline__ void xcd_barrier_complete(unsigned* bar, unsigned x, unsigned& nloc, unsigned& nx) {
    const unsigned G = gridDim.x * gridDim.y * gridDim.z;
    unsigned sum, cnt, mine, sp = 0u;
    for (;;) {
        sum = 0u; cnt = 0u; mine = 0u;
#pragma unroll
        for (unsigned j = 0; j < 16; ++j) { const unsigned c = xb_ld(&bar[XB_XCNT(j)]); sum += c; cnt += (c > 0u) ? 1u : 0u; mine = (j == x) ? c : mine; }
        if (sum == G) break;
        __builtin_amdgcn_s_sleep(1);
        if ((++sp & 255u) == 0u) { if (xb_ld(&bar[XB_TMO])) break; if (sp > XB_SPIN_CAP) { atomicAdd(&bar[XB_TMO], 1u); break; } }
    }
    nloc = mine > 0u ? mine : 1u; nx = cnt > 0u ? cnt : 1u;
}
__device__ __forceinline__ void xcd_barrier(const XcdBarrier& b) {
    asm volatile("s_waitcnt vmcnt(0)" ::: "memory");
    __syncthreads();
    if (threadIdx.x == 0) {
        unsigned* bar = b.bar;
        __builtin_amdgcn_s_waitcnt(0);
        unsigned nloc = b.st[0], nx = b.st[1];
        if (nloc == 0u) { xcd_barrier_complete(bar, b.x, nloc, nx); b.st[0] = nloc; b.st[1] = nx; }
        const unsigned old = xb_add(&bar[XB_XSUB(b.x)], 1u);
        const unsigned gen = old / nloc;
        if (old + 1u == (gen + 1u) * nloc) {
            __builtin_amdgcn_fence(__ATOMIC_RELEASE, "agent");
            asm volatile("s_waitcnt vmcnt(0)" ::: "memory");
            const unsigned og = xb_add(&bar[XB_TOP], 1u);
            const unsigned tg = og / nx;
            if (og + 1u == (tg + 1u) * nx) xb_add(&bar[XB_TOPGEN], 1u);
            else XB_SPIN(xb_ld(&bar[XB_TOPGEN]) == tg, bar);
            __builtin_amdgcn_fence(__ATOMIC_ACQUIRE, "agent");
            xb_add(&bar[XB_XGEN(b.x)], 1u);
            asm volatile("s_waitcnt vmcnt(0)" ::: "memory");
        } else {
            XB_SPIN(xb_ld(&bar[XB_XGEN(b.x)]) == gen, bar);
            __builtin_amdgcn_fence(__ATOMIC_ACQUIRE, "agent");
            asm volatile("s_waitcnt vmcnt(0)" ::: "memory");
        }
    }
    __syncthreads();
}

constexpr size_t MiB = (size_t)1 << 20;
constexpr size_t OFF_XN = 1 * MiB;
constexpr size_t OFF_XB = OFF_XN + 64 * MiB;
constexpr size_t OFF_WGU = OFF_XB + 64 * MiB;
constexpr size_t OFF_WD = OFF_WGU + 44 * MiB;
constexpr size_t OFF_WMIA = OFF_WD + 22 * MiB;
constexpr size_t OFF_WMIB = OFF_WMIA + 17 * MiB;
constexpr size_t OFF_WMO = OFF_WMIB + 12 * MiB;
constexpr size_t OFF_WAI = OFF_WMO + 8 * MiB;
constexpr size_t OFF_WUQ = OFF_WAI + 5 * MiB;
constexpr size_t OFF_WUKV = OFF_WUQ + 3 * MiB;
constexpr size_t OFF_WAO = OFF_WUKV + 4 * MiB;
constexpr size_t OFF_BIG = OFF_WAO + 8 * MiB;
constexpr size_t OFF_H = OFF_BIG;
constexpr size_t OFF_WGU2 = OFF_BIG + 180 * MiB;
constexpr size_t OFF_WD2 = OFF_WGU2 + 44 * MiB;
constexpr size_t OFF_SSQ = 131072;
constexpr size_t OFF_QKO = OFF_BIG;
constexpr size_t OFF_KVT = OFF_QKO + 128 * MiB;
constexpr size_t OFF_DC = OFF_KVT + 96 * MiB;
constexpr size_t OFF_DN = OFF_DC + 256 * MiB;
constexpr size_t OFF_G = OFF_DN + 1 * MiB;
constexpr size_t OFF_SC = OFF_G + 1 * MiB;
constexpr size_t OFF_MS = OFF_SC + 65536;
constexpr size_t END_MLSTM = OFF_MS + 65536;
constexpr size_t OFF_C = OFF_BIG;
constexpr size_t OFF_KF = OFF_C;
constexpr size_t OFF_CQN = OFF_KF + 96 * MiB;
constexpr size_t OFF_CKVN = OFF_CQN + 16 * MiB;
constexpr size_t OFF_Q = OFF_CKVN + 16 * MiB;
constexpr size_t OFF_KVRAW = OFF_Q + 96 * MiB;
constexpr size_t OFF_KR = OFF_KVRAW + 128 * MiB;
constexpr size_t END_MLA = OFF_KR + 4 * MiB;
constexpr size_t WS_NEED = END_MLA > END_MLSTM ? END_MLA : END_MLSTM;

struct Args {
    const float* x; const int* pos;
    const float* ffn1_norm; const float* ffn1_wgu; const float* ffn1_wd; const float* mix_norm; const float* ffn2_norm; const float* ffn2_wgu; const float* ffn2_wd;
    const float* ml_win; const float* ml_gb; const float* ml_hn; const float* ml_wout;
    const float* mla_win; const float* mla_qn; const float* mla_kvn; const float* mla_wuq; const float* mla_wukv; const float* mla_qkn; const float* mla_wout;
    float* out; unsigned char* ws;
};

__global__ void __launch_bounds__(NWAVES * 64, 2) mega_fwd(Args a) {
    extern __shared__ __attribute__((aligned(16))) unsigned char lds_g[];
    cg::grid_group grid = cg::this_grid();
    LAS unsigned char* lds = (LAS unsigned char*)lds_g;
    const int tid = threadIdx.x;
    const int G = gridDim.x, bid = blockIdx.x;
    const int vcu = (G % 8 == 0) ? (bid % 8) * (G / 8) + bid / 8 : bid;
    volatile LAS unsigned* bst = (volatile LAS unsigned*)(lds + LDS_BYTES - 64);
    if (tid < 16) bst[tid] = 0u;
    __syncthreads();
    XcdBarrier xbar = xcd_barrier_post((unsigned*)a.ws + 4096, bst);
#define GSYNC() xcd_barrier(xbar)
    unsigned char* ws = a.ws;
    bf16_t* XN = (bf16_t*)(ws + OFF_XN);
    bf16_t* WGU = (bf16_t*)(ws + OFF_WGU); bf16_t* WD = (bf16_t*)(ws + OFF_WD);
    bf16_t* WMIA = (bf16_t*)(ws + OFF_WMIA); bf16_t* WMIB = (bf16_t*)(ws + OFF_WMIB); bf16_t* WMO = (bf16_t*)(ws + OFF_WMO);
    bf16_t* WAI = (bf16_t*)(ws + OFF_WAI); bf16_t* WUQ = (bf16_t*)(ws + OFF_WUQ); bf16_t* WUKV = (bf16_t*)(ws + OFF_WUKV); bf16_t* WAO = (bf16_t*)(ws + OFF_WAO);
    bf16_t* Hb = (bf16_t*)(ws + OFF_H);
    bf16_t* QKO = (bf16_t*)(ws + OFF_QKO); bf16_t* KVT = (bf16_t*)(ws + OFF_KVT); bf16_t* DC = (bf16_t*)(ws + OFF_DC);
    float* DN = (float*)(ws + OFF_DN); float* Gt = (float*)(ws + OFF_G); float* SC = (float*)(ws + OFF_SC); float* MS = (float*)(ws + OFF_MS);
    float* Cb = (float*)(ws + OFF_C); bf16_t* KF = (bf16_t*)(ws + OFF_KF); bf16_t* CQN = (bf16_t*)(ws + OFF_CQN); bf16_t* CKVN = (bf16_t*)(ws + OFF_CKVN);
    bf16_t* Qb = (bf16_t*)(ws + OFF_Q); bf16_t* KVRAW = (bf16_t*)(ws + OFF_KVRAW); float* KR = (float*)(ws + OFF_KR);

    bf16_t* XB = (bf16_t*)(ws + OFF_XB); bf16_t* WGU2 = (bf16_t*)(ws + OFF_WGU2); bf16_t* WD2 = (bf16_t*)(ws + OFF_WD2);
    float* SSQ = (float*)(ws + OFF_SSQ);
#define SSQ_(i) (SSQ + (size_t)(i) * M)
#define CONV_FFN(wgu_, wd_, norm_, layer, WGU_, WD_) do { for (int rep_ = 0; rep_ < REP_CONV; ++rep_) { \
        conv_matrix((wgu_) + (size_t)(layer) * D * 2 * FF, D, 2 * FF, 0, 2 * FF, (WGU_), 0, 1, (norm_) + (layer) * D, lds); \
        conv_matrix((wd_) + (size_t)(layer) * FF * D, FF, D, 0, D, (WD_), 0, 0, nullptr, lds); } \
        __syncthreads();   } while (0)
#define GEMM_GU(WGU_, ssq_) do { for (int rep_ = 0; rep_ < REP_GU; ++rep_) { pg8::Gemm g{XB, (WGU_), M, 2 * FF, D}; pg8::StaticOrder S; S.init(M, 2 * FF, G, bid); pg8::EpiSwiGLU E{Hb, (ssq_)}; pg8::gemm_phase<pg8::EpiSwiGLU>(lds, g, S, E); } } while (0)
#define GEMM_DOWN(WD_, basef_, out_, xb_, ssqo_) do { pg8::Gemm g{Hb, (WD_), M, D, FF}; pg8::StaticOrder S; S.init(M, D, G, bid, 0, 4); pg8::EpiRes E{XB, (basef_), (out_), D, 0.5f, (xb_), (ssqo_)}; pg8::gemm_phase<pg8::EpiRes>(lds, g, S, E); } while (0)

    CONV_FFN(a.ffn1_wgu, a.ffn1_wd, a.ffn1_norm, 0, WGU, WD);
    conv_matrix(a.ml_win, D, 6152, 0, 2048, WMIA, 0, 0, a.mix_norm, lds);
    conv_matrix(a.ml_win, D, 6152, 4096, 2048, WMIA, 2048, 0, a.mix_norm, lds);
    conv_matrix(a.ml_win, D, 6152, 2048, 2048, WMIB, 0, 0, a.mix_norm, lds);
    { const int gt = bid * 512 + opaque_tid(), ngt = G * 512;
      for (int i = gt; i < 8 * D; i += ngt) { const int k = i >> 3, j = i & 7; WMIA[(size_t)(4096 + j) * D + k] = (bf16_t)f2bf(a.ml_win[(size_t)k * 6152 + 6144 + j] * a.mix_norm[k]); }
      u32x4 z = {0u, 0u, 0u, 0u};
      for (int i = gt; i < 248 * D / 8; i += ngt) *(u32x4*)(WMIA + (size_t)4104 * D + (size_t)i * 8) = z;
      for (int i = gt; i < 192 * D / 8; i += ngt) *(u32x4*)(WAI + (size_t)1088 * D + (size_t)i * 8) = z;
      for (int i = gt; i < 7 * M / 4; i += ngt) *(u32x4*)(SSQ_(1) + (size_t)i * 4) = z; }
    conv_matrix(a.ml_wout, D, D, 0, D, WMO, 0, 0, nullptr, lds);
    conv_matrix(a.mla_win, D, 1088, 0, 1088, WAI, 0, 0, a.mix_norm + D, lds);
    conv_matrix(a.mla_wuq, 512, 3072, 0, 3072, WUQ, 0, 0, a.mla_qn, lds);
    conv_matrix(a.mla_wukv, 512, 4096, 0, 4096, WUKV, 0, 0, a.mla_kvn, lds);
    conv_matrix(a.mla_wout, D, D, 0, D, WAO, 0, 0, nullptr, lds);
    cast_rows_ssq(a.x, XB, SSQ_(0));
    if (a.ws == nullptr) grid.sync();
    GSYNC();

    GEMM_GU(WGU, SSQ_(0)); GSYNC();
    GEMM_DOWN(WD, a.x, nullptr, XB, SSQ_(1)); GSYNC();
    CONV_FFN(a.ffn2_wgu, a.ffn2_wd, a.ffn2_norm, 0, WGU, WD);
    for (int rep_ = 0; rep_ < REP_OTHER; ++rep_) { pg8::Gemm g{XB, WMIA, M, 4352, D}; pg8::StaticOrder S; S.init(M, 4352, G, bid); pg8::EpiMlstmIn E{QKO, Gt, SSQ_(1)}; pg8::gemm_phase<pg8::EpiMlstmIn>(lds, g, S, E); }
    for (int rep_ = 0; rep_ < REP_OTHER; ++rep_) { pg8::Gemm g{WMIB, XB, 2048, M, D}; pg8::StaticOrder S; S.init(2048, M, G, bid); pg8::EpiBf16 E{KVT, M, SSQ_(1), nullptr}; pg8::gemm_phase<pg8::EpiBf16>(lds, g, S, E); }
    GSYNC();
    mlstm_stage_a(lds, QKO, KVT, Gt, a.ml_gb, DC, DN, SC, bid, G, tid);
    GSYNC();
    mlstm_stage_b(DC, DN, SC, MS, bid, G, tid);
    GSYNC();
    mlstm_stage_c(lds, QKO, KVT, Gt, a.ml_gb, DC, DN, MS, a.ml_hn, XN, bid, G, tid);
    GSYNC();
    { pg8::Gemm g{XN, WMO, M, D, D}; pg8::StaticOrder S; S.init(M, D, G, bid); pg8::EpiRes E{XB, nullptr, nullptr, D, 1.0f, XB, SSQ_(2)}; pg8::gemm_phase<pg8::EpiRes>(lds, g, S, E); }
    GSYNC();
    CONV_FFN(a.ffn1_wgu, a.ffn1_wd, a.ffn1_norm, 1, WGU2, WD2);
    GEMM_GU(WGU, SSQ_(2)); GSYNC();
    GEMM_DOWN(WD, nullptr, nullptr, XB, SSQ_(3)); GSYNC();

    GEMM_GU(WGU2, SSQ_(3)); GSYNC();
    GEMM_DOWN(WD2, nullptr, nullptr, XB, SSQ_(4)); GSYNC();
    CONV_FFN(a.ffn2_wgu, a.ffn2_wd, a.ffn2_norm, 1, WGU, WD);
    { pg8::Gemm g{XB, WAI, M, 1280, D}; pg8::StaticOrder S; S.init(M, 1280, G, bid); pg8::EpiMlaIn E{CQN, CKVN, KR, SSQ_(4), SSQ_(6), SSQ_(7)}; pg8::gemm_phase<pg8::EpiMlaIn>(lds, g, S, E); }
    GSYNC();
    for (int rep_ = 0; rep_ < REP_OTHER; ++rep_) { pg8::Gemm g{CQN, WUQ, M, 3072, 512}; pg8::StaticOrder S; S.init(M, 3072, G, bid); pg8::EpiBf16 E{Qb, 3072, nullptr, SSQ_(6)}; pg8::gemm_phase<pg8::EpiBf16>(lds, g, S, E); }
    for (int rep_ = 0; rep_ < REP_OTHER; ++rep_) { pg8::Gemm g{CKVN, WUKV, M, 4096, 512}; pg8::StaticOrder S; S.init(M, 4096, G, bid); pg8::EpiBf16 E{KVRAW, 4096, nullptr, SSQ_(7)}; pg8::gemm_phase<pg8::EpiBf16>(lds, g, S, E); }
    GSYNC();
    mla_qk_norm_rope(Qb, KVRAW, KR, a.pos, a.mla_qkn, KF, lds);
    GSYNC();
    for (int rep = 0; rep < REP_ATT; ++rep)
    for (int it = vcu; it < 256; it += G) {
        const int h = it >> 4, s = it & 15;
        for (int k = 0; k < 4; ++k) { const int qb = (k == 0) ? 63 - s : (k == 1) ? 32 + s : (k == 2) ? 31 - s : s; att::attn_unit(lds_g, Qb, KF, KVRAW, XN, h, qb, tid); }
    }
    GSYNC();
    { pg8::Gemm g{XN, WAO, M, D, D}; pg8::StaticOrder S; S.init(M, D, G, bid); pg8::EpiRes E{XB, nullptr, nullptr, D, 1.0f, XB, SSQ_(5)}; pg8::gemm_phase<pg8::EpiRes>(lds, g, S, E); }
    GSYNC();
    GEMM_GU(WGU, SSQ_(5)); GSYNC();
    GEMM_DOWN(WD, nullptr, a.out, nullptr, nullptr);
#undef CONV_FFN
#undef GEMM_GU
#undef GEMM_DOWN
#undef SSQ_
}

extern "C" void kernel_launch(void* const* d_in, const int* in_sizes, int n_in, void* d_out, int out_size, void* d_ws, size_t ws_size, hipStream_t stream) {
    static int grid_blocks = 0;
    if (grid_blocks == 0) {
        if (n_in != 20 || in_sizes[0] != M * D || out_size != M * D || ws_size < WS_NEED) {
            fprintf(stderr, "kernel_launch: unexpected shapes (n_in %d, in0 %d, out %d, ws %zu, need %zu)\n", n_in, n_in > 0 ? in_sizes[0] : -1, out_size, ws_size, (size_t)WS_NEED);
            grid_blocks = -1; return; }
        int dev = 0, cus = 0, per_cu = 0;
        hipGetDevice(&dev);
        hipDeviceGetAttribute(&cus, hipDeviceAttributeMultiprocessorCount, dev);
        hipFuncSetAttribute((const void*)mega_fwd, hipFuncAttributeMaxDynamicSharedMemorySize, LDS_BYTES);
        hipOccupancyMaxActiveBlocksPerMultiprocessor(&per_cu, (const void*)mega_fwd, NWAVES * 64, LDS_BYTES);
        if (per_cu < 1) per_cu = 1;
        grid_blocks = cus * per_cu;
        if (grid_blocks > 256) grid_blocks = 256;
    }
    if (grid_blocks < 0) return;
    Args a{};
    a.x = (const float*)d_in[0]; a.pos = (const int*)d_in[1];
    a.ffn1_norm = (const float*)d_in[2]; a.ffn1_wgu = (const float*)d_in[3]; a.ffn1_wd = (const float*)d_in[4]; a.mix_norm = (const float*)d_in[5];
    a.ffn2_norm = (const float*)d_in[6]; a.ffn2_wgu = (const float*)d_in[7]; a.ffn2_wd = (const float*)d_in[8];
    a.ml_win = (const float*)d_in[9]; a.ml_gb = (const float*)d_in[10]; a.ml_hn = (const float*)d_in[11]; a.ml_wout = (const float*)d_in[12];
    a.mla_win = (const float*)d_in[13]; a.mla_qn = (const float*)d_in[14]; a.mla_kvn = (const float*)d_in[15]; a.mla_wuq = (const float*)d_in[16];
    a.mla_wukv = (const float*)d_in[17]; a.mla_qkn = (const float*)d_in[18]; a.mla_wout = (const float*)d_in[19];
    a.out = (float*)d_out; a.ws = (unsigned char*)d_ws;
    (void)hipMemsetAsync(d_ws, 0, 65536, stream);
    void* args[] = {&a};
    hipError_t e = hipLaunchCooperativeKernel((const void*)mega_fwd, dim3(grid_blocks), dim3(NWAVES * 64), args, LDS_BYTES, stream);
    if (e != hipSuccess) fprintf(stderr, "cooperative launch failed: %s (grid %d)\n", hipGetErrorString(e), grid_blocks);
}
```

```cpp
#include <hip/hip_runtime.h>
#include <hip/hip_cooperative_groups.h>
#include <cstdio>
#include <cstdint>
namespace cg = cooperative_groups;

#define LAS __attribute__((address_space(3)))
typedef unsigned short bf16_t;
typedef short bf16x8 __attribute__((ext_vector_type(8)));
typedef short s16x4 __attribute__((ext_vector_type(4)));
typedef float f32x4 __attribute__((ext_vector_type(4)));
typedef float f32x16 __attribute__((ext_vector_type(16)));
typedef unsigned u32x4 __attribute__((ext_vector_type(4)));
typedef unsigned u32x2 __attribute__((ext_vector_type(2)));

constexpr int M = 16384, D = 2048, FF = 5632;
constexpr float EPS = 1e-6f;
constexpr int NWAVES = 8;
constexpr int LDS_BYTES = 147456;
#ifndef REP_ATT
#define REP_ATT 1
#endif
#define REP_MLSTM 1
#define REP_CONV 1
#define REP_GU 1
#define REP_NORM 1
#define REP_MA 1
#define REP_MC 1
#define REP_DOWN 1
#define REP_OTHER 1

__device__ __forceinline__ unsigned f2bf(float f) { unsigned u = __float_as_uint(f); return (u + 0x7fffu + ((u >> 16) & 1u)) >> 16; }
__device__ __forceinline__ unsigned pk2(float lo, float hi) { return f2bf(lo) | (f2bf(hi) << 16); }
__device__ __forceinline__ float bf2f(unsigned short b) { return __uint_as_float(((unsigned)b) << 16); }
__device__ __forceinline__ float bflo(unsigned w) { return __uint_as_float(w << 16); }
__device__ __forceinline__ float bfhi(unsigned w) { return __uint_as_float(w & 0xffff0000u); }
__device__ __forceinline__ float wave_sum(float v) {
#pragma unroll
    for (int o = 1; o < 64; o <<= 1) v += __shfl_xor(v, o);
    return v;
}
__device__ __forceinline__ float wave_max(float v) {
#pragma unroll
    for (int o = 1; o < 64; o <<= 1) v = fmaxf(v, __shfl_xor(v, o));
    return v;
}
__device__ __forceinline__ int opaque_tid() { int t = threadIdx.x; asm volatile("" : "+v"(t)); return t; }
__device__ __forceinline__ float sigmoidf_(float x) { return 1.0f / (1.0f + __expf(-x)); }

namespace pg8 {
constexpr int BM = 256, BK = 64, HALF = 128, HTB = HALF * BK * 2, STAGE_BYTES = 8 * HTB, NXCD = 8, WGM = 8;
__host__ __device__ __forceinline__ int lds_byte(int r, int c) { const int st = (r >> 4) * 2 + (c >> 5), rr = r & 15, cc = c & 31, ob = rr * 64 + cc * 2; return st * 1024 + (ob ^ (((ob >> 9) & 1) << 5)); }
__host__ __device__ __forceinline__ void stage_rc(int b, int& R, int& C) { const int st = b / 1024, sb = b % 1024, swz = sb ^ (((sb >> 9) & 1) << 5); R = (st >> 1) * 16 + swz / 64; C = (st & 1) * 32 + (swz % 64) / 2; }
__host__ __device__ __forceinline__ int perm32(int rho) { const int n = rho >> 4, i = rho & 15; return 8 * (i >> 2) + 4 * n + (i & 3); }

struct Unit { int pm, pn; };
struct Gemm { const bf16_t* A; const bf16_t* Bt; int M, N, K; };

struct StaticOrder {
    int nM, nN, nwg, G, c, rev, wgm;
    __device__ void init(int M_, int N_, int G_, int c_, int rev_ = 0, int wgm_ = WGM) { nM = M_ / BM; nN = N_ / BM; nwg = nM * nN; G = G_; c = c_; rev = rev_; wgm = wgm_; }
    __device__ bool next(int i, Unit& u) const {
        const long L = (long)i * G + c; if (L >= nwg) return false;
        int wgid = (int)L; { const int q = nwg / NXCD, r = nwg % NXCD, xcd = wgid % NXCD, off = wgid / NXCD; wgid = (xcd < r ? xcd * (q + 1) : r * (q + 1) + (xcd - r) * q) + off; }
        const int nig = wgm * nN, gid = wgid / nig, fm = gid * wgm, gsz = (nM - fm) < wgm ? (nM - fm) : wgm;
        u.pm = fm + ((wgid % nig) % gsz); u.pn = (wgid % nig) / gsz; if (rev) u.pm = nM - 1 - u.pm; return true;
    }
};

__device__ __forceinline__ unsigned cvt_pk_bf16(float lo, float hi) { unsigned r; asm volatile("v_cvt_pk_bf16_f32 %0, %1, %2" : "=v"(r) : "v"(lo), "v"(hi)); return r; }

__device__ __forceinline__ float rstd_of(float ssq) { return __builtin_amdgcn_rsqf(ssq * (1.0f / 2048.0f) + 1e-6f); }
struct EpiBf16 {
    static constexpr bool PERM = true;
    bf16_t* O; int ldc; const float* cssq; const float* rssq512;
    __device__ __forceinline__ void operator()(const f32x4 (&acc)[2][2][4][2], const Unit& u, int wr, int wc, int fr, int fq) const {
        const int row0 = u.pm * BM + wr * 64 + fr; const int col0 = u.pn * BM + wc * 32 + 8 * fq;
        f32x4 cs[2][2];
#pragma unroll
        for (int bj = 0; bj < 2; ++bj)
#pragma unroll
            for (int n = 0; n < 2; ++n) { if (cssq) { const f32x4 q = *(const f32x4*)(cssq + col0 + bj * HALF + 4 * n); cs[bj][n] = (f32x4){rstd_of(q.x), rstd_of(q.y), rstd_of(q.z), rstd_of(q.w)}; } else cs[bj][n] = (f32x4){1.f, 1.f, 1.f, 1.f}; }
#pragma unroll
        for (int ai = 0; ai < 2; ++ai)
#pragma unroll
            for (int m = 0; m < 4; ++m) { const int row = row0 + ai * HALF + m * 16; bf16_t* rowp = O + (size_t)row * ldc + col0;
                const float rs = rssq512 ? __builtin_amdgcn_rsqf(rssq512[row] * (1.0f / 512.0f) + 1e-6f) : 1.0f;
#pragma unroll
                for (int bj = 0; bj < 2; ++bj) { f32x4 v0 = acc[ai][bj][m][0] * cs[bj][0] * rs, v1 = acc[ai][bj][m][1] * cs[bj][1] * rs;
                    u32x4 w; w.x = cvt_pk_bf16(v0[0], v0[1]); w.y = cvt_pk_bf16(v0[2], v0[3]); w.z = cvt_pk_bf16(v1[0], v1[1]); w.w = cvt_pk_bf16(v1[2], v1[3]);
                    *(u32x4*)(rowp + bj * HALF) = w; } }
    }
};
struct EpiMlstmIn {
    static constexpr bool PERM = true;
    bf16_t* O; float* G; const float* ssq;
    __device__ __forceinline__ void operator()(const f32x4 (&acc)[2][2][4][2], const Unit& u, int wr, int wc, int fr, int fq) const {
        const int row0 = u.pm * BM + wr * 64 + fr;
        if (u.pn < 16) {
            const int col0 = u.pn * BM + wc * 32 + 8 * fq; const float sc0 = (u.pn < 4) ? 0.0625f : 1.f;
#pragma unroll
            for (int ai = 0; ai < 2; ++ai)
#pragma unroll
                for (int m = 0; m < 4; ++m) { const int row = row0 + ai * HALF + m * 16; const float sc = sc0 * rstd_of(ssq[row]); bf16_t* rowp = O + (size_t)row * 4096 + col0;
#pragma unroll
                    for (int bj = 0; bj < 2; ++bj) { f32x4 v0 = acc[ai][bj][m][0] * sc, v1 = acc[ai][bj][m][1] * sc;
                        u32x4 w; w.x = cvt_pk_bf16(v0[0], v0[1]); w.y = cvt_pk_bf16(v0[2], v0[3]); w.z = cvt_pk_bf16(v1[0], v1[1]); w.w = cvt_pk_bf16(v1[2], v1[3]);
                        *(u32x4*)(rowp + bj * HALF) = w; } }
        } else if (wc == 0 && fq == 0) {
#pragma unroll
            for (int ai = 0; ai < 2; ++ai)
#pragma unroll
                for (int m = 0; m < 4; ++m) { const int row = row0 + ai * HALF + m * 16; const float sc = rstd_of(ssq[row]); float* gp = G + (size_t)row * 8;
                    *(f32x4*)gp = acc[ai][0][m][0] * sc; *(f32x4*)(gp + 4) = acc[ai][0][m][1] * sc; }
        }
    }
};
struct EpiMlaIn {
    static constexpr bool PERM = true;
    bf16_t* CQ; bf16_t* CKV; float* KR; const float* ssq; float* ssq_q; float* ssq_kv;
    __device__ __forceinline__ void operator()(const f32x4 (&acc)[2][2][4][2], const Unit& u, int wr, int wc, int fr, int fq) const {
        const int row0 = u.pm * BM + wr * 64 + fr;
        if (u.pn < 4) {
            bf16_t* O = (u.pn < 2) ? CQ : CKV; float* so = (u.pn < 2) ? ssq_q : ssq_kv; const int col0 = (u.pn & 1) * BM + wc * 32 + 8 * fq;
#pragma unroll
            for (int ai = 0; ai < 2; ++ai)
#pragma unroll
                for (int m = 0; m < 4; ++m) { const int row = row0 + ai * HALF + m * 16; const float sc = rstd_of(ssq[row]); bf16_t* rowp = O + (size_t)row * 512 + col0; float ss = 0.f;
#pragma unroll
                    for (int bj = 0; bj < 2; ++bj) { f32x4 v0 = acc[ai][bj][m][0] * sc, v1 = acc[ai][bj][m][1] * sc;
                        u32x4 w; w.x = cvt_pk_bf16(v0[0], v0[1]); w.y = cvt_pk_bf16(v0[2], v0[3]); w.z = cvt_pk_bf16(v1[0], v1[1]); w.w = cvt_pk_bf16(v1[2], v1[3]);
                        *(u32x4*)(rowp + bj * HALF) = w;
                        ss += (v0[0] * v0[0] + v0[1] * v0[1]) + (v0[2] * v0[2] + v0[3] * v0[3]) + (v1[0] * v1[0] + v1[1] * v1[1]) + (v1[2] * v1[2] + v1[3] * v1[3]); }
                    ss += __shfl_xor(ss, 16); ss += __shfl_xor(ss, 32); if (fq == 0) atomicAdd(so + row, ss); }
        } else if (wc < 2) {
#pragma unroll
            for (int ai = 0; ai < 2; ++ai)
#pragma unroll
                for (int m = 0; m < 4; ++m) { const int row = row0 + ai * HALF + m * 16; const float sc = rstd_of(ssq[row]); float* kp = KR + (size_t)row * 64 + wc * 32 + 8 * fq;
                    *(f32x4*)kp = acc[ai][0][m][0] * sc; *(f32x4*)(kp + 4) = acc[ai][0][m][1] * sc; }
        }
    }
};
struct EpiSwiGLU {
    static constexpr bool PERM = true;
    bf16_t* H; const float* ssq;
    __device__ __forceinline__ void operator()(const f32x4 (&acc)[2][2][4][2], const Unit& u, int wr, int wc, int fr, int fq) const {
        const int row0 = u.pm * BM + wr * 64 + fr; const int col0 = u.pn * HALF + wc * 32 + 8 * fq;
#pragma unroll
        for (int ai = 0; ai < 2; ++ai)
#pragma unroll
            for (int m = 0; m < 4; ++m) { const int row = row0 + ai * HALF + m * 16; const float rs = rstd_of(ssq[row]), rs2 = rs * rs, rsc = rs * -1.4426950408889634f; bf16_t* rowp = H + (size_t)row * FF + col0;
                float h[8];
#pragma unroll
                for (int n = 0; n < 2; ++n)
#pragma unroll
                    for (int j = 0; j < 4; ++j) { const float g = acc[ai][0][m][n][j], up = acc[ai][1][m][n][j]; h[n * 4 + j] = (g * up) * rs2 * __builtin_amdgcn_rcpf(1.0f + __builtin_amdgcn_exp2f(g * rsc)); }
                u32x4 w; w.x = cvt_pk_bf16(h[0], h[1]); w.y = cvt_pk_bf16(h[2], h[3]); w.z = cvt_pk_bf16(h[4], h[5]); w.w = cvt_pk_bf16(h[6], h[7]);
                *(u32x4*)rowp = w; }
    }
};
struct EpiRes {
    static constexpr bool PERM = true;
    const bf16_t* base; const float* basef; float* out; int ldc; float scale; bf16_t* xb; float* ssq_out;
    __device__ __forceinline__ void operator()(const f32x4 (&acc)[2][2][4][2], const Unit& u, int wr, int wc, int fr, int fq) const {
        const int col0 = u.pn * BM + wc * 32 + 8 * fq;
        float sc = scale; asm volatile("" : "+v"(sc));
#pragma unroll
        for (int ai = 0; ai < 2; ++ai)
#pragma unroll
            for (int m = 0; m < 4; ++m) { const int row = u.pm * BM + ai * HALF + wr * 64 + m * 16 + fr; const size_t off = (size_t)row * ldc + col0; float ss = 0.f;
#pragma unroll
                for (int bj = 0; bj < 2; ++bj) { f32x4 b0, b1;
                    if (basef) { b0 = *(const f32x4*)(basef + off + bj * HALF); b1 = *(const f32x4*)(basef + off + bj * HALF + 4); }
                    else { const u32x4 bw = *(const u32x4*)(base + off + bj * HALF); b0 = (f32x4){bflo(bw.x), bfhi(bw.x), bflo(bw.y), bfhi(bw.y)}; b1 = (f32x4){bflo(bw.z), bfhi(bw.z), bflo(bw.w), bfhi(bw.w)}; }
                    f32x4 o0 = acc[ai][bj][m][0] * sc + b0;
                    f32x4 o1 = acc[ai][bj][m][1] * sc + b1;
                    if (out) { *(f32x4*)(out + off + bj * HALF) = o0; *(f32x4*)(out + off + bj * HALF + 4) = o1; }
                    if (xb) { u32x4 w; w.x = cvt_pk_bf16(o0[0], o0[1]); w.y = cvt_pk_bf16(o0[2], o0[3]); w.z = cvt_pk_bf16(o1[0], o1[1]); w.w = cvt_pk_bf16(o1[2], o1[3]);
                        *(u32x4*)(xb + off + bj * HALF) = w;
                        ss += (o0[0] * o0[0] + o0[1] * o0[1]) + (o0[2] * o0[2] + o0[3] * o0[3]) + (o1[0] * o1[0] + o1[1] * o1[1]) + (o1[2] * o1[2] + o1[3] * o1[3]); } }
                if (xb) { ss += __shfl_xor(ss, 16); ss += __shfl_xor(ss, 32); if (fq == 0) atomicAdd(ssq_out + row, ss); }
                if (m & 1) asm volatile("" ::: "memory"); }
    }
};

template <class Epi>
__device__ __forceinline__ void gemm_phase(LAS unsigned char* lds, const Gemm g, const StaticOrder& S, const Epi& E) {
    int tid = threadIdx.x; asm volatile("" : "+v"(tid));
    const int wid = __builtin_amdgcn_readfirstlane(tid >> 6), lane = tid & 63, wr = wid >> 2, wc = wid & 3, fr = lane & 15, fq = lane >> 4;
    const int K = g.K, nt = K / BK;
    unsigned voffA[2], voffB[2];
#pragma unroll
    for (int i = 0; i < 2; ++i) { int R, C; stage_rc(tid * 16 + i * 8192, R, C); const int Rb = Epi::PERM ? ((R & ~31) + perm32(R & 31)) : R;
        voffA[i] = (unsigned)(R * K + C) * 2u; voffB[i] = (unsigned)(Rb * K + C) * 2u; }
    const size_t kstep = (size_t)(BK * 2);
    const size_t hstep = (size_t)HALF * K * 2;
    const size_t tstep = 2 * hstep;
    const unsigned ldsw = (unsigned)wid * 1024u;
    const int aoff = lds_byte(wr * 64 + fr, fq * 8), boff = lds_byte(wc * 32 + fr, fq * 8);
#define PG8_SA(b, h) (((b) * 2 + (h)) * HTB)
#define PG8_SB(b, h) ((4 + (b) * 2 + (h)) * HTB)
#define PG8_STAGE(bufoff, gbase, voff) do { _Pragma("unroll") for (int _i = 0; _i < 2; ++_i) \
        __builtin_amdgcn_global_load_lds((const unsigned*)((const char*)(gbase) + (voff)[_i]), (LAS unsigned*)(lds + (bufoff) + ldsw + _i * 8192), 16, 0, 0); } while (0)
#define PG8_LDA(dst, b, h) do { _Pragma("unroll") for (int m = 0; m < 4; ++m) _Pragma("unroll") for (int k = 0; k < 2; ++k) dst[m][k] = *(const LAS bf16x8*)(lds + PG8_SA(b, h) + aoff + m * 2048 + k * 1024); } while (0)
#define PG8_LDB(dst, b, h) do { _Pragma("unroll") for (int n = 0; n < 2; ++n) _Pragma("unroll") for (int k = 0; k < 2; ++k) dst[n][k] = *(const LAS bf16x8*)(lds + PG8_SB(b, h) + boff + n * 2048 + k * 1024); } while (0)
#define PG8_MMA(ai, bj, At, Bt) do { __builtin_amdgcn_s_setprio(1); _Pragma("unroll") for (int m = 0; m < 4; ++m) _Pragma("unroll") for (int n = 0; n < 2; ++n) _Pragma("unroll") for (int k = 0; k < 2; ++k) \
        acc[ai][bj][m][n] = __builtin_amdgcn_mfma_f32_16x16x32_bf16(Bt[n][k], At[m][k], acc[ai][bj][m][n], 0, 0, 0); __builtin_amdgcn_s_setprio(0); } while (0)
#define PG8_WAIT_V(n) asm volatile("s_waitcnt vmcnt(" #n ")" ::: "memory")
#define PG8_WAIT_L(n) asm volatile("s_waitcnt lgkmcnt(" #n ")" ::: "memory")
#define PG8_BAR __builtin_amdgcn_s_barrier()
#define PG8_SCHED __builtin_amdgcn_sched_barrier(0)
    Unit cur, nxt; int ui = 0;
    if (!S.next(0, cur)) return;
    f32x4 acc[2][2][4][2];
#pragma unroll
    for (int a = 0; a < 2; ++a)
#pragma unroll
        for (int b = 0; b < 2; ++b)
#pragma unroll
            for (int m = 0; m < 4; ++m)
#pragma unroll
                for (int n = 0; n < 2; ++n) acc[a][b][m][n] = (f32x4){0.f, 0.f, 0.f, 0.f};
    bf16x8 At[4][2], B0[2][2], B1[2][2];
    const char* cA = (const char*)g.A + (size_t)cur.pm * tstep; const char* cB = (const char*)g.Bt + (size_t)cur.pn * tstep;
    PG8_STAGE(PG8_SB(0, 0), cB, voffB); PG8_STAGE(PG8_SB(0, 1), cB + hstep, voffB); PG8_STAGE(PG8_SA(0, 0), cA, voffA); PG8_STAGE(PG8_SA(0, 1), cA + hstep, voffA);
    if (wr == 1) PG8_BAR;
    PG8_WAIT_V(2); PG8_BAR;
    PG8_STAGE(PG8_SB(1, 0), cB + kstep, voffB); PG8_STAGE(PG8_SA(1, 0), cA + kstep, voffA); PG8_STAGE(PG8_SB(1, 1), cB + hstep + kstep, voffB);
    PG8_WAIT_V(6); PG8_BAR;
    for (;;) {
        const bool has_next = S.next(ui + 1, nxt);
        const char* nA = has_next ? (const char*)g.A + (size_t)nxt.pm * tstep : cA; const char* nB = has_next ? (const char*)g.Bt + (size_t)nxt.pn * tstep : cB;
        for (int t = 0; t < nt; t += 2) {
            const bool last = (t == nt - 2);
            const char* a1 = cA + (size_t)(t + 1) * kstep;
            const char* a2 = last ? nA : cA + (size_t)(t + 2) * kstep; const char* b2 = last ? nB : cB + (size_t)(t + 2) * kstep;
            const char* a3 = a2 + kstep; const char* b3 = b2 + kstep;
            PG8_LDB(B0, 0, 0); PG8_LDB(B1, 0, 1); PG8_SCHED; PG8_LDA(At, 0, 0); PG8_STAGE(PG8_SA(1, 1), a1 + hstep, voffA);
            PG8_WAIT_V(8); PG8_WAIT_L(0); PG8_BAR; PG8_MMA(0, 0, At, B0); PG8_MMA(0, 1, At, B1); PG8_BAR; PG8_SCHED;
            PG8_LDA(At, 0, 1); PG8_STAGE(PG8_SB(0, 0), b2, voffB); PG8_STAGE(PG8_SB(0, 1), b2 + hstep, voffB); PG8_STAGE(PG8_SA(0, 0), a2, voffA);
            PG8_WAIT_V(8); PG8_WAIT_L(0); PG8_BAR; PG8_MMA(1, 0, At, B0); PG8_MMA(1, 1, At, B1); PG8_BAR; PG8_SCHED;
            PG8_LDB(B0, 1, 0); PG8_LDB(B1, 1, 1); PG8_SCHED; PG8_LDA(At, 1, 0); PG8_STAGE(PG8_SA(0, 1), a2 + hstep, voffA);
            PG8_WAIT_V(8); PG8_WAIT_L(0); PG8_BAR; PG8_MMA(0, 0, At, B0); PG8_MMA(0, 1, At, B1); PG8_BAR; PG8_SCHED;
            PG8_LDA(At, 1, 1); PG8_STAGE(PG8_SB(1, 0), b3, voffB); PG8_STAGE(PG8_SB(1, 1), b3 + hstep, voffB); PG8_STAGE(PG8_SA(1, 0), a3, voffA);
            PG8_WAIT_V(8); PG8_WAIT_L(0); PG8_BAR; PG8_MMA(1, 0, At, B0); PG8_MMA(1, 1, At, B1); PG8_BAR; PG8_SCHED;
        }
        if (wr == 0) PG8_BAR;
        { int fr_e = fr, fq_e = fq; asm volatile("" : "+v"(fr_e), "+v"(fq_e));
          E(acc, cur, wr, wc, fr_e, fq_e); }
        if (!has_next) break;
#pragma unroll
        for (int a = 0; a < 2; ++a)
#pragma unroll
            for (int b = 0; b < 2; ++b)
#pragma unroll
                for (int m = 0; m < 4; ++m)
#pragma unroll
                    for (int n = 0; n < 2; ++n) acc[a][b][m][n] = (f32x4){0.f, 0.f, 0.f, 0.f};
        cur = nxt; cA = nA; cB = nB; ++ui;
        if (wr == 1) PG8_BAR;
    }
    PG8_WAIT_V(0);
    PG8_BAR;
#undef PG8_SA
#undef PG8_SB
#undef PG8_STAGE
#undef PG8_LDA
#undef PG8_LDB
#undef PG8_MMA
#undef PG8_WAIT_V
#undef PG8_WAIT_L
#undef PG8_BAR
#undef PG8_SCHED
}
}

__device__ __forceinline__ void conv_matrix(const float* W, int K, int ldn, int c0, int ncols, bf16_t* WT, int drow0, int mode, const float* gain, LAS unsigned char* lds) {
    const int tid = opaque_tid(), lane = tid & 63, wave = __builtin_amdgcn_readfirstlane(tid >> 6), gw = blockIdx.x * NWAVES + wave, ngw = gridDim.x * NWAVES;
    LAS float* scr = (LAS float*)(lds + wave * 16384);
    const int nblk = ncols / 32, nitems = (K / 64) * nblk;
    for (int it = gw; it < nitems; it += ngw) {
        const int kb = it / nblk, nb = it - kb * nblk, k0 = 64 * kb, n0 = c0 + 32 * nb;
        int drow;
        if (mode == 1) { const int up = n0 >= FF ? 1 : 0, j = n0 - up * FF; drow = (j >> 7) * 256 + up * 128 + (j & 127); } else drow = drow0 + 32 * nb;
#pragma unroll 8
        for (int i = 0; i < 32; ++i) { const int kk = 2 * i + (lane >> 5); scr[kk * 33 + (lane & 31)] = W[(size_t)(k0 + kk) * ldn + n0 + (lane & 31)]; }
        asm volatile("s_waitcnt lgkmcnt(0)" ::: "memory");
        const int c = lane & 7;
        f32x4 g0 = {1.f, 1.f, 1.f, 1.f}, g1 = {1.f, 1.f, 1.f, 1.f};
        if (gain) { g0 = *(const f32x4*)(gain + k0 + 8 * c); g1 = *(const f32x4*)(gain + k0 + 8 * c + 4); }
#pragma unroll
        for (int j = 0; j < 4; ++j) { const int n = (lane >> 3) + 8 * j; const LAS float* s = scr + (8 * c) * 33 + n;
            u32x4 o; o.x = pk2(s[0 * 33] * g0.x, s[1 * 33] * g0.y); o.y = pk2(s[2 * 33] * g0.z, s[3 * 33] * g0.w); o.z = pk2(s[4 * 33] * g1.x, s[5 * 33] * g1.y); o.w = pk2(s[6 * 33] * g1.z, s[7 * 33] * g1.w);
            *(u32x4*)(WT + (size_t)(drow + n) * K + k0 + 8 * c) = o; }
        asm volatile("s_waitcnt lgkmcnt(0)" ::: "memory");
    }
}

__device__ __forceinline__ void cast_rows_ssq(const float* X, bf16_t* XB, float* ssq) {
    const int tid = opaque_tid(), lane = tid & 63, gw = blockIdx.x * NWAVES + __builtin_amdgcn_readfirstlane(tid >> 6), ngw = gridDim.x * NWAVES;
    for (int m = gw; m < M; m += ngw) {
        const float* xr = X + (size_t)m * D + 4 * lane; f32x4 v[8]; float s = 0.f;
#pragma unroll
        for (int j = 0; j < 8; ++j) { v[j] = *(const f32x4*)(xr + 256 * j); s += (v[j].x * v[j].x + v[j].y * v[j].y) + (v[j].z * v[j].z + v[j].w * v[j].w); }
        s = wave_sum(s);
        if (lane == 0) ssq[m] = s;
        bf16_t* orow = XB + (size_t)m * D + 4 * lane;
#pragma unroll
        for (int j = 0; j < 8; ++j) { u32x2 w; w.x = pk2(v[j].x, v[j].y); w.y = pk2(v[j].z, v[j].w); *(u32x2*)(orow + 256 * j) = w; }
    }
}

__device__ __forceinline__ float scan_add(float v, int lane) {
#pragma unroll
    for (int o = 1; o < 64; o <<= 1) { const float t = __shfl_up(v, o); if (lane >= o) v += t; }
    return v;
}
__device__ __forceinline__ float scan_max(float v, int lane) {
#pragma unroll
    for (int o = 1; o < 64; o <<= 1) { const float t = __shfl_up(v, o); if (lane >= o) v = fmaxf(v, t); }
    return v;
}
__device__ __forceinline__ float log_sigmoid(float x) { return fminf(x, 0.f) - log1pf(expf(-fabsf(x))); }

__device__ __forceinline__ void mlstm_stage_a(LAS unsigned char* lds, const bf16_t* QKO, const bf16_t* KVT, const float* G, const float* gbias, bf16_t* DC, float* DN, float* SC,
                                              int bid, int nblk, int tid) {
    asm volatile("" : "+v"(tid));
    const int lane = tid & 63, wave = __builtin_amdgcn_readfirstlane(tid >> 6), r32 = lane & 31, hi = lane >> 5;
    LAS float* sWk = (LAS float*)lds;
    LAS unsigned char* sKS = lds + 1024;
    for (int u = bid; u < 1024; u += nblk) {
        const int c = u >> 2, h = u & 3, t0 = c * 64;
        if (wave == 0) {
            const float ig = G[(size_t)(t0 + lane) * 8 + h] + gbias[h];
            const float lf = log_sigmoid(G[(size_t)(t0 + lane) * 8 + 4 + h] + gbias[4 + h]);
            const float b = scan_add(lf, lane);
            const float blast = __shfl(b, 63);
            const float gg = blast - b + ig;
            const float mloc = wave_max(gg);
            sWk[lane] = expf(gg - mloc);
            if (lane == 0) { SC[(c * 4 + h) * 2] = blast; SC[(c * 4 + h) * 2 + 1] = mloc; }
        }
        __syncthreads();
#pragma unroll
        for (int i = 0; i < 4; ++i) { const int q = tid + 512 * i, sidx = q & 63, d8 = q >> 6;
            const u32x4 kv = *(const u32x4*)(QKO + (size_t)(t0 + sidx) * 4096 + 1024 + h * 256 + d8 * 8);
            const float wk = sWk[sidx];
            LAS unsigned short* dst = (LAS unsigned short*)(sKS + (d8 * 8) * 144 + sidx * 2);
            dst[0 * 72] = (unsigned short)f2bf(bflo(kv.x) * wk); dst[1 * 72] = (unsigned short)f2bf(bfhi(kv.x) * wk);
            dst[2 * 72] = (unsigned short)f2bf(bflo(kv.y) * wk); dst[3 * 72] = (unsigned short)f2bf(bfhi(kv.y) * wk);
            dst[4 * 72] = (unsigned short)f2bf(bflo(kv.z) * wk); dst[5 * 72] = (unsigned short)f2bf(bfhi(kv.z) * wk);
            dst[6 * 72] = (unsigned short)f2bf(bflo(kv.w) * wk); dst[7 * 72] = (unsigned short)f2bf(bfhi(kv.w) * wk); }
        __syncthreads();
        if (tid < 256) { float s = 0.f;
#pragma unroll
            for (int j = 0; j < 8; ++j) { const u32x4 w = *(const LAS u32x4*)(sKS + tid * 144 + j * 16);
                s += (bflo(w.x) + bfhi(w.x)) + (bflo(w.y) + bfhi(w.y)) + (bflo(w.z) + bfhi(w.z)) + (bflo(w.w) + bfhi(w.w)); }
            DN[(size_t)(c * 4 + h) * 256 + tid] = s; }
        bf16x8 bfr[2][4];
#pragma unroll
        for (int vb = 0; vb < 2; ++vb)
#pragma unroll
            for (int ks = 0; ks < 4; ++ks) bfr[vb][ks] = *(const bf16x8*)(KVT + (size_t)(h * 512 + (wave * 2 + vb) * 32 + r32) * M + t0 + ks * 16 + hi * 8);
#pragma unroll
        for (int dh = 0; dh < 2; ++dh) {
            f32x16 acc[4][2];
#pragma unroll
            for (int a = 0; a < 4; ++a) { acc[a][0] = f32x16{}; acc[a][1] = f32x16{}; }
#pragma unroll
            for (int db4 = 0; db4 < 4; ++db4)
#pragma unroll
                for (int ks = 0; ks < 4; ++ks) { const bf16x8 a = *(const LAS bf16x8*)(sKS + ((dh * 4 + db4) * 32 + r32) * 144 + ks * 32 + hi * 16);
                    acc[db4][0] = __builtin_amdgcn_mfma_f32_32x32x16_bf16(a, bfr[0][ks], acc[db4][0], 0, 0, 0);
                    acc[db4][1] = __builtin_amdgcn_mfma_f32_32x32x16_bf16(a, bfr[1][ks], acc[db4][1], 0, 0, 0); }
#pragma unroll
            for (int db4 = 0; db4 < 4; ++db4)
#pragma unroll
                for (int vb = 0; vb < 2; ++vb) { const int v = (wave * 2 + vb) * 32 + r32;
                    bf16_t* dp = DC + ((size_t)((c * 4 + h) * 512 + v)) * 256 + (dh * 4 + db4) * 32 + 4 * hi;
#pragma unroll
                    for (int gq = 0; gq < 4; ++gq) { u32x2 w; w.x = pk2(acc[db4][vb][4 * gq], acc[db4][vb][4 * gq + 1]); w.y = pk2(acc[db4][vb][4 * gq + 2], acc[db4][vb][4 * gq + 3]);
                        *(u32x2*)(dp + 8 * gq) = w; } }
        }
        __syncthreads();
    }
}

__device__ __forceinline__ void mlstm_stage_b(bf16_t* DC, float* DN, const float* SC, float* MS, int bid, int nblk, int tid) {
    for (int e4 = bid * 512 + tid; e4 < 131072; e4 += nblk * 512) {
        const int h = __builtin_amdgcn_readfirstlane(e4 >> 15);
        const bool do_n = (e4 & 32767) < 256, do_m = (e4 & 32767) == 0;
        u32x2* p = (u32x2*)DC + e4;
        float* np = DN + (size_t)h * 256 + (e4 & 255);
        float s0 = 0.f, s1 = 0.f, s2 = 0.f, s3 = 0.f, sn = 0.f, m = 0.f;
        u32x2 xa[16]; float na[16];
#pragma unroll
        for (int i = 0; i < 16; ++i) { xa[i] = p[(size_t)i * 131072]; na[i] = do_n ? np[(size_t)i * 1024] : 0.f; }
        for (int c = 0; c < 256; c += 16) {
            u32x2 xb[16]; float nb[16];
            const int cn = (c + 16 < 256) ? c + 16 : c;
#pragma unroll
            for (int i = 0; i < 16; ++i) { xb[i] = p[(size_t)(cn + i) * 131072]; nb[i] = do_n ? np[(size_t)(cn + i) * 1024] : 0.f; }
#pragma unroll
            for (int i = 0; i < 16; ++i) {
                const float blast = SC[((c + i) * 4 + h) * 2], mloc = SC[((c + i) * 4 + h) * 2 + 1];
                const float mn = fmaxf(blast + m, mloc), al = __expf(blast + m - mn), be = __expf(mloc - mn);
                u32x2 w; w.x = pk2(s0, s1); w.y = pk2(s2, s3);
                p[(size_t)(c + i) * 131072] = w;
                if (do_n) np[(size_t)(c + i) * 1024] = sn;
                if (do_m) MS[(c + i) * 4 + h] = m;
                s0 = al * s0 + be * bflo(xa[i].x); s1 = al * s1 + be * bfhi(xa[i].x); s2 = al * s2 + be * bflo(xa[i].y); s3 = al * s3 + be * bfhi(xa[i].y);
                sn = al * sn + be * na[i]; m = mn;
            }
#pragma unroll
            for (int i = 0; i < 16; ++i) { xa[i] = xb[i]; na[i] = nb[i]; }
        }
    }
}

__device__ __forceinline__ void mlstm_stage_c(LAS unsigned char* lds, const bf16_t* QKO, const bf16_t* KVT, const float* G, const float* gbias, const bf16_t* DC, const float* DN,
                                              const float* MS, const float* hnorm, bf16_t* HG, int bid, int nblk, int tid) {
    asm volatile("" : "+v"(tid));
    const int lane = tid & 63, wave = __builtin_amdgcn_readfirstlane(tid >> 6), r32 = lane & 31, hi = lane >> 5;
    LAS float* sB = (LAS float*)lds; LAS float* sI = sB + 64; LAS float* sMt = sB + 128; LAS float* sA = sB + 192; LAS float* sDinv = sB + 256;
    LAS float* sQn = sB + 320;
    LAS float* sSsq = sB + 832;
    LAS unsigned char* sW = lds + 5376;
    for (int u = bid; u < 1024; u += nblk) {
        const int c = u >> 2, h = u & 3, t0 = c * 64;
        if (wave == 0) {
            const float ig = G[(size_t)(t0 + lane) * 8 + h] + gbias[h];
            const float lf = log_sigmoid(G[(size_t)(t0 + lane) * 8 + 4 + h] + gbias[4 + h]);
            const float b = scan_add(lf, lane);
            const float mc = MS[c * 4 + h];
            const float pm = scan_max(ig - b, lane);
            const float mt = b + fmaxf(mc, pm);
            sB[lane] = b; sI[lane] = ig; sMt[lane] = mt; sA[lane] = expf(b + mc - mt);
        }
        { const int t = tid & 63, part = tid >> 6;
          const bf16_t* qp = QKO + (size_t)(t0 + t) * 4096 + h * 256 + part * 32; const float* np = DN + (size_t)(c * 4 + h) * 256 + part * 32;
          float s = 0.f;
#pragma unroll
          for (int j = 0; j < 4; ++j) { const u32x4 qv = *(const u32x4*)(qp + j * 8); const f32x4 n0 = *(const f32x4*)(np + j * 8), n1 = *(const f32x4*)(np + j * 8 + 4);
              s += bflo(qv.x) * n0.x + bfhi(qv.x) * n0.y + bflo(qv.y) * n0.z + bfhi(qv.y) * n0.w + bflo(qv.z) * n1.x + bfhi(qv.z) * n1.y + bflo(qv.w) * n1.z + bfhi(qv.w) * n1.w; }
          sQn[part * 64 + t] = s; }
        __syncthreads();
        if (wave < 4) {
            const int sb = wave >> 1, tb = wave & 1;
            f32x16 acc = f32x16{};
            const bf16_t* kp = QKO + (size_t)(t0 + sb * 32 + r32) * 4096 + 1024 + h * 256 + hi * 8;
            const bf16_t* qp = QKO + (size_t)(t0 + tb * 32 + r32) * 4096 + h * 256 + hi * 8;
#pragma unroll
            for (int ks = 0; ks < 16; ++ks) acc = __builtin_amdgcn_mfma_f32_32x32x16_bf16(*(const bf16x8*)(kp + ks * 16), *(const bf16x8*)(qp + ks * 16), acc, 0, 0, 0);
            const int t = tb * 32 + r32; const float bt = sB[t], mt = sMt[t];
#pragma unroll
            for (int gq = 0; gq < 4; ++gq) { const int s0 = sb * 32 + 8 * gq + 4 * hi; float wv[4];
#pragma unroll
                for (int e = 0; e < 4; ++e) { const int s = s0 + e; wv[e] = (s <= t) ? acc[4 * gq + e] * expf(bt - sB[s] + sI[s] - mt) : 0.f; }
                u32x2 w; w.x = pk2(wv[0], wv[1]); w.y = pk2(wv[2], wv[3]);
                *(LAS u32x2*)(sW + t * 144 + s0 * 2) = w; }
        }
        __syncthreads();
        if (wave == 0) { const int t = lane; float rs = 0.f;
#pragma unroll
            for (int j = 0; j < 8; ++j) { const u32x4 w = *(const LAS u32x4*)(sW + t * 144 + j * 16);
                rs += (bflo(w.x) + bfhi(w.x)) + (bflo(w.y) + bfhi(w.y)) + (bflo(w.z) + bfhi(w.z)) + (bflo(w.w) + bfhi(w.w)); }
            float qn = 0.f;
#pragma unroll
            for (int p = 0; p < 8; ++p) qn += sQn[p * 64 + t];
            const float den = sA[t] * qn + rs;
            sDinv[t] = 1.0f / fmaxf(fabsf(den), expf(-sMt[t])); }
        f32x16 acc[2][2];
#pragma unroll
        for (int a = 0; a < 2; ++a) { acc[a][0] = f32x16{}; acc[a][1] = f32x16{}; }
        { const bf16_t* q0p = QKO + (size_t)(t0 + r32) * 4096 + h * 256 + hi * 8; const bf16_t* q1p = q0p + (size_t)32 * 4096;
          const bf16_t* s0p = DC + ((size_t)((c * 4 + h) * 512 + wave * 64 + r32)) * 256 + hi * 8; const bf16_t* s1p = s0p + 32 * 256;
#pragma unroll
          for (int ks = 0; ks < 16; ++ks) { const bf16x8 b0 = *(const bf16x8*)(q0p + ks * 16), b1 = *(const bf16x8*)(q1p + ks * 16);
              const bf16x8 a0 = *(const bf16x8*)(s0p + ks * 16), a1 = *(const bf16x8*)(s1p + ks * 16);
              acc[0][0] = __builtin_amdgcn_mfma_f32_32x32x16_bf16(a0, b0, acc[0][0], 0, 0, 0); acc[0][1] = __builtin_amdgcn_mfma_f32_32x32x16_bf16(a0, b1, acc[0][1], 0, 0, 0);
              acc[1][0] = __builtin_amdgcn_mfma_f32_32x32x16_bf16(a1, b0, acc[1][0], 0, 0, 0); acc[1][1] = __builtin_amdgcn_mfma_f32_32x32x16_bf16(a1, b1, acc[1][1], 0, 0, 0); } }
        { const float a0 = sA[r32], a1 = sA[32 + r32];
#pragma unroll
          for (int vb = 0; vb < 2; ++vb) { acc[vb][0] *= a0; acc[vb][1] *= a1; } }
        { const bf16_t* v0p = KVT + (size_t)(h * 512 + wave * 64 + r32) * M + t0 + hi * 8; const bf16_t* v1p = v0p + (size_t)32 * M;
#pragma unroll
          for (int ks = 0; ks < 4; ++ks) { const bf16x8 b0 = *(const LAS bf16x8*)(sW + r32 * 144 + ks * 32 + hi * 16), b1 = *(const LAS bf16x8*)(sW + (32 + r32) * 144 + ks * 32 + hi * 16);
              const bf16x8 a0 = *(const bf16x8*)(v0p + ks * 16), a1 = *(const bf16x8*)(v1p + ks * 16);
              acc[0][0] = __builtin_amdgcn_mfma_f32_32x32x16_bf16(a0, b0, acc[0][0], 0, 0, 0); acc[0][1] = __builtin_amdgcn_mfma_f32_32x32x16_bf16(a0, b1, acc[0][1], 0, 0, 0);
              acc[1][0] = __builtin_amdgcn_mfma_f32_32x32x16_bf16(a1, b0, acc[1][0], 0, 0, 0); acc[1][1] = __builtin_amdgcn_mfma_f32_32x32x16_bf16(a1, b1, acc[1][1], 0, 0, 0); } }
        __syncthreads();
#pragma unroll
        for (int tb = 0; tb < 2; ++tb) { const float dinv = sDinv[tb * 32 + r32]; float ss = 0.f;
#pragma unroll
            for (int vb = 0; vb < 2; ++vb) { acc[vb][tb] *= dinv;
#pragma unroll
                for (int r = 0; r < 16; ++r) ss += acc[vb][tb][r] * acc[vb][tb][r]; }
            ss += __shfl_xor(ss, 32);
            if (hi == 0) sSsq[wave * 64 + tb * 32 + r32] = ss; }
        __syncthreads();
#pragma unroll
        for (int tb = 0; tb < 2; ++tb) { const int t = tb * 32 + r32; float tot = 0.f;
#pragma unroll
            for (int w = 0; w < 8; ++w) tot += sSsq[w * 64 + t];
            const float rstd = 1.0f / sqrtf(tot * (1.0f / 512.0f) + EPS);
#pragma unroll
            for (int vb = 0; vb < 2; ++vb)
#pragma unroll
                for (int gq = 0; gq < 4; ++gq) { const int v0 = wave * 64 + vb * 32 + 8 * gq + 4 * hi;
                    const u32x2 ow = *(const u32x2*)(QKO + (size_t)(t0 + t) * 4096 + 2048 + h * 512 + v0);
                    const f32x4 gn = *(const f32x4*)(hnorm + h * 512 + v0);
                    const float o0 = acc[vb][tb][4 * gq] * rstd * gn.x * sigmoidf_(bflo(ow.x)), o1 = acc[vb][tb][4 * gq + 1] * rstd * gn.y * sigmoidf_(bfhi(ow.x));
                    const float o2 = acc[vb][tb][4 * gq + 2] * rstd * gn.z * sigmoidf_(bflo(ow.y)), o3 = acc[vb][tb][4 * gq + 3] * rstd * gn.w * sigmoidf_(bfhi(ow.y));
                    u32x2 w; w.x = pk2(o0, o1); w.y = pk2(o2, o3);
                    *(u32x2*)(HG + (size_t)(t0 + t) * 2048 + h * 512 + v0) = w; } }
        __syncthreads();
    }
}

__device__ __forceinline__ void mla_latent_norm(const float* C, const float* qn, const float* kvn, bf16_t* CQN, bf16_t* CKVN, float* KR) {
    const int tid = opaque_tid(), lane = tid & 63, gw = blockIdx.x * NWAVES + __builtin_amdgcn_readfirstlane(tid >> 6), ngw = gridDim.x * NWAVES;
    for (int m = gw; m < M; m += ngw) {
        KR[(size_t)m * 64 + lane] = C[(size_t)m * 1280 + 1024 + lane];
        const float* cr = C + (size_t)m * 1280 + 4 * lane;
        f32x4 a[2], b[2]; float sa = 0.f, sb = 0.f;
#pragma unroll
        for (int j = 0; j < 2; ++j) { a[j] = *(const f32x4*)(cr + 256 * j); b[j] = *(const f32x4*)(cr + 512 + 256 * j);
            sa += (a[j].x * a[j].x + a[j].y * a[j].y) + (a[j].z * a[j].z + a[j].w * a[j].w); sb += (b[j].x * b[j].x + b[j].y * b[j].y) + (b[j].z * b[j].z + b[j].w * b[j].w); }
        const float ra = 1.0f / sqrtf(wave_sum(sa) * (1.0f / 512.0f) + EPS), rb = 1.0f / sqrtf(wave_sum(sb) * (1.0f / 512.0f) + EPS);
#pragma unroll
        for (int j = 0; j < 2; ++j) { const f32x4 ga = *(const f32x4*)(qn + 4 * lane + 256 * j), gb = *(const f32x4*)(kvn + 4 * lane + 256 * j);
            u32x2 w; w.x = pk2(a[j].x * ra * ga.x, a[j].y * ra * ga.y); w.y = pk2(a[j].z * ra * ga.z, a[j].w * ra * ga.w);
            *(u32x2*)(CQN + (size_t)m * 512 + 4 * lane + 256 * j) = w;
            w.x = pk2(b[j].x * rb * gb.x, b[j].y * rb * gb.y); w.y = pk2(b[j].z * rb * gb.z, b[j].w * rb * gb.w);
            *(u32x2*)(CKVN + (size_t)m * 512 + 4 * lane + 256 * j) = w; }
    }
}
__device__ __forceinline__ void mla_qk_norm_rope(bf16_t* Q, const bf16_t* KVRAW, const float* KR, const int* pos, const float* qkn, bf16_t* KF, LAS unsigned char* lds) {
    const int tid = opaque_tid(), lane = tid & 63, wave = __builtin_amdgcn_readfirstlane(tid >> 6), gw = blockIdx.x * NWAVES + wave, ngw = gridDim.x * NWAVES;
    LAS unsigned short* skr = (LAS unsigned short*)(lds + wave * 256);
    const float QS = 0.07216878364870322f * 1.4426950408889634f;
    const int i32 = lane & 31;
    const double freq = exp2(-(double)i32 * (13.287712379549449 / 32.0));
    const float gqn0 = qkn[2 * lane], gqn1 = qkn[2 * lane + 1], gqr = qkn[128 + lane], gkr = qkn[192 + 128 + lane];
    const int kh = lane >> 2, kp = lane & 3;
    f32x4 gk[8];
#pragma unroll
    for (int e = 0; e < 8; ++e) gk[e] = *(const f32x4*)(qkn + 192 + kp * 32 + e * 4);
    for (int m = gw; m < M; m += ngw) {
        const double ang = (double)pos[m] * freq;
        const double red = ang - 6.283185307179586476925 * rint(ang * 0.15915494309189533577);
        const float sn = sinf((float)red), cs = cosf((float)red);
        { const float x = KR[(size_t)m * 64 + lane]; const float r = 1.0f / sqrtf(wave_sum(x * x) * (1.0f / 64.0f) + EPS);
          const float xn = x * r * gkr; const float pr = __shfl_xor(xn, 32);
          const float kr = (lane < 32) ? (xn * cs - pr * sn) : (xn * cs + pr * sn);
          skr[lane] = (unsigned short)f2bf(kr); }
        { const bf16_t* kp_ = KVRAW + (size_t)m * 4096 + kh * 256 + kp * 32; bf16_t* kf_ = KF + (size_t)m * 3072 + kh * 192;
          u32x4 w[4]; float ss = 0.f;
#pragma unroll
          for (int e = 0; e < 4; ++e) { w[e] = *(const u32x4*)(kp_ + e * 8);
              ss += (bflo(w[e].x) * bflo(w[e].x) + bfhi(w[e].x) * bfhi(w[e].x)) + (bflo(w[e].y) * bflo(w[e].y) + bfhi(w[e].y) * bfhi(w[e].y))
                  + (bflo(w[e].z) * bflo(w[e].z) + bfhi(w[e].z) * bfhi(w[e].z)) + (bflo(w[e].w) * bflo(w[e].w) + bfhi(w[e].w) * bfhi(w[e].w)); }
          ss += __shfl_xor(ss, 1); ss += __shfl_xor(ss, 2);
          const float r3 = 1.0f / sqrtf(ss * (1.0f / 128.0f) + EPS);
#pragma unroll
          for (int e = 0; e < 4; ++e) { const f32x4 g0 = gk[2 * e], g1 = gk[2 * e + 1]; u32x4 o;
              o.x = pk2(bflo(w[e].x) * r3 * g0.x, bfhi(w[e].x) * r3 * g0.y); o.y = pk2(bflo(w[e].y) * r3 * g0.z, bfhi(w[e].y) * r3 * g0.w);
              o.z = pk2(bflo(w[e].z) * r3 * g1.x, bfhi(w[e].z) * r3 * g1.y); o.w = pk2(bflo(w[e].w) * r3 * g1.z, bfhi(w[e].w) * r3 * g1.w);
              *(u32x4*)(kf_ + kp * 32 + e * 8) = o; }
          asm volatile("s_waitcnt lgkmcnt(0)" ::: "memory");
          const u32x4 k0 = *(const LAS u32x4*)(skr + kp * 16), k1 = *(const LAS u32x4*)(skr + kp * 16 + 8);
          *(u32x4*)(kf_ + 128 + kp * 16) = k0; *(u32x4*)(kf_ + 128 + kp * 16 + 8) = k1; }
        bf16_t* qrow = Q + (size_t)m * 3072;
#pragma unroll 4
        for (int hh = 0; hh < 16; ++hh) {
            const unsigned qw = *(const unsigned*)(qrow + hh * 192 + 2 * lane);
            const float qr_ = bf2f(qrow[hh * 192 + 128 + lane]);
            const float q0 = bflo(qw), q1 = bfhi(qw);
            float s1 = q0 * q0 + q1 * q1, s2 = qr_ * qr_;
#pragma unroll
            for (int o = 1; o < 64; o <<= 1) { s1 += __shfl_xor(s1, o); s2 += __shfl_xor(s2, o); }
            const float r1 = QS / sqrtf(s1 * (1.0f / 128.0f) + EPS), r2 = 1.0f / sqrtf(s2 * (1.0f / 64.0f) + EPS);
            *(unsigned*)(qrow + hh * 192 + 2 * lane) = pk2(q0 * r1 * gqn0, q1 * r1 * gqn1);
            const float xn = qr_ * r2 * gqr; const float pr = __shfl_xor(xn, 32);
            const float qo = ((lane < 32) ? (xn * cs - pr * sn) : (xn * cs + pr * sn)) * QS;
            qrow[hh * 192 + 128 + lane] = (unsigned short)f2bf(qo);
        }
    }
}

namespace att {
constexpr int SHM_V = 16384, SHM_K = 24576, OFF_V = 0, OFF_K = 3 * SHM_V, OFF_WS = OFF_K + 3 * SHM_K;
#define SBAR() __builtin_amdgcn_sched_barrier(0)
__device__ __forceinline__ int v_st(int k, int c) { const int kk = (k & ~0xC) | ((k & 4) << 1) | ((k & 8) >> 1); return ((kk >> 3) * 4 + (c >> 5)) * 512 + ((kk & 7) * 32 + (c & 31)) * 2; }
__device__ __forceinline__ int v_rd_base(int lane) { return ((lane & 3) << 3) | (((lane >> 2) & 3) << 6) | (((lane >> 4) & 1) << 5) | (((lane >> 5) & 1) << 8); }
constexpr int v_rd_off(int d0, int ks, int half) { return d0 * 512 + ks * 4096 + half * 2048; }
__device__ __forceinline__ int crow(int r, int hi) { return (r & 3) + 8 * (r >> 2) + 4 * hi; }
__device__ __forceinline__ unsigned cvtpk(float lo, float hi) { unsigned r; asm volatile("v_cvt_pk_bf16_f32 %0, %1, %2" : "=v"(r) : "v"(lo), "v"(hi)); return r; }
__device__ __forceinline__ void mask_tile(f32x16& p0, f32x16& p1, int dq) {
    const float NEG = -__builtin_inff();
#pragma unroll
    for (int r = 0; r < 16; ++r) { const int c = (r & 3) + 8 * (r >> 2);
        if (dq - c < 0) p0[r] = NEG;
        if (dq - c - 32 < 0) p1[r] = NEG; }
}
__device__ __forceinline__ void partialSM(f32x16& p0, f32x16& p1, float& m_reg, float& alpha, f32x16& negm) {
    float pmax = p0[0];
#pragma unroll
    for (int r = 1; r < 16; ++r) pmax = fmaxf(pmax, p0[r]);
#pragma unroll
    for (int r = 0; r < 16; ++r) pmax = fmaxf(pmax, p1[r]);
    { auto rr = __builtin_amdgcn_permlane32_swap(__float_as_uint(pmax), __float_as_uint(pmax), false, false);
      pmax = fmaxf(__uint_as_float(rr[0]), __uint_as_float(rr[1])); }
    if (__builtin_expect(__all(pmax <= 8.0f), 1)) { alpha = 1.f; }
    else { const float dl = fmaxf(pmax, 0.f); m_reg += dl; alpha = __builtin_amdgcn_exp2f(-dl);
#pragma unroll
        for (int r = 0; r < 16; ++r) { p0[r] -= dl; p1[r] -= dl; }
#pragma unroll
        for (int r = 0; r < 16; ++r) negm[r] = -m_reg; }
#pragma unroll
    for (int r = 0; r < 16; ++r) p0[r] = __builtin_amdgcn_exp2f(p0[r]);
#pragma unroll
    for (int r = 0; r < 16; ++r) p1[r] = __builtin_amdgcn_exp2f(p1[r]);
}
__device__ __forceinline__ void finishSM(f32x16& p0, f32x16& p1, float alpha, float& l_reg, bf16x8& pa0, bf16x8& pa1, bf16x8& pa2, bf16x8& pa3) {
    float ps = 0;
#pragma unroll
    for (int r = 0; r < 16; ++r) ps += p0[r];
#pragma unroll
    for (int r = 0; r < 16; ++r) ps += p1[r];
    { auto rr = __builtin_amdgcn_permlane32_swap(__float_as_uint(ps), __float_as_uint(ps), false, false);
      ps = __uint_as_float(rr[0]) + __uint_as_float(rr[1]); }
    l_reg = l_reg * alpha + ps;
#define PK4(P, B_, OUT) do { unsigned a0 = cvtpk(P[B_+0], P[B_+1]), a1 = cvtpk(P[B_+2], P[B_+3]);                          \
        unsigned b0 = cvtpk(P[B_+4], P[B_+5]), b1 = cvtpk(P[B_+6], P[B_+7]);                                             \
        auto r0 = __builtin_amdgcn_permlane32_swap(a0, b0, false, false); auto r1 = __builtin_amdgcn_permlane32_swap(a1, b1, false, false); \
        u32x4 w = {r0[0], r1[0], r0[1], r1[1]}; OUT = *reinterpret_cast<bf16x8*>(&w); } while (0)
    PK4(p0, 0, pa0); PK4(p0, 8, pa1); PK4(p1, 0, pa2); PK4(p1, 8, pa3);
#undef PK4
}
__device__ __forceinline__ int kswz(int row, int colB) { return row * 384 + (colB ^ (((row >> 1) & 7) << 4)); }
__device__ __forceinline__ void qkt(f32x16& p0, f32x16& p1, const LAS unsigned char* Kb, int r32, int hi, const bf16x8* qr, const f32x16& negm) {
    const LAS unsigned char* kb[4];
#pragma unroll
    for (int dd = 0; dd < 4; ++dd) kb[dd] = Kb + kswz(r32, dd * 32 + hi * 16);
#define LDK(d0_, w_) (*(const LAS bf16x8*)(kb[(d0_) & 3] + ((d0_) >> 2) * 128 + (w_) * 32 * 384))
    bf16x8 fa[12], fb[12];
    fa[0] = LDK(0, 0); fb[0] = LDK(0, 1); fa[1] = LDK(1, 0); fb[1] = LDK(1, 1);
#pragma unroll
    for (int d0 = 0; d0 < 12; ++d0) {
        if (d0 + 2 < 12) { fa[d0 + 2] = LDK(d0 + 2, 0); fb[d0 + 2] = LDK(d0 + 2, 1); }
        SBAR();
        p0 = __builtin_amdgcn_mfma_f32_32x32x16_bf16(fa[d0], qr[d0], d0 == 0 ? negm : p0, 0, 0, 0);
        p1 = __builtin_amdgcn_mfma_f32_32x32x16_bf16(fb[d0], qr[d0], d0 == 0 ? negm : p1, 0, 0, 0);
        SBAR();
    }
#undef LDK
}
__device__ __forceinline__ void pv_tile(f32x16* o, int vb0, bf16x8 pa0, bf16x8 pa1, bf16x8 pa2, bf16x8 pa3) {
#define TRRD(dst, off) asm volatile("ds_read_b64_tr_b16 %0, %1 offset:%2" : "=&v"(dst) : "v"(vb0), "i"(off) : "memory")
#define RD8(S, d0) do { constexpr int b_ = v_rd_off(d0, 0, 0); TRRD(S##l0, b_); TRRD(S##h0, b_ + 2048); TRRD(S##l1, b_ + 4096); TRRD(S##h1, b_ + 6144); \
        TRRD(S##l2, b_ + 8192); TRRD(S##h2, b_ + 10240); TRRD(S##l3, b_ + 12288); TRRD(S##h3, b_ + 14336); } while (0)
#define MM4(S, d0) do { \
        o[d0] = __builtin_amdgcn_mfma_f32_32x32x16_bf16(pa0, (bf16x8){S##l0[0], S##l0[1], S##l0[2], S##l0[3], S##h0[0], S##h0[1], S##h0[2], S##h0[3]}, o[d0], 0, 0, 0); \
        o[d0] = __builtin_amdgcn_mfma_f32_32x32x16_bf16(pa1, (bf16x8){S##l1[0], S##l1[1], S##l1[2], S##l1[3], S##h1[0], S##h1[1], S##h1[2], S##h1[3]}, o[d0], 0, 0, 0); \
        o[d0] = __builtin_amdgcn_mfma_f32_32x32x16_bf16(pa2, (bf16x8){S##l2[0], S##l2[1], S##l2[2], S##l2[3], S##h2[0], S##h2[1], S##h2[2], S##h2[3]}, o[d0], 0, 0, 0); \
        o[d0] = __builtin_amdgcn_mfma_f32_32x32x16_bf16(pa3, (bf16x8){S##l3[0], S##l3[1], S##l3[2], S##l3[3], S##h3[0], S##h3[1], S##h3[2], S##h3[3]}, o[d0], 0, 0, 0); } while (0)
#define WAITL(n) do { asm volatile("s_waitcnt lgkmcnt(" #n ")" ::: "memory"); SBAR(); } while (0)
    s16x4 Al0, Al1, Al2, Al3, Ah0, Ah1, Ah2, Ah3, Bl0, Bl1, Bl2, Bl3, Bh0, Bh1, Bh2, Bh3;
    RD8(A, 0); RD8(B, 1); SBAR();
    WAITL(8); MM4(A, 0); SBAR();
    RD8(A, 2); SBAR();
    WAITL(8); MM4(B, 1); SBAR();
    RD8(B, 3); SBAR();
    WAITL(8); MM4(A, 2); SBAR();
    WAITL(0); MM4(B, 3);
#undef WAITL
#undef MM4
#undef RD8
#undef TRRD
}
__device__ __forceinline__ void attn_unit(unsigned char* ldsg, const bf16_t* QF, const bf16_t* KF, const bf16_t* KVRAW, bf16_t* O, int h, int qb, int tid) {
    asm volatile("" : "+v"(tid));
    LAS unsigned char* lds = (LAS unsigned char*)ldsg;
    const int wid = __builtin_amdgcn_readfirstlane(tid >> 6), lane = tid & 63, r32 = lane & 31, hi = lane >> 5;
    const int q0 = qb * 256, NT = 4 * (qb + 1);
    const int qlo = q0 + wid * 32, qm = qlo + r32 - 4 * hi;
    LAS float* ws = (LAS float*)(lds + OFF_WS) + wid * 64; LAS float* li_l = ws; LAS float* al_l = ws + 32;
    int kgo[3], vgo[2];
#pragma unroll
    for (int i = 0; i < 3; ++i) { const int off = ((wid * 3 + i) * 64 + lane) * 16, row = off / 384, c1 = (off - row * 384) >> 4, ch = (c1 & ~7) | ((c1 & 7) ^ ((row >> 1) & 7)); kgo[i] = row * 3072 + ch * 8; }
#pragma unroll
    for (int i = 0; i < 2; ++i) { const int off = ((wid * 2 + i) * 64 + lane) * 16, sub = off >> 9, kkh = sub >> 2, cb = sub & 3, w = (off & 511) >> 1, kk = kkh * 8 + (w >> 5), cc = w & 31;
        const int k = (kk & ~0xC) | ((kk & 4) << 1) | ((kk & 8) >> 1); vgo[i] = k * 4096 + cb * 32 + cc; }
    const bf16_t* Kh = KF + h * 192; const bf16_t* Vh = KVRAW + h * 256 + 128;
    const int vb_base = (int)(unsigned)(uintptr_t)(ldsg + OFF_V) + v_rd_base(lane);
    bf16x8 qr[12];
#pragma unroll
    for (int d0 = 0; d0 < 12; ++d0) qr[d0] = *(const bf16x8*)(QF + (size_t)(qlo + r32) * 3072 + h * 192 + d0 * 16 + hi * 8);
#define ADMA(kb_, slot_) do { \
        _Pragma("unroll") for (int i = 0; i < 3; ++i) __builtin_amdgcn_global_load_lds((const unsigned*)(Kh + (size_t)(kb_) * 3072 + kgo[i]), (LAS unsigned*)(lds + OFF_K + (slot_) * SHM_K + (wid * 3 + i) * 1024), 16, 0, 0); \
        _Pragma("unroll") for (int i = 0; i < 2; ++i) __builtin_amdgcn_global_load_lds((const unsigned*)(Vh + (size_t)(kb_) * 4096 + vgo[i]), (LAS unsigned*)(lds + OFF_V + (slot_) * SHM_V + (wid * 2 + i) * 1024), 16, 0, 0); } while (0)
    ADMA(0, 0); ADMA(64, 1);
    __syncthreads();
    float m_reg = 0.f, l_reg = 0.f; f32x16 o[4];
    f32x16 negm = f32x16{}; asm volatile("" : "+v"(negm));
#pragma unroll
    for (int d = 0; d < 4; ++d) o[d] = f32x16{};
    int sj = 0, sn = 1, s2 = 2;
    for (int j = 0; j < NT; ++j) {
        const int kb = j * 64;
        if (j + 2 < NT) ADMA(kb + 128, s2);
        if (kb <= qlo + 31) {
            f32x16 p0, p1; float alpha; bf16x8 pa0, pa1, pa2, pa3;
            qkt(p0, p1, lds + OFF_K + sj * SHM_K, r32, hi, qr, negm);
            if (kb + 63 > qlo) mask_tile(p0, p1, qm - kb);
            partialSM(p0, p1, m_reg, alpha, negm);
            finishSM(p0, p1, alpha, l_reg, pa0, pa1, pa2, pa3);
            if (__any(alpha < 1.f)) { if (hi == 0) al_l[r32] = alpha; asm volatile("s_waitcnt lgkmcnt(0)" ::: "memory");
#pragma unroll
                for (int d_ = 0; d_ < 4; ++d_)
#pragma unroll
                    for (int r = 0; r < 16; ++r) o[d_][r] *= al_l[crow(r, hi)]; }
            SBAR();
            pv_tile(o, vb_base + sj * SHM_V, pa0, pa1, pa2, pa3);
        }
        { const int t_ = sj; sj = sn; sn = s2; s2 = t_; }
        __syncthreads();
    }
#undef ADMA
    if (hi == 0) li_l[r32] = l_reg; asm volatile("s_waitcnt lgkmcnt(0)" ::: "memory");
    float rli[16];
#pragma unroll
    for (int r = 0; r < 16; ++r) rli[r] = 1.0f / li_l[crow(r, hi)];
    bf16_t* Ow = O + (size_t)qlo * 2048 + h * 128;
#pragma unroll
    for (int r = 0; r < 16; ++r) { const int orow = crow(r, hi);
#pragma unroll
        for (int d0 = 0; d0 < 4; ++d0) { const float v = o[d0][r] * rli[r]; const float vn = __shfl_xor(v, 1);
            if ((r32 & 1) == 0) *(unsigned*)(Ow + (size_t)orow * 2048 + d0 * 32 + r32) = cvtpk(v, vn); } }
    __syncthreads();
}
#undef SBAR
}


#define XB_TMO      128
#define XB_XCNT(j)  (256  + 64 * (j))
#define XB_XSUB(j)  (1280 + 64 * (j))
#define XB_XGEN(j)  (2304 + 64 * (j))
#define XB_TOP      3328
#define XB_TOPGEN   3392
#define XCD_BAR_WORDS 3456
#define XB_SPIN_CAP (1u << 22)
__device__ __forceinline__ unsigned xb_ld(unsigned* p)              { return __hip_atomic_load(p, __ATOMIC_RELAXED, __HIP_MEMORY_SCOPE_AGENT); }
__device__ __forceinline__ unsigned xb_add(unsigned* p, unsigned v) { return __hip_atomic_fetch_add(p, v, __ATOMIC_RELAXED, __HIP_MEMORY_SCOPE_AGENT); }
__device__ __forceinline__ unsigned xb_xcc_id() { return (unsigned)__builtin_amdgcn_s_getreg((3 << 11) | 20) & 0xFu; }
#define XB_SPIN(cond, bar) do { unsigned _sp = 0; while (cond) { __builtin_amdgcn_s_sleep(1); \
    if ((++_sp & 255u) == 0u) { if (xb_ld(&(bar)[XB_TMO])) break; if (_sp > XB_SPIN_CAP) { atomicAdd(&(bar)[XB_TMO], 1u); break; } } } } while (0)
struct XcdBarrier { unsigned* bar; unsigned x; volatile LAS unsigned* st; };
__device__ __forceinline__ XcdBarrier xcd_barrier_post(unsigned* bar, volatile LAS unsigned* st) {
    XcdBarrier b; b.bar = bar; b.x = xb_xcc_id(); b.st = st;
    if (threadIdx.x == 0) (void)xb_add(&bar[XB_XCNT(b.x)], 1u);
    return b;
}
__device__ __forceinline__ void xcd_barrier_complete(unsigned* bar, unsigned x, unsigned& nloc, unsigned& nx) {
    const unsigned G = gridDim.x * gridDim.y * gridDim.z;
    unsigned sum, cnt, mine, sp = 0u;
    for (;;) {
        sum = 0u; cnt = 0u; mine = 0u;
#pragma unroll
        for (unsigned j = 0; j < 16; ++j) { const unsigned c = xb_ld(&bar[XB_XCNT(j)]); sum += c; cnt += (c > 0u) ? 1u : 0u; mine = (j == x) ? c : mine; }
        if (sum == G) break;
        __builtin_amdgcn_s_sleep(1);
        if ((++sp & 255u) == 0u) { if (xb_ld(&bar[XB_TMO])) break; if (sp > XB_SPIN_CAP) { atomicAdd(&bar[XB_TMO], 1u); break; } }
    }
    nloc = mine > 0u ? mine : 1u; nx = cnt > 0u ? cnt : 1u;
}
__device__ __forceinline__ void xcd_barrier(const XcdBarrier& b) {
    asm volatile("s_waitcnt vmcnt(0)" ::: "memory");
    __syncthreads();
    if (threadIdx.x == 0) {
        unsigned* bar = b.bar;
        __builtin_amdgcn_s_waitcnt(0);
        unsigned nloc = b.st[0], nx = b.st[1];
        if (nloc == 0u) { xcd_barrier_complete(bar, b.x, nloc, nx); b.st[0] = nloc; b.st[1] = nx; }
        const unsigned old = xb_add(&bar[XB_XSUB(b.x)], 1u);
        const unsigned gen = old / nloc;
        if (old + 1u == (gen + 1u) * nloc) {
            __builtin_amdgcn_fence(__ATOMIC_RELEASE, "agent");
            asm volatile("s_waitcnt vmcnt(0)" ::: "memory");
            const unsigned og = xb_add(&bar[XB_TOP], 1u);
            const unsigned tg = og / nx;
            if (og + 1u == (tg + 1u) * nx) xb_add(&bar[XB_TOPGEN], 1u);
            else XB_SPIN(xb_ld(&bar[XB_TOPGEN]) == tg, bar);
            __builtin_amdgcn_fence(__ATOMIC_ACQUIRE, "agent");
            xb_add(&bar[XB_XGEN(b.x)], 1u);
            asm volatile("s_waitcnt vmcnt(0)" ::: "memory");
        } else {
            XB_SPIN(xb_ld(&bar[XB_XGEN(b.x)]) == gen, bar);
            __builtin_amdgcn_fence(__ATOMIC_ACQUIRE, "agent");
            asm volatile("s_waitcnt vmcnt(0)" ::: "memory");
        }
    }
    __syncthreads();
}

constexpr size_t MiB = (size_t)1 << 20;
constexpr size_t OFF_XN = 1 * MiB;
constexpr size_t OFF_XB = OFF_XN + 64 * MiB;
constexpr size_t OFF_WGU = OFF_XB + 64 * MiB;
constexpr size_t OFF_WD = OFF_WGU + 44 * MiB;
constexpr size_t OFF_WMIA = OFF_WD + 22 * MiB;
constexpr size_t OFF_WMIB = OFF_WMIA + 17 * MiB;
constexpr size_t OFF_WMO = OFF_WMIB + 12 * MiB;
constexpr size_t OFF_WAI = OFF_WMO + 8 * MiB;
constexpr size_t OFF_WUQ = OFF_WAI + 5 * MiB;
constexpr size_t OFF_WUKV = OFF_WUQ + 3 * MiB;
constexpr size_t OFF_WAO = OFF_WUKV + 4 * MiB;
constexpr size_t OFF_BIG = OFF_WAO + 8 * MiB;
constexpr size_t OFF_H = OFF_BIG;
constexpr size_t OFF_WGU2 = OFF_BIG + 180 * MiB;
constexpr size_t OFF_WD2 = OFF_WGU2 + 44 * MiB;
constexpr size_t OFF_SSQ = 131072;
constexpr size_t OFF_QKO = OFF_BIG;
constexpr size_t OFF_KVT = OFF_QKO + 128 * MiB;
constexpr size_t OFF_DC = OFF_KVT + 96 * MiB;
constexpr size_t OFF_DN = OFF_DC + 256 * MiB;
constexpr size_t OFF_G = OFF_DN + 1 * MiB;
constexpr size_t OFF_SC = OFF_G + 1 * MiB;
constexpr size_t OFF_MS = OFF_SC + 65536;
constexpr size_t END_MLSTM = OFF_MS + 65536;
constexpr size_t OFF_C = OFF_BIG;
constexpr size_t OFF_KF = OFF_C;
constexpr size_t OFF_CQN = OFF_KF + 96 * MiB;
constexpr size_t OFF_CKVN = OFF_CQN + 16 * MiB;
constexpr size_t OFF_Q = OFF_CKVN + 16 * MiB;
constexpr size_t OFF_KVRAW = OFF_Q + 96 * MiB;
constexpr size_t OFF_KR = OFF_KVRAW + 128 * MiB;
constexpr size_t END_MLA = OFF_KR + 4 * MiB;
constexpr size_t WS_NEED = END_MLA > END_MLSTM ? END_MLA : END_MLSTM;

struct Args {
    const float* x; const int* pos;
    const float* ffn1_norm; const float* ffn1_wgu; const float* ffn1_wd; const float* mix_norm; const float* ffn2_norm; const float* ffn2_wgu; const float* ffn2_wd;
    const float* ml_win; const float* ml_gb; const float* ml_hn; const float* ml_wout;
    const float* mla_win; const float* mla_qn; const float* mla_kvn; const float* mla_wuq; const float* mla_wukv; const float* mla_qkn; const float* mla_wout;
    float* out; unsigned char* ws;
};

__global__ void __launch_bounds__(NWAVES * 64, 2) mega_fwd(Args a) {
    extern __shared__ __attribute__((aligned(16))) unsigned char lds_g[];
    cg::grid_group grid = cg::this_grid();
    LAS unsigned char* lds = (LAS unsigned char*)lds_g;
    const int tid = threadIdx.x;
    const int G = gridDim.x, bid = blockIdx.x;
    const int vcu = (G % 8 == 0) ? (bid % 8) * (G / 8) + bid / 8 : bid;
    volatile LAS unsigned* bst = (volatile LAS unsigned*)(lds + LDS_BYTES - 64);
    if (tid < 16) bst[tid] = 0u;
    __syncthreads();
    XcdBarrier xbar = xcd_barrier_post((unsigned*)a.ws + 4096, bst);
#define GSYNC() xcd_barrier(xbar)
    unsigned char* ws = a.ws;
    bf16_t* XN = (bf16_t*)(ws + OFF_XN);
    bf16_t* WGU = (bf16_t*)(ws + OFF_WGU); bf16_t* WD = (bf16_t*)(ws + OFF_WD);
    bf16_t* WMIA = (bf16_t*)(ws + OFF_WMIA); bf16_t* WMIB = (bf16_t*)(ws + OFF_WMIB); bf16_t* WMO = (bf16_t*)(ws + OFF_WMO);
    bf16_t* WAI = (bf16_t*)(ws + OFF_WAI); bf16_t* WUQ = (bf16_t*)(ws + OFF_WUQ); bf16_t* WUKV = (bf16_t*)(ws + OFF_WUKV); bf16_t* WAO = (bf16_t*)(ws + OFF_WAO);
    bf16_t* Hb = (bf16_t*)(ws + OFF_H);
    bf16_t* QKO = (bf16_t*)(ws + OFF_QKO); bf16_t* KVT = (bf16_t*)(ws + OFF_KVT); bf16_t* DC = (bf16_t*)(ws + OFF_DC);
    float* DN = (float*)(ws + OFF_DN); float* Gt = (float*)(ws + OFF_G); float* SC = (float*)(ws + OFF_SC); float* MS = (float*)(ws + OFF_MS);
    float* Cb = (float*)(ws + OFF_C); bf16_t* KF = (bf16_t*)(ws + OFF_KF); bf16_t* CQN = (bf16_t*)(ws + OFF_CQN); bf16_t* CKVN = (bf16_t*)(ws + OFF_CKVN);
    bf16_t* Qb = (bf16_t*)(ws + OFF_Q); bf16_t* KVRAW = (bf16_t*)(ws + OFF_KVRAW); float* KR = (float*)(ws + OFF_KR);

    bf16_t* XB = (bf16_t*)(ws + OFF_XB); bf16_t* WGU2 = (bf16_t*)(ws + OFF_WGU2); bf16_t* WD2 = (bf16_t*)(ws + OFF_WD2);
    float* SSQ = (float*)(ws + OFF_SSQ);
#define SSQ_(i) (SSQ + (size_t)(i) * M)
#define CONV_FFN(wgu_, wd_, norm_, layer, WGU_, WD_) do { for (int rep_ = 0; rep_ < REP_CONV; ++rep_) { \
        conv_matrix((wgu_) + (size_t)(layer) * D * 2 * FF, D, 2 * FF, 0, 2 * FF, (WGU_), 0, 1, (norm_) + (layer) * D, lds); \
        conv_matrix((wd_) + (size_t)(layer) * FF * D, FF, D, 0, D, (WD_), 0, 0, nullptr, lds); } \
        __syncthreads();   } while (0)
#define GEMM_GU(WGU_, ssq_) do { for (int rep_ = 0; rep_ < REP_GU; ++rep_) { pg8::Gemm g{XB, (WGU_), M, 2 * FF, D}; pg8::StaticOrder S; S.init(M, 2 * FF, G, bid); pg8::EpiSwiGLU E{Hb, (ssq_)}; pg8::gemm_phase<pg8::EpiSwiGLU>(lds, g, S, E); } } while (0)
#define GEMM_DOWN(WD_, basef_, out_, xb_, ssqo_) do { pg8::Gemm g{Hb, (WD_), M, D, FF}; pg8::StaticOrder S; S.init(M, D, G, bid, 0, 4); pg8::EpiRes E{XB, (basef_), (out_), D, 0.5f, (xb_), (ssqo_)}; pg8::gemm_phase<pg8::EpiRes>(lds, g, S, E); } while (0)

    CONV_FFN(a.ffn1_wgu, a.ffn1_wd, a.ffn1_norm, 0, WGU, WD);
    conv_matrix(a.ml_win, D, 6152, 0, 2048, WMIA, 0, 0, a.mix_norm, lds);
    conv_matrix(a.ml_win, D, 6152, 4096, 2048, WMIA, 2048, 0, a.mix_norm, lds);
    conv_matrix(a.ml_win, D, 6152, 2048, 2048, WMIB, 0, 0, a.mix_norm, lds);
    { const int gt = bid * 512 + opaque_tid(), ngt = G * 512;
      for (int i = gt; i < 8 * D; i += ngt) { const int k = i >> 3, j = i & 7; WMIA[(size_t)(4096 + j) * D + k] = (bf16_t)f2bf(a.ml_win[(size_t)k * 6152 + 6144 + j] * a.mix_norm[k]); }
      u32x4 z = {0u, 0u, 0u, 0u};
      for (int i = gt; i < 248 * D / 8; i += ngt) *(u32x4*)(WMIA + (size_t)4104 * D + (size_t)i * 8) = z;
      for (int i = gt; i < 192 * D / 8; i += ngt) *(u32x4*)(WAI + (size_t)1088 * D + (size_t)i * 8) = z;
      for (int i = gt; i < 7 * M / 4; i += ngt) *(u32x4*)(SSQ_(1) + (size_t)i * 4) = z; }
    conv_matrix(a.ml_wout, D, D, 0, D, WMO, 0, 0, nullptr, lds);
    conv_matrix(a.mla_win, D, 1088, 0, 1088, WAI, 0, 0, a.mix_norm + D, lds);
    conv_matrix(a.mla_wuq, 512, 3072, 0, 3072, WUQ, 0, 0, a.mla_qn, lds);
    conv_matrix(a.mla_wukv, 512, 4096, 0, 4096, WUKV, 0, 0, a.mla_kvn, lds);
    conv_matrix(a.mla_wout, D, D, 0, D, WAO, 0, 0, nullptr, lds);
    cast_rows_ssq(a.x, XB, SSQ_(0));
    if (a.ws == nullptr) grid.sync();
    GSYNC();

    GEMM_GU(WGU, SSQ_(0)); GSYNC();
    GEMM_DOWN(WD, a.x, nullptr, XB, SSQ_(1)); GSYNC();
    CONV_FFN(a.ffn2_wgu, a.ffn2_wd, a.ffn2_norm, 0, WGU, WD);
    for (int rep_ = 0; rep_ < REP_OTHER; ++rep_) { pg8::Gemm g{XB, WMIA, M, 4352, D}; pg8::StaticOrder S; S.init(M, 4352, G, bid); pg8::EpiMlstmIn E{QKO, Gt, SSQ_(1)}; pg8::gemm_phase<pg8::EpiMlstmIn>(lds, g, S, E); }
    for (int rep_ = 0; rep_ < REP_OTHER; ++rep_) { pg8::Gemm g{WMIB, XB, 2048, M, D}; pg8::StaticOrder S; S.init(2048, M, G, bid); pg8::EpiBf16 E{KVT, M, SSQ_(1), nullptr}; pg8::gemm_phase<pg8::EpiBf16>(lds, g, S, E); }
    GSYNC();
    mlstm_stage_a(lds, QKO, KVT, Gt, a.ml_gb, DC, DN, SC, bid, G, tid);
    GSYNC();
    mlstm_stage_b(DC, DN, SC, MS, bid, G, tid);
    GSYNC();
    mlstm_stage_c(lds, QKO, KVT, Gt, a.ml_gb, DC, DN, MS, a.ml_hn, XN, bid, G, tid);
    GSYNC();
    { pg8::Gemm g{XN, WMO, M, D, D}; pg8::StaticOrder S; S.init(M, D, G, bid); pg8::EpiRes E{XB, nullptr, nullptr, D, 1.0f, XB, SSQ_(2)}; pg8::gemm_phase<pg8::EpiRes>(lds, g, S, E); }
    GSYNC();
    CONV_FFN(a.ffn1_wgu, a.ffn1_wd, a.ffn1_norm, 1, WGU2, WD2);
    GEMM_GU(WGU, SSQ_(2)); GSYNC();
    GEMM_DOWN(WD, nullptr, nullptr, XB, SSQ_(3)); GSYNC();

    GEMM_GU(WGU2, SSQ_(3)); GSYNC();
    GEMM_DOWN(WD2, nullptr, nullptr, XB, SSQ_(4)); GSYNC();
    CONV_FFN(a.ffn2_wgu, a.ffn2_wd, a.ffn2_norm, 1, WGU, WD);
    { pg8::Gemm g{XB, WAI, M, 1280, D}; pg8::StaticOrder S; S.init(M, 1280, G, bid); pg8::EpiMlaIn E{CQN, CKVN, KR, SSQ_(4), SSQ_(6), SSQ_(7)}; pg8::gemm_phase<pg8::EpiMlaIn>(lds, g, S, E); }
    GSYNC();
    for (int rep_ = 0; rep_ < REP_OTHER; ++rep_) { pg8::Gemm g{CQN, WUQ, M, 3072, 512}; pg8::StaticOrder S; S.init(M, 3072, G, bid); pg8::EpiBf16 E{Qb, 3072, nullptr, SSQ_(6)}; pg8::gemm_phase<pg8::EpiBf16>(lds, g, S, E); }
    for (int rep_ = 0; rep_ < REP_OTHER; ++rep_) { pg8::Gemm g{CKVN, WUKV, M, 4096, 512}; pg8::StaticOrder S; S.init(M, 4096, G, bid); pg8::EpiBf16 E{KVRAW, 4096, nullptr, SSQ_(7)}; pg8::gemm_phase<pg8::EpiBf16>(lds, g, S, E); }
    GSYNC();
    mla_qk_norm_rope(Qb, KVRAW, KR, a.pos, a.mla_qkn, KF, lds);
    GSYNC();
    for (int rep = 0; rep < REP_ATT; ++rep)
    for (int it = vcu; it < 256; it += G) {
        const int h = it >> 4, s = it & 15;
        for (int k = 0; k < 4; ++k) { const int qb = (k == 0) ? 63 - s : (k == 1) ? 32 + s : (k == 2) ? 31 - s : s; att::attn_unit(lds_g, Qb, KF, KVRAW, XN, h, qb, tid); }
    }
    GSYNC();
    { pg8::Gemm g{XN, WAO, M, D, D}; pg8::StaticOrder S; S.init(M, D, G, bid); pg8::EpiRes E{XB, nullptr, nullptr, D, 1.0f, XB, SSQ_(5)}; pg8::gemm_phase<pg8::EpiRes>(lds, g, S, E); }
    GSYNC();
    GEMM_GU(WGU, SSQ_(5)); GSYNC();
    GEMM_DOWN(WD, nullptr, a.out, nullptr, nullptr);
#undef CONV_FFN
#undef GEMM_GU
#undef GEMM_DOWN
#undef SSQ_
}

extern "C" void kernel_launch(void* const* d_in, const int* in_sizes, int n_in, void* d_out, int out_size, void* d_ws, size_t ws_size, hipStream_t stream) {
    static int grid_blocks = 0;
    if (grid_blocks == 0) {
        if (n_in != 20 || in_sizes[0] != M * D || out_size != M * D || ws_size < WS_NEED) {
            fprintf(stderr, "kernel_launch: unexpected shapes (n_in %d, in0 %d, out %d, ws %zu, need %zu)\n", n_in, n_in > 0 ? in_sizes[0] : -1, out_size, ws_size, (size_t)WS_NEED);
            grid_blocks = -1; return; }
        int dev = 0, cus = 0, per_cu = 0;
        hipGetDevice(&dev);
        hipDeviceGetAttribute(&cus, hipDeviceAttributeMultiprocessorCount, dev);
        hipFuncSetAttribute((const void*)mega_fwd, hipFuncAttributeMaxDynamicSharedMemorySize, LDS_BYTES);
        hipOccupancyMaxActiveBlocksPerMultiprocessor(&per_cu, (const void*)mega_fwd, NWAVES * 64, LDS_BYTES);
        if (per_cu < 1) per_cu = 1;
        grid_blocks = cus * per_cu;
        if (grid_blocks > 256) grid_blocks = 256;
    }
    if (grid_blocks < 0) return;
    Args a{};
    a.x = (const float*)d_in[0]; a.pos = (const int*)d_in[1];
    a.ffn1_norm = (const float*)d_in[2]; a.ffn1_wgu = (const float*)d_in[3]; a.ffn1_wd = (const float*)d_in[4]; a.mix_norm = (const float*)d_in[5];
    a.ffn2_norm = (const float*)d_in[6]; a.ffn2_wgu = (const float*)d_in[7]; a.ffn2_wd = (const float*)d_in[8];
    a.ml_win = (const float*)d_in[9]; a.ml_gb = (const float*)d_in[10]; a.ml_hn = (const float*)d_in[11]; a.ml_wout = (const float*)d_in[12];
    a.mla_win = (const float*)d_in[13]; a.mla_qn = (const float*)d_in[14]; a.mla_kvn = (const float*)d_in[15]; a.mla_wuq = (const float*)d_in[16];
    a.mla_wukv = (const float*)d_in[17]; a.mla_qkn = (const float*)d_in[18]; a.mla_wout = (const float*)d_in[19];
    a.out = (float*)d_out; a.ws = (unsigned char*)d_ws;
    (void)hipMemsetAsync(d_ws, 0, 65536, stream);
    void* args[] = {&a};
    hipError_t e = hipLaunchCooperativeKernel((const void*)mega_fwd, dim3(grid_blocks), dim3(NWAVES * 64), args, LDS_BYTES, stream);
    if (e != hipSuccess) fprintf(stderr, "cooperative launch failed: %s (grid %d)\n", hipGetErrorString(e), grid_blocks);
}
```

```cpp
#include <hip/hip_runtime.h>
#include <hip/hip_cooperative_groups.h>
#include <cstdio>
#include <cstdint>
namespace cg = cooperative_groups;

#define LAS __attribute__((address_space(3)))
typedef unsigned short bf16_t;
typedef short bf16x8 __attribute__((ext_vector_type(8)));
typedef short s16x4 __attribute__((ext_vector_type(4)));
typedef float f32x4 __attribute__((ext_vector_type(4)));
typedef float f32x16 __attribute__((ext_vector_type(16)));
typedef unsigned u32x4 __attribute__((ext_vector_type(4)));
typedef unsigned u32x2 __attribute__((ext_vector_type(2)));

constexpr int M = 16384, D = 2048, FF = 5632;
constexpr float EPS = 1e-6f;
constexpr int NWAVES = 8;
constexpr int LDS_BYTES = 147456;
#ifndef REP_ATT
#define REP_ATT 1
#endif
#define REP_MLSTM 1
#define REP_CONV 1
#define REP_GU 1
#define REP_NORM 1
#define REP_MA 1
#define REP_MC 1
#define REP_DOWN 1
#define REP_OTHER 1

__device__ __forceinline__ unsigned f2bf(float f) { unsigned u = __float_as_uint(f); return (u + 0x7fffu + ((u >> 16) & 1u)) >> 16; }
__device__ __forceinline__ unsigned pk2(float lo, float hi) { return f2bf(lo) | (f2bf(hi) << 16); }
__device__ __forceinline__ float bf2f(unsigned short b) { return __uint_as_float(((unsigned)b) << 16); }
__device__ __forceinline__ float bflo(unsigned w) { return __uint_as_float(w << 16); }
__device__ __forceinline__ float bfhi(unsigned w) { return __uint_as_float(w & 0xffff0000u); }
__device__ __forceinline__ float wave_sum(float v) {
#pragma unroll
    for (int o = 1; o < 64; o <<= 1) v += __shfl_xor(v, o);
    return v;
}
__device__ __forceinline__ float wave_max(float v) {
#pragma unroll
    for (int o = 1; o < 64; o <<= 1) v = fmaxf(v, __shfl_xor(v, o));
    return v;
}
__device__ __forceinline__ int opaque_tid() { int t = threadIdx.x; asm volatile("" : "+v"(t)); return t; }
__device__ __forceinline__ float sigmoidf_(float x) { return 1.0f / (1.0f + __expf(-x)); }

namespace pg8 {
constexpr int BM = 256, BK = 64, HALF = 128, HTB = HALF * BK * 2, STAGE_BYTES = 8 * HTB, NXCD = 8, WGM = 8;
__host__ __device__ __forceinline__ int lds_byte(int r, int c) { const int st = (r >> 4) * 2 + (c >> 5), rr = r & 15, cc = c & 31, ob = rr * 64 + cc * 2; return st * 1024 + (ob ^ (((ob >> 9) & 1) << 5)); }
__host__ __device__ __forceinline__ void stage_rc(int b, int& R, int& C) { const int st = b / 1024, sb = b % 1024, swz = sb ^ (((sb >> 9) & 1) << 5); R = (st >> 1) * 16 + swz / 64; C = (st & 1) * 32 + (swz % 64) / 2; }
__host__ __device__ __forceinline__ int perm32(int rho) { const int n = rho >> 4, i = rho & 15; return 8 * (i >> 2) + 4 * n + (i & 3); }

struct Unit { int pm, pn; };
struct Gemm { const bf16_t* A; const bf16_t* Bt; int M, N, K; };

struct StaticOrder {
    int nM, nN, nwg, G, c, rev, wgm;
    __device__ void init(int M_, int N_, int G_, int c_, int rev_ = 0, int wgm_ = WGM) { nM = M_ / BM; nN = N_ / BM; nwg = nM * nN; G = G_; c = c_; rev = rev_; wgm = wgm_; }
    __device__ bool next(int i, Unit& u) const {
        const long L = (long)i * G + c; if (L >= nwg) return false;
        int wgid = (int)L; { const int q = nwg / NXCD, r = nwg % NXCD, xcd = wgid % NXCD, off = wgid / NXCD; wgid = (xcd < r ? xcd * (q + 1) : r * (q + 1) + (xcd - r) * q) + off; }
        const int nig = wgm * nN, gid = wgid / nig, fm = gid * wgm, gsz = (nM - fm) < wgm ? (nM - fm) : wgm;
        u.pm = fm + ((wgid % nig) % gsz); u.pn = (wgid % nig) / gsz; if (rev) u.pm = nM - 1 - u.pm; return true;
    }
};

__device__ __forceinline__ unsigned cvt_pk_bf16(float lo, float hi) { unsigned r; asm volatile("v_cvt_pk_bf16_f32 %0, %1, %2" : "=v"(r) : "v"(lo), "v"(hi)); return r; }

__device__ __forceinline__ float rstd_of(float ssq) { return __builtin_amdgcn_rsqf(ssq * (1.0f / 2048.0f) + 1e-6f); }
struct EpiBf16 {
    static constexpr bool PERM = true;
    bf16_t* O; int ldc; const float* cssq; const float* rssq512;
    __device__ __forceinline__ void operator()(const f32x4 (&acc)[2][2][4][2], const Unit& u, int wr, int wc, int fr, int fq) const {
        const int row0 = u.pm * BM + wr * 64 + fr; const int col0 = u.pn * BM + wc * 32 + 8 * fq;
        f32x4 cs[2][2];
#pragma unroll
        for (int bj = 0; bj < 2; ++bj)
#pragma unroll
            for (int n = 0; n < 2; ++n) { if (cssq) { const f32x4 q = *(const f32x4*)(cssq + col0 + bj * HALF + 4 * n); cs[bj][n] = (f32x4){rstd_of(q.x), rstd_of(q.y), rstd_of(q.z), rstd_of(q.w)}; } else cs[bj][n] = (f32x4){1.f, 1.f, 1.f, 1.f}; }
#pragma unroll
        for (int ai = 0; ai < 2; ++ai)
#pragma unroll
            for (int m = 0; m < 4; ++m) { const int row = row0 + ai * HALF + m * 16; bf16_t* rowp = O + (size_t)row * ldc + col0;
                const float rs = rssq512 ? __builtin_amdgcn_rsqf(rssq512[row] * (1.0f / 512.0f) + 1e-6f) : 1.0f;
#pragma unroll
                for (int bj = 0; bj < 2; ++bj) { f32x4 v0 = acc[ai][bj][m][0] * cs[bj][0] * rs, v1 = acc[ai][bj][m][1] * cs[bj][1] * rs;
                    u32x4 w; w.x = cvt_pk_bf16(v0[0], v0[1]); w.y = cvt_pk_bf16(v0[2], v0[3]); w.z = cvt_pk_bf16(v1[0], v1[1]); w.w = cvt_pk_bf16(v1[2], v1[3]);
                    *(u32x4*)(rowp + bj * HALF) = w; } }
    }
};
struct EpiMlstmIn {
    static constexpr bool PERM = true;
    bf16_t* O; float* G; const float* ssq;
    __device__ __forceinline__ void operator()(const f32x4 (&acc)[2][2][4][2], const Unit& u, int wr, int wc, int fr, int fq) const {
        const int row0 = u.pm * BM + wr * 64 + fr;
        if (u.pn < 16) {
            const int col0 = u.pn * BM + wc * 32 + 8 * fq; const float sc0 = (u.pn < 4) ? 0.0625f : 1.f;
#pragma unroll
            for (int ai = 0; ai < 2; ++ai)
#pragma unroll
                for (int m = 0; m < 4; ++m) { const int row = row0 + ai * HALF + m * 16; const float sc = sc0 * rstd_of(ssq[row]); bf16_t* rowp = O + (size_t)row * 4096 + col0;
#pragma unroll
                    for (int bj = 0; bj < 2; ++bj) { f32x4 v0 = acc[ai][bj][m][0] * sc, v1 = acc[ai][bj][m][1] * sc;
                        u32x4 w; w.x = cvt_pk_bf16(v0[0], v0[1]); w.y = cvt_pk_bf16(v0[2], v0[3]); w.z = cvt_pk_bf16(v1[0], v1[1]); w.w = cvt_pk_bf16(v1[2], v1[3]);
                        *(u32x4*)(rowp + bj * HALF) = w; } }
        } else if (wc == 0 && fq == 0) {
#pragma unroll
            for (int ai = 0; ai < 2; ++ai)
#pragma unroll
                for (int m = 0; m < 4; ++m) { const int row = row0 + ai * HALF + m * 16; const float sc = rstd_of(ssq[row]); float* gp = G + (size_t)row * 8;
                    *(f32x4*)gp = acc[ai][0][m][0] * sc; *(f32x4*)(gp + 4) = acc[ai][0][m][1] * sc; }
        }
    }
};
struct EpiMlaIn {
    static constexpr bool PERM = true;
    bf16_t* CQ; bf16_t* CKV; float* KR; const float* ssq; float* ssq_q; float* ssq_kv;
    __device__ __forceinline__ void operator()(const f32x4 (&acc)[2][2][4][2], const Unit& u, int wr, int wc, int fr, int fq) const {
        const int row0 = u.pm * BM + wr * 64 + fr;
        if (u.pn < 4) {
            bf16_t* O = (u.pn < 2) ? CQ : CKV; float* so = (u.pn < 2) ? ssq_q : ssq_kv; const int col0 = (u.pn & 1) * BM + wc * 32 + 8 * fq;
#pragma unroll
            for (int ai = 0; ai < 2; ++ai)
#pragma unroll
                for (int m = 0; m < 4; ++m) { const int row = row0 + ai * HALF + m * 16; const float sc = rstd_of(ssq[row]); bf16_t* rowp = O + (size_t)row * 512 + col0; float ss = 0.f;
#pragma unroll
                    for (int bj = 0; bj < 2; ++bj) { f32x4 v0 = acc[ai][bj][m][0] * sc, v1 = acc[ai][bj][m][1] * sc;
                        u32x4 w; w.x = cvt_pk_bf16(v0[0], v0[1]); w.y = cvt_pk_bf16(v0[2], v0[3]); w.z = cvt_pk_bf16(v1[0], v1[1]); w.w = cvt_pk_bf16(v1[2], v1[3]);
                        *(u32x4*)(rowp + bj * HALF) = w;
                        ss += (v0[0] * v0[0] + v0[1] * v0[1]) + (v0[2] * v0[2] + v0[3] * v0[3]) + (v1[0] * v1[0] + v1[1] * v1[1]) + (v1[2] * v1[2] + v1[3] * v1[3]); }
                    ss += __shfl_xor(ss, 16); ss += __shfl_xor(ss, 32); if (fq == 0) atomicAdd(so + row, ss); }
        } else if (wc < 2) {
#pragma unroll
            for (int ai = 0; ai < 2; ++ai)
#pragma unroll
                for (int m = 0; m < 4; ++m) { const int row = row0 + ai * HALF + m * 16; const float sc = rstd_of(ssq[row]); float* kp = KR + (size_t)row * 64 + wc * 32 + 8 * fq;
                    *(f32x4*)kp = acc[ai][0][m][0] * sc; *(f32x4*)(kp + 4) = acc[ai][0][m][1] * sc; }
        }
    }
};
struct EpiSwiGLU {
    static constexpr bool PERM = true;
    bf16_t* H; const float* ssq;
    __device__ __forceinline__ void operator()(const f32x4 (&acc)[2][2][4][2], const Unit& u, int wr, int wc, int fr, int fq) const {
        const int row0 = u.pm * BM + wr * 64 + fr; const int col0 = u.pn * HALF + wc * 32 + 8 * fq;
#pragma unroll
        for (int ai = 0; ai < 2; ++ai)
#pragma unroll
            for (int m = 0; m < 4; ++m) { const int row = row0 + ai * HALF + m * 16; const float rs = rstd_of(ssq[row]), rs2 = rs * rs, rsc = rs * -1.4426950408889634f; bf16_t* rowp = H + (size_t)row * FF + col0;
                float h[8];
#pragma unroll
                for (int n = 0; n < 2; ++n)
#pragma unroll
                    for (int j = 0; j < 4; ++j) { const float g = acc[ai][0][m][n][j], up = acc[ai][1][m][n][j]; h[n * 4 + j] = (g * up) * rs2 * __builtin_amdgcn_rcpf(1.0f + __builtin_amdgcn_exp2f(g * rsc)); }
                u32x4 w; w.x = cvt_pk_bf16(h[0], h[1]); w.y = cvt_pk_bf16(h[2], h[3]); w.z = cvt_pk_bf16(h[4], h[5]); w.w = cvt_pk_bf16(h[6], h[7]);
                *(u32x4*)rowp = w; }
    }
};
struct EpiRes {
    static constexpr bool PERM = true;
    const bf16_t* base; const float* basef; float* out; int ldc; float scale; bf16_t* xb; float* ssq_out;
    __device__ __forceinline__ void operator()(const f32x4 (&acc)[2][2][4][2], const Unit& u, int wr, int wc, int fr, int fq) const {
        const int col0 = u.pn * BM + wc * 32 + 8 * fq;
        float sc = scale; asm volatile("" : "+v"(sc));
#pragma unroll
        for (int ai = 0; ai < 2; ++ai)
#pragma unroll
            for (int m = 0; m < 4; ++m) { const int row = u.pm * BM + ai * HALF + wr * 64 + m * 16 + fr; const size_t off = (size_t)row * ldc + col0; float ss = 0.f;
#pragma unroll
                for (int bj = 0; bj < 2; ++bj) { f32x4 b0, b1;
                    if (basef) { b0 = *(const f32x4*)(basef + off + bj * HALF); b1 = *(const f32x4*)(basef + off + bj * HALF + 4); }
                    else { const u32x4 bw = *(const u32x4*)(base + off + bj * HALF); b0 = (f32x4){bflo(bw.x), bfhi(bw.x), bflo(bw.y), bfhi(bw.y)}; b1 = (f32x4){bflo(bw.z), bfhi(bw.z), bflo(bw.w), bfhi(bw.w)}; }
                    f32x4 o0 = acc[ai][bj][m][0] * sc + b0;
                    f32x4 o1 = acc[ai][bj][m][1] * sc + b1;
                    if (out) { *(f32x4*)(out + off + bj * HALF) = o0; *(f32x4*)(out + off + bj * HALF + 4) = o1; }
                    if (xb) { u32x4 w; w.x = cvt_pk_bf16(o0[0], o0[1]); w.y = cvt_pk_bf16(o0[2], o0[3]); w.z = cvt_pk_bf16(o1[0], o1[1]); w.w = cvt_pk_bf16(o1[2], o1[3]);
                        *(u32x4*)(xb + off + bj * HALF) = w;
                        ss += (o0[0] * o0[0] + o0[1] * o0[1]) + (o0[2] * o0[2] + o0[3] * o0[3]) + (o1[0] * o1[0] + o1[1] * o1[1]) + (o1[2] * o1[2] + o1[3] * o1[3]); } }
                if (xb) { ss += __shfl_xor(ss, 16); ss += __shfl_xor(ss, 32); if (fq == 0) atomicAdd(ssq_out + row, ss); }
                if (m & 1) asm volatile("" ::: "memory"); }
    }
};

template <class Epi>
__device__ __forceinline__ void gemm_phase(LAS unsigned char* lds, const Gemm g, const StaticOrder& S, const Epi& E) {
    int tid = threadIdx.x; asm volatile("" : "+v"(tid));
    const int wid = __builtin_amdgcn_readfirstlane(tid >> 6), lane = tid & 63, wr = wid >> 2, wc = wid & 3, fr = lane & 15, fq = lane >> 4;
    const int K = g.K, nt = K / BK;
    unsigned voffA[2], voffB[2];
#pragma unroll
    for (int i = 0; i < 2; ++i) { int R, C; stage_rc(tid * 16 + i * 8192, R, C); const int Rb = Epi::PERM ? ((R & ~31) + perm32(R & 31)) : R;
        voffA[i] = (unsigned)(R * K + C) * 2u; voffB[i] = (unsigned)(Rb * K + C) * 2u; }
    const size_t kstep = (size_t)(BK * 2);
    const size_t hstep = (size_t)HALF * K * 2;
    const size_t tstep = 2 * hstep;
    const unsigned ldsw = (unsigned)wid * 1024u;
    const int aoff = lds_byte(wr * 64 + fr, fq * 8), boff = lds_byte(wc * 32 + fr, fq * 8);
#define PG8_SA(b, h) (((b) * 2 + (h)) * HTB)
#define PG8_SB(b, h) ((4 + (b) * 2 + (h)) * HTB)
#define PG8_STAGE(bufoff, gbase, voff) do { _Pragma("unroll") for (int _i = 0; _i < 2; ++_i) \
        __builtin_amdgcn_global_load_lds((const unsigned*)((const char*)(gbase) + (voff)[_i]), (LAS unsigned*)(lds + (bufoff) + ldsw + _i * 8192), 16, 0, 0); } while (0)
#define PG8_LDA(dst, b, h) do { _Pragma("unroll") for (int m = 0; m < 4; ++m) _Pragma("unroll") for (int k = 0; k < 2; ++k) dst[m][k] = *(const LAS bf16x8*)(lds + PG8_SA(b, h) + aoff + m * 2048 + k * 1024); } while (0)
#define PG8_LDB(dst, b, h) do { _Pragma("unroll") for (int n = 0; n < 2; ++n) _Pragma("unroll") for (int k = 0; k < 2; ++k) dst[n][k] = *(const LAS bf16x8*)(lds + PG8_SB(b, h) + boff + n * 2048 + k * 1024); } while (0)
#define PG8_MMA(ai, bj, At, Bt) do { __builtin_amdgcn_s_setprio(1); _Pragma("unroll") for (int m = 0; m < 4; ++m) _Pragma("unroll") for (int n = 0; n < 2; ++n) _Pragma("unroll") for (int k = 0; k < 2; ++k) \
        acc[ai][bj][m][n] = __builtin_amdgcn_mfma_f32_16x16x32_bf16(Bt[n][k], At[m][k], acc[ai][bj][m][n], 0, 0, 0); __builtin_amdgcn_s_setprio(0); } while (0)
#define PG8_WAIT_V(n) asm volatile("s_waitcnt vmcnt(" #n ")" ::: "memory")
#define PG8_WAIT_L(n) asm volatile("s_waitcnt lgkmcnt(" #n ")" ::: "memory")
#define PG8_BAR __builtin_amdgcn_s_barrier()
#define PG8_SCHED __builtin_amdgcn_sched_barrier(0)
    Unit cur, nxt; int ui = 0;
    if (!S.next(0, cur)) return;
    f32x4 acc[2][2][4][2];
#pragma unroll
    for (int a = 0; a < 2; ++a)
#pragma unroll
        for (int b = 0; b < 2; ++b)
#pragma unroll
            for (int m = 0; m < 4; ++m)
#pragma unroll
                for (int n = 0; n < 2; ++n) acc[a][b][m][n] = (f32x4){0.f, 0.f, 0.f, 0.f};
    bf16x8 At[4][2], B0[2][2], B1[2][2];
    const char* cA = (const char*)g.A + (size_t)cur.pm * tstep; const char* cB = (const char*)g.Bt + (size_t)cur.pn * tstep;
    PG8_STAGE(PG8_SB(0, 0), cB, voffB); PG8_STAGE(PG8_SB(0, 1), cB + hstep, voffB); PG8_STAGE(PG8_SA(0, 0), cA, voffA); PG8_STAGE(PG8_SA(0, 1), cA + hstep, voffA);
    if (wr == 1) PG8_BAR;
    PG8_WAIT_V(2); PG8_BAR;
    PG8_STAGE(PG8_SB(1, 0), cB + kstep, voffB); PG8_STAGE(PG8_SA(1, 0), cA + kstep, voffA); PG8_STAGE(PG8_SB(1, 1), cB + hstep + kstep, voffB);
    PG8_WAIT_V(6); PG8_BAR;
    for (;;) {
        const bool has_next = S.next(ui + 1, nxt);
        const char* nA = has_next ? (const char*)g.A + (size_t)nxt.pm * tstep : cA; const char* nB = has_next ? (const char*)g.Bt + (size_t)nxt.pn * tstep : cB;
        for (int t = 0; t < nt; t += 2) {
            const bool last = (t == nt - 2);
            const char* a1 = cA + (size_t)(t + 1) * kstep;
            const char* a2 = last ? nA : cA + (size_t)(t + 2) * kstep; const char* b2 = last ? nB : cB + (size_t)(t + 2) * kstep;
            const char* a3 = a2 + kstep; const char* b3 = b2 + kstep;
            PG8_LDB(B0, 0, 0); PG8_LDB(B1, 0, 1); PG8_SCHED; PG8_LDA(At, 0, 0); PG8_STAGE(PG8_SA(1, 1), a1 + hstep, voffA);
            PG8_WAIT_V(8); PG8_WAIT_L(0); PG8_BAR; PG8_MMA(0, 0, At, B0); PG8_MMA(0, 1, At, B1); PG8_BAR; PG8_SCHED;
            PG8_LDA(At, 0, 1); PG8_STAGE(PG8_SB(0, 0), b2, voffB); PG8_STAGE(PG8_SB(0, 1), b2 + hstep, voffB); PG8_STAGE(PG8_SA(0, 0), a2, voffA);
            PG8_WAIT_V(8); PG8_WAIT_L(0); PG8_BAR; PG8_MMA(1, 0, At, B0); PG8_MMA(1, 1, At, B1); PG8_BAR; PG8_SCHED;
            PG8_LDB(B0, 1, 0); PG8_LDB(B1, 1, 1); PG8_SCHED; PG8_LDA(At, 1, 0); PG8_STAGE(PG8_SA(0, 1), a2 + hstep, voffA);
            PG8_WAIT_V(8); PG8_WAIT_L(0); PG8_BAR; PG8_MMA(0, 0, At, B0); PG8_MMA(0, 1, At, B1); PG8_BAR; PG8_SCHED;
            PG8_LDA(At, 1, 1); PG8_STAGE(PG8_SB(1, 0), b3, voffB); PG8_STAGE(PG8_SB(1, 1), b3 + hstep, voffB); PG8_STAGE(PG8_SA(1, 0), a3, voffA);
            PG8_WAIT_V(8); PG8_WAIT_L(0); PG8_BAR; PG8_MMA(1, 0, At, B0); PG8_MMA(1, 1, At, B1); PG8_BAR; PG8_SCHED;
        }
        if (wr == 0) PG8_BAR;
        { int fr_e = fr, fq_e = fq; asm volatile("" : "+v"(fr_e), "+v"(fq_e));
          E(acc, cur, wr, wc, fr_e, fq_e); }
        if (!has_next) break;
#pragma unroll
        for (int a = 0; a < 2; ++a)
#pragma unroll
            for (int b = 0; b < 2; ++b)
#pragma unroll
                for (int m = 0; m < 4; ++m)
#pragma unroll
                    for (int n = 0; n < 2; ++n) acc[a][b][m][n] = (f32x4){0.f, 0.f, 0.f, 0.f};
        cur = nxt; cA = nA; cB = nB; ++ui;
        if (wr == 1) PG8_BAR;
    }
    PG8_WAIT_V(0);
    PG8_BAR;
#undef PG8_SA
#undef PG8_SB
#undef PG8_STAGE
#undef PG8_LDA
#undef PG8_LDB
#undef PG8_MMA
#undef PG8_WAIT_V
#undef PG8_WAIT_L
#undef PG8_BAR
#undef PG8_SCHED
}
}

__device__ __forceinline__ void conv_matrix(const float* W, int K, int ldn, int c0, int ncols, bf16_t* WT, int drow0, int mode, const float* gain, LAS unsigned char* lds) {
    const int tid = opaque_tid(), lane = tid & 63, wave = __builtin_amdgcn_readfirstlane(tid >> 6), gw = blockIdx.x * NWAVES + wave, ngw = gridDim.x * NWAVES;
    LAS float* scr = (LAS float*)(lds + wave * 16384);
    const int nblk = ncols / 32, nitems = (K / 64) * nblk;
    for (int it = gw; it < nitems; it += ngw) {
        const int kb = it / nblk, nb = it - kb * nblk, k0 = 64 * kb, n0 = c0 + 32 * nb;
        int drow;
        if (mode == 1) { const int up = n0 >= FF ? 1 : 0, j = n0 - up * FF; drow = (j >> 7) * 256 + up * 128 + (j & 127); } else drow = drow0 + 32 * nb;
#pragma unroll 8
        for (int i = 0; i < 32; ++i) { const int kk = 2 * i + (lane >> 5); scr[kk * 33 + (lane & 31)] = W[(size_t)(k0 + kk) * ldn + n0 + (lane & 31)]; }
        asm volatile("s_waitcnt lgkmcnt(0)" ::: "memory");
        const int c = lane & 7;
        f32x4 g0 = {1.f, 1.f, 1.f, 1.f}, g1 = {1.f, 1.f, 1.f, 1.f};
        if (gain) { g0 = *(const f32x4*)(gain + k0 + 8 * c); g1 = *(const f32x4*)(gain + k0 + 8 * c + 4); }
#pragma unroll
        for (int j = 0; j < 4; ++j) { const int n = (lane >> 3) + 8 * j; const LAS float* s = scr + (8 * c) * 33 + n;
            u32x4 o; o.x = pk2(s[0 * 33] * g0.x, s[1 * 33] * g0.y); o.y = pk2(s[2 * 33] * g0.z, s[3 * 33] * g0.w); o.z = pk2(s[4 * 33] * g1.x, s[5 * 33] * g1.y); o.w = pk2(s[6 * 33] * g1.z, s[7 * 33] * g1.w);
            *(u32x4*)(WT + (size_t)(drow + n) * K + k0 + 8 * c) = o; }
        asm volatile("s_waitcnt lgkmcnt(0)" ::: "memory");
    }
}

__device__ __forceinline__ void cast_rows_ssq(const float* X, bf16_t* XB, float* ssq) {
    const int tid = opaque_tid(), lane = tid & 63, gw = blockIdx.x * NWAVES + __builtin_amdgcn_readfirstlane(tid >> 6), ngw = gridDim.x * NWAVES;
    for (int m = gw; m < M; m += ngw) {
        const float* xr = X + (size_t)m * D + 4 * lane; f32x4 v[8]; float s = 0.f;
#pragma unroll
        for (int j = 0; j < 8; ++j) { v[j] = *(const f32x4*)(xr + 256 * j); s += (v[j].x * v[j].x + v[j].y * v[j].y) + (v[j].z * v[j].z + v[j].w * v[j].w); }
        s = wave_sum(s);
        if (lane == 0) ssq[m] = s;
        bf16_t* orow = XB + (size_t)m * D + 4 * lane;
#pragma unroll
        for (int j = 0; j < 8; ++j) { u32x2 w; w.x = pk2(v[j].x, v[j].y); w.y = pk2(v[j].z, v[j].w); *(u32x2*)(orow + 256 * j) = w; }
    }
}

__device__ __forceinline__ float scan_add(float v, int lane) {
#pragma unroll
    for (int o = 1; o < 64; o <<= 1) { const float t = __shfl_up(v, o); if (lane >= o) v += t; }
    return v;
}
__device__ __forceinline__ float scan_max(float v, int lane) {
#pragma unroll
    for (int o = 1; o < 64; o <<= 1) { const float t = __shfl_up(v, o); if (lane >= o) v = fmaxf(v, t); }
    return v;
}
__device__ __forceinline__ float log_sigmoid(float x) { return fminf(x, 0.f) - log1pf(expf(-fabsf(x))); }

__device__ __forceinline__ void mlstm_stage_a(LAS unsigned char* lds, const bf16_t* QKO, const bf16_t* KVT, const float* G, const float* gbias, bf16_t* DC, float* DN, float* SC,
                                              int bid, int nblk, int tid) {
    asm volatile("" : "+v"(tid));
    const int lane = tid & 63, wave = __builtin_amdgcn_readfirstlane(tid >> 6), r32 = lane & 31, hi = lane >> 5;
    LAS float* sWk = (LAS float*)lds;
    LAS unsigned char* sKS = lds + 1024;
    for (int u = bid; u < 1024; u += nblk) {
        const int c = u >> 2, h = u & 3, t0 = c * 64;
        if (wave == 0) {
            const float ig = G[(size_t)(t0 + lane) * 8 + h] + gbias[h];
            const float lf = log_sigmoid(G[(size_t)(t0 + lane) * 8 + 4 + h] + gbias[4 + h]);
            const float b = scan_add(lf, lane);
            const float blast = __shfl(b, 63);
            const float gg = blast - b + ig;
            const float mloc = wave_max(gg);
            sWk[lane] = expf(gg - mloc);
            if (lane == 0) { SC[(c * 4 + h) * 2] = blast; SC[(c * 4 + h) * 2 + 1] = mloc; }
        }
        __syncthreads();
#pragma unroll
        for (int i = 0; i < 4; ++i) { const int q = tid + 512 * i, sidx = q & 63, d8 = q >> 6;
            const u32x4 kv = *(const u32x4*)(QKO + (size_t)(t0 + sidx) * 4096 + 1024 + h * 256 + d8 * 8);
            const float wk = sWk[sidx];
            LAS unsigned short* dst = (LAS unsigned short*)(sKS + (d8 * 8) * 144 + sidx * 2);
            dst[0 * 72] = (unsigned short)f2bf(bflo(kv.x) * wk); dst[1 * 72] = (unsigned short)f2bf(bfhi(kv.x) * wk);
            dst[2 * 72] = (unsigned short)f2bf(bflo(kv.y) * wk); dst[3 * 72] = (unsigned short)f2bf(bfhi(kv.y) * wk);
            dst[4 * 72] = (unsigned short)f2bf(bflo(kv.z) * wk); dst[5 * 72] = (unsigned short)f2bf(bfhi(kv.z) * wk);
            dst[6 * 72] = (unsigned short)f2bf(bflo(kv.w) * wk); dst[7 * 72] = (unsigned short)f2bf(bfhi(kv.w) * wk); }
        __syncthreads();
        if (tid < 256) { float s = 0.f;
#pragma unroll
            for (int j = 0; j < 8; ++j) { const u32x4 w = *(const LAS u32x4*)(sKS + tid * 144 + j * 16);
                s += (bflo(w.x) + bfhi(w.x)) + (bflo(w.y) + bfhi(w.y)) + (bflo(w.z) + bfhi(w.z)) + (bflo(w.w) + bfhi(w.w)); }
            DN[(size_t)(c * 4 + h) * 256 + tid] = s; }
        bf16x8 bfr[2][4];
#pragma unroll
        for (int vb = 0; vb < 2; ++vb)
#pragma unroll
            for (int ks = 0; ks < 4; ++ks) bfr[vb][ks] = *(const bf16x8*)(KVT + (size_t)(h * 512 + (wave * 2 + vb) * 32 + r32) * M + t0 + ks * 16 + hi * 8);
#pragma unroll
        for (int dh = 0; dh < 2; ++dh) {
            f32x16 acc[4][2];
#pragma unroll
            for (int a = 0; a < 4; ++a) { acc[a][0] = f32x16{}; acc[a][1] = f32x16{}; }
#pragma unroll
            for (int db4 = 0; db4 < 4; ++db4)
#pragma unroll
                for (int ks = 0; ks < 4; ++ks) { const bf16x8 a = *(const LAS bf16x8*)(sKS + ((dh * 4 + db4) * 32 + r32) * 144 + ks * 32 + hi * 16);
                    acc[db4][0] = __builtin_amdgcn_mfma_f32_32x32x16_bf16(a, bfr[0][ks], acc[db4][0], 0, 0, 0);
                    acc[db4][1] = __builtin_amdgcn_mfma_f32_32x32x16_bf16(a, bfr[1][ks], acc[db4][1], 0, 0, 0); }
#pragma unroll
            for (int db4 = 0; db4 < 4; ++db4)
#pragma unroll
                for (int vb = 0; vb < 2; ++vb) { const int v = (wave * 2 + vb) * 32 + r32;
                    bf16_t* dp = DC + ((size_t)((c * 4 + h) * 512 + v)) * 256 + (dh * 4 + db4) * 32 + 4 * hi;
#pragma unroll
                    for (int gq = 0; gq < 4; ++gq) { u32x2 w; w.x = pk2(acc[db4][vb][4 * gq], acc[db4][vb][4 * gq + 1]); w.y = pk2(acc[db4][vb][4 * gq + 2], acc[db4][vb][4 * gq + 3]);
                        *(u32x2*)(dp + 8 * gq) = w; } }
        }
        __syncthreads();
    }
}

__device__ __forceinline__ void mlstm_stage_b(bf16_t* DC, float* DN, const float* SC, float* MS, int bid, int nblk, int tid) {
    for (int e4 = bid * 512 + tid; e4 < 131072; e4 += nblk * 512) {
        const int h = __builtin_amdgcn_readfirstlane(e4 >> 15);
        const bool do_n = (e4 & 32767) < 256, do_m = (e4 & 32767) == 0;
        u32x2* p = (u32x2*)DC + e4;
        float* np = DN + (size_t)h * 256 + (e4 & 255);
        float s0 = 0.f, s1 = 0.f, s2 = 0.f, s3 = 0.f, sn = 0.f, m = 0.f;
        u32x2 xa[16]; float na[16];
#pragma unroll
        for (int i = 0; i < 16; ++i) { xa[i] = p[(size_t)i * 131072]; na[i] = do_n ? np[(size_t)i * 1024] : 0.f; }
        for (int c = 0; c < 256; c += 16) {
            u32x2 xb[16]; float nb[16];
            const int cn = (c + 16 < 256) ? c + 16 : c;
#pragma unroll
            for (int i = 0; i < 16; ++i) { xb[i] = p[(size_t)(cn + i) * 131072]; nb[i] = do_n ? np[(size_t)(cn + i) * 1024] : 0.f; }
#pragma unroll
            for (int i = 0; i < 16; ++i) {
                const float blast = SC[((c + i) * 4 + h) * 2], mloc = SC[((c + i) * 4 + h) * 2 + 1];
                const float mn = fmaxf(blast + m, mloc), al = __expf(blast + m - mn), be = __expf(mloc - mn);
                u32x2 w; w.x = pk2(s0, s1); w.y = pk2(s2, s3);
                p[(size_t)(c + i) * 131072] = w;
                if (do_n) np[(size_t)(c + i) * 1024] = sn;
                if (do_m) MS[(c + i) * 4 + h] = m;
                s0 = al * s0 + be * bflo(xa[i].x); s1 = al * s1 + be * bfhi(xa[i].x); s2 = al * s2 + be * bflo(xa[i].y); s3 = al * s3 + be * bfhi(xa[i].y);
                sn = al * sn + be * na[i]; m = mn;
            }
#pragma unroll
            for (int i = 0; i < 16; ++i) { xa[i] = xb[i]; na[i] = nb[i]; }
        }
    }
}

__device__ __forceinline__ void mlstm_stage_c(LAS unsigned char* lds, const bf16_t* QKO, const bf16_t* KVT, const float* G, const float* gbias, const bf16_t* DC, const float* DN,
                                              const float* MS, const float* hnorm, bf16_t* HG, int bid, int nblk, int tid) {
    asm volatile("" : "+v"(tid));
    const int lane = tid & 63, wave = __builtin_amdgcn_readfirstlane(tid >> 6), r32 = lane & 31, hi = lane >> 5;
    LAS float* sB = (LAS float*)lds; LAS float* sI = sB + 64; LAS float* sMt = sB + 128; LAS float* sA = sB + 192; LAS float* sDinv = sB + 256;
    LAS float* sQn = sB + 320;
    LAS float* sSsq = sB + 832;
    LAS unsigned char* sW = lds + 5376;
    for (int u = bid; u < 1024; u += nblk) {
        const int c = u >> 2, h = u & 3, t0 = c * 64;
        if (wave == 0) {
            const float ig = G[(size_t)(t0 + lane) * 8 + h] + gbias[h];
            const float lf = log_sigmoid(G[(size_t)(t0 + lane) * 8 + 4 + h] + gbias[4 + h]);
            const float b = scan_add(lf, lane);
            const float mc = MS[c * 4 + h];
            const float pm = scan_max(ig - b, lane);
            const float mt = b + fmaxf(mc, pm);
            sB[lane] = b; sI[lane] = ig; sMt[lane] = mt; sA[lane] = expf(b + mc - mt);
        }
        { const int t = tid & 63, part = tid >> 6;
          const bf16_t* qp = QKO + (size_t)(t0 + t) * 4096 + h * 256 + part * 32; const float* np = DN + (size_t)(c * 4 + h) * 256 + part * 32;
          float s = 0.f;
#pragma unroll
          for (int j = 0; j < 4; ++j) { const u32x4 qv = *(const u32x4*)(qp + j * 8); const f32x4 n0 = *(const f32x4*)(np + j * 8), n1 = *(const f32x4*)(np + j * 8 + 4);
              s += bflo(qv.x) * n0.x + bfhi(qv.x) * n0.y + bflo(qv.y) * n0.z + bfhi(qv.y) * n0.w + bflo(qv.z) * n1.x + bfhi(qv.z) * n1.y + bflo(qv.w) * n1.z + bfhi(qv.w) * n1.w; }
          sQn[part * 64 + t] = s; }
        __syncthreads();
        if (wave < 4) {
            const int sb = wave >> 1, tb = wave & 1;
            f32x16 acc = f32x16{};
            const bf16_t* kp = QKO + (size_t)(t0 + sb * 32 + r32) * 4096 + 1024 + h * 256 + hi * 8;
            const bf16_t* qp = QKO + (size_t)(t0 + tb * 32 + r32) * 4096 + h * 256 + hi * 8;
#pragma unroll
            for (int ks = 0; ks < 16; ++ks) acc = __builtin_amdgcn_mfma_f32_32x32x16_bf16(*(const bf16x8*)(kp + ks * 16), *(const bf16x8*)(qp + ks * 16), acc, 0, 0, 0);
            const int t = tb * 32 + r32; const float bt = sB[t], mt = sMt[t];
#pragma unroll
            for (int gq = 0; gq < 4; ++gq) { const int s0 = sb * 32 + 8 * gq + 4 * hi; float wv[4];
#pragma unroll
                for (int e = 0; e < 4; ++e) { const int s = s0 + e; wv[e] = (s <= t) ? acc[4 * gq + e] * expf(bt - sB[s] + sI[s] - mt) : 0.f; }
                u32x2 w; w.x = pk2(wv[0], wv[1]); w.y = pk2(wv[2], wv[3]);
                *(LAS u32x2*)(sW + t * 144 + s0 * 2) = w; }
        }
        __syncthreads();
        if (wave == 0) { const int t = lane; float rs = 0.f;
#pragma unroll
            for (int j = 0; j < 8; ++j) { const u32x4 w = *(const LAS u32x4*)(sW + t * 144 + j * 16);
                rs += (bflo(w.x) + bfhi(w.x)) + (bflo(w.y) + bfhi(w.y)) + (bflo(w.z) + bfhi(w.z)) + (bflo(w.w) + bfhi(w.w)); }
            float qn = 0.f;
#pragma unroll
            for (int p = 0; p < 8; ++p) qn += sQn[p * 64 + t];
            const float den = sA[t] * qn + rs;
            sDinv[t] = 1.0f / fmaxf(fabsf(den), expf(-sMt[t])); }
        f32x16 acc[2][2];
#pragma unroll
        for (int a = 0; a < 2; ++a) { acc[a][0] = f32x16{}; acc[a][1] = f32x16{}; }
        { const bf16_t* q0p = QKO + (size_t)(t0 + r32) * 4096 + h * 256 + hi * 8; const bf16_t* q1p = q0p + (size_t)32 * 4096;
          const bf16_t* s0p = DC + ((size_t)((c * 4 + h) * 512 + wave * 64 + r32)) * 256 + hi * 8; const bf16_t* s1p = s0p + 32 * 256;
#pragma unroll
          for (int ks = 0; ks < 16; ++ks) { const bf16x8 b0 = *(const bf16x8*)(q0p + ks * 16), b1 = *(const bf16x8*)(q1p + ks * 16);
              const bf16x8 a0 = *(const bf16x8*)(s0p + ks * 16), a1 = *(const bf16x8*)(s1p + ks * 16);
              acc[0][0] = __builtin_amdgcn_mfma_f32_32x32x16_bf16(a0, b0, acc[0][0], 0, 0, 0); acc[0][1] = __builtin_amdgcn_mfma_f32_32x32x16_bf16(a0, b1, acc[0][1], 0, 0, 0);
              acc[1][0] = __builtin_amdgcn_mfma_f32_32x32x16_bf16(a1, b0, acc[1][0], 0, 0, 0); acc[1][1] = __builtin_amdgcn_mfma_f32_32x32x16_bf16(a1, b1, acc[1][1], 0, 0, 0); } }
        { const float a0 = sA[r32], a1 = sA[32 + r32];
#pragma unroll
          for (int vb = 0; vb < 2; ++vb) { acc[vb][0] *= a0; acc[vb][1] *= a1; } }
        { const bf16_t* v0p = KVT + (size_t)(h * 512 + wave * 64 + r32) * M + t0 + hi * 8; const bf16_t* v1p = v0p + (size_t)32 * M;
#pragma unroll
          for (int ks = 0; ks < 4; ++ks) { const bf16x8 b0 = *(const LAS bf16x8*)(sW + r32 * 144 + ks * 32 + hi * 16), b1 = *(const LAS bf16x8*)(sW + (32 + r32) * 144 + ks * 32 + hi * 16);
              const bf16x8 a0 = *(const bf16x8*)(v0p + ks * 16), a1 = *(const bf16x8*)(v1p + ks * 16);
              acc[0][0] = __builtin_amdgcn_mfma_f32_32x32x16_bf16(a0, b0, acc[0][0], 0, 0, 0); acc[0][1] = __builtin_amdgcn_mfma_f32_32x32x16_bf16(a0, b1, acc[0][1], 0, 0, 0);
              acc[1][0] = __builtin_amdgcn_mfma_f32_32x32x16_bf16(a1, b0, acc[1][0], 0, 0, 0); acc[1][1] = __builtin_amdgcn_mfma_f32_32x32x16_bf16(a1, b1, acc[1][1], 0, 0, 0); } }
        __syncthreads();
#pragma unroll
        for (int tb = 0; tb < 2; ++tb) { const float dinv = sDinv[tb * 32 + r32]; float ss = 0.f;
#pragma unroll
            for (int vb = 0; vb < 2; ++vb) { acc[vb][tb] *= dinv;
#pragma unroll
                for (int r = 0; r < 16; ++r) ss += acc[vb][tb][r] * acc[vb][tb][r]; }
            ss += __shfl_xor(ss, 32);
            if (hi == 0) sSsq[wave * 64 + tb * 32 + r32] = ss; }
        __syncthreads();
#pragma unroll
        for (int tb = 0; tb < 2; ++tb) { const int t = tb * 32 + r32; float tot = 0.f;
#pragma unroll
            for (int w = 0; w < 8; ++w) tot += sSsq[w * 64 + t];
            const float rstd = 1.0f / sqrtf(tot * (1.0f / 512.0f) + EPS);
#pragma unroll
            for (int vb = 0; vb < 2; ++vb)
#pragma unroll
                for (int gq = 0; gq < 4; ++gq) { const int v0 = wave * 64 + vb * 32 + 8 * gq + 4 * hi;
                    const u32x2 ow = *(const u32x2*)(QKO + (size_t)(t0 + t) * 4096 + 2048 + h * 512 + v0);
                    const f32x4 gn = *(const f32x4*)(hnorm + h * 512 + v0);
                    const float o0 = acc[vb][tb][4 * gq] * rstd * gn.x * sigmoidf_(bflo(ow.x)), o1 = acc[vb][tb][4 * gq + 1] * rstd * gn.y * sigmoidf_(bfhi(ow.x));
                    const float o2 = acc[vb][tb][4 * gq + 2] * rstd * gn.z * sigmoidf_(bflo(ow.y)), o3 = acc[vb][tb][4 * gq + 3] * rstd * gn.w * sigmoidf_(bfhi(ow.y));
                    u32x2 w; w.x = pk2(o0, o1); w.y = pk2(o2, o3);
                    *(u32x2*)(HG + (size_t)(t0 + t) * 2048 + h * 512 + v0) = w; } }
        __syncthreads();
    }
}

__device__ __forceinline__ void mla_latent_norm(const float* C, const float* qn, const float* kvn, bf16_t* CQN, bf16_t* CKVN, float* KR) {
    const int tid = opaque_tid(), lane = tid & 63, gw = blockIdx.x * NWAVES + __builtin_amdgcn_readfirstlane(tid >> 6), ngw = gridDim.x * NWAVES;
    for (int m = gw; m < M; m += ngw) {
        KR[(size_t)m * 64 + lane] = C[(size_t)m * 1280 + 1024 + lane];
        const float* cr = C + (size_t)m * 1280 + 4 * lane;
        f32x4 a[2], b[2]; float sa = 0.f, sb = 0.f;
#pragma unroll
        for (int j = 0; j < 2; ++j) { a[j] = *(const f32x4*)(cr + 256 * j); b[j] = *(const f32x4*)(cr + 512 + 256 * j);
            sa += (a[j].x * a[j].x + a[j].y * a[j].y) + (a[j].z * a[j].z + a[j].w * a[j].w); sb += (b[j].x * b[j].x + b[j].y * b[j].y) + (b[j].z * b[j].z + b[j].w * b[j].w); }
        const float ra = 1.0f / sqrtf(wave_sum(sa) * (1.0f / 512.0f) + EPS), rb = 1.0f / sqrtf(wave_sum(sb) * (1.0f / 512.0f) + EPS);
#pragma unroll
        for (int j = 0; j < 2; ++j) { const f32x4 ga = *(const f32x4*)(qn + 4 * lane + 256 * j), gb = *(const f32x4*)(kvn + 4 * lane + 256 * j);
            u32x2 w; w.x = pk2(a[j].x * ra * ga.x, a[j].y * ra * ga.y); w.y = pk2(a[j].z * ra * ga.z, a[j].w * ra * ga.w);
            *(u32x2*)(CQN + (size_t)m * 512 + 4 * lane + 256 * j) = w;
            w.x = pk2(b[j].x * rb * gb.x, b[j].y * rb * gb.y); w.y = pk2(b[j].z * rb * gb.z, b[j].w * rb * gb.w);
            *(u32x2*)(CKVN + (size_t)m * 512 + 4 * lane + 256 * j) = w; }
    }
}
__device__ __forceinline__ void mla_qk_norm_rope(bf16_t* Q, const bf16_t* KVRAW, const float* KR, const int* pos, const float* qkn, bf16_t* KF, LAS unsigned char* lds) {
    const int tid = opaque_tid(), lane = tid & 63, wave = __builtin_amdgcn_readfirstlane(tid >> 6), gw = blockIdx.x * NWAVES + wave, ngw = gridDim.x * NWAVES;
    LAS unsigned short* skr = (LAS unsigned short*)(lds + wave * 256);
    const float QS = 0.07216878364870322f * 1.4426950408889634f;
    const int i32 = lane & 31;
    const double freq = exp2(-(double)i32 * (13.287712379549449 / 32.0));
    const float gqn0 = qkn[2 * lane], gqn1 = qkn[2 * lane + 1], gqr = qkn[128 + lane], gkr = qkn[192 + 128 + lane];
    const int kh = lane >> 2, kp = lane & 3;
    f32x4 gk[8];
#pragma unroll
    for (int e = 0; e < 8; ++e) gk[e] = *(const f32x4*)(qkn + 192 + kp * 32 + e * 4);
    for (int m = gw; m < M; m += ngw) {
        const double ang = (double)pos[m] * freq;
        const double red = ang - 6.283185307179586476925 * rint(ang * 0.15915494309189533577);
        const float sn = sinf((float)red), cs = cosf((float)red);
        { const float x = KR[(size_t)m * 64 + lane]; const float r = 1.0f / sqrtf(wave_sum(x * x) * (1.0f / 64.0f) + EPS);
          const float xn = x * r * gkr; const float pr = __shfl_xor(xn, 32);
          const float kr = (lane < 32) ? (xn * cs - pr * sn) : (xn * cs + pr * sn);
          skr[lane] = (unsigned short)f2bf(kr); }
        { const bf16_t* kp_ = KVRAW + (size_t)m * 4096 + kh * 256 + kp * 32; bf16_t* kf_ = KF + (size_t)m * 3072 + kh * 192;
          u32x4 w[4]; float ss = 0.f;
#pragma unroll
          for (int e = 0; e < 4; ++e) { w[e] = *(const u32x4*)(kp_ + e * 8);
              ss += (bflo(w[e].x) * bflo(w[e].x) + bfhi(w[e].x) * bfhi(w[e].x)) + (bflo(w[e].y) * bflo(w[e].y) + bfhi(w[e].y) * bfhi(w[e].y))
                  + (bflo(w[e].z) * bflo(w[e].z) + bfhi(w[e].z) * bfhi(w[e].z)) + (bflo(w[e].w) * bflo(w[e].w) + bfhi(w[e].w) * bfhi(w[e].w)); }
          ss += __shfl_xor(ss, 1); ss += __shfl_xor(ss, 2);
          const float r3 = 1.0f / sqrtf(ss * (1.0f / 128.0f) + EPS);
#pragma unroll
          for (int e = 0; e < 4; ++e) { const f32x4 g0 = gk[2 * e], g1 = gk[2 * e + 1]; u32x4 o;
              o.x = pk2(bflo(w[e].x) * r3 * g0.x, bfhi(w[e].x) * r3 * g0.y); o.y = pk2(bflo(w[e].y) * r3 * g0.z, bfhi(w[e].y) * r3 * g0.w);
              o.z = pk2(bflo(w[e].z) * r3 * g1.x, bfhi(w[e].z) * r3 * g1.y); o.w = pk2(bflo(w[e].w) * r3 * g1.z, bfhi(w[e].w) * r3 * g1.w);
              *(u32x4*)(kf_ + kp * 32 + e * 8) = o; }
          asm volatile("s_waitcnt lgkmcnt(0)" ::: "memory");
          const u32x4 k0 = *(const LAS u32x4*)(skr + kp * 16), k1 = *(const LAS u32x4*)(skr + kp * 16 + 8);
          *(u32x4*)(kf_ + 128 + kp * 16) = k0; *(u32x4*)(kf_ + 128 + kp * 16 + 8) = k1; }
        bf16_t* qrow = Q + (size_t)m * 3072;
#pragma unroll 4
        for (int hh = 0; hh < 16; ++hh) {
            const unsigned qw = *(const unsigned*)(qrow + hh * 192 + 2 * lane);
            const float qr_ = bf2f(qrow[hh * 192 + 128 + lane]);
            const float q0 = bflo(qw), q1 = bfhi(qw);
            float s1 = q0 * q0 + q1 * q1, s2 = qr_ * qr_;
#pragma unroll
            for (int o = 1; o < 64; o <<= 1) { s1 += __shfl_xor(s1, o); s2 += __shfl_xor(s2, o); }
            const float r1 = QS / sqrtf(s1 * (1.0f / 128.0f) + EPS), r2 = 1.0f / sqrtf(s2 * (1.0f / 64.0f) + EPS);
            *(unsigned*)(qrow + hh * 192 + 2 * lane) = pk2(q0 * r1 * gqn0, q1 * r1 * gqn1);
            const float xn = qr_ * r2 * gqr; const float pr = __shfl_xor(xn, 32);
            const float qo = ((lane < 32) ? (xn * cs - pr * sn) : (xn * cs + pr * sn)) * QS;
            qrow[hh * 192 + 128 + lane] = (unsigned short)f2bf(qo);
        }
    }
}

namespace att {
constexpr int SHM_V = 16384, SHM_K = 24576, OFF_V = 0, OFF_K = 3 * SHM_V, OFF_WS = OFF_K + 3 * SHM_K;
#define SBAR() __builtin_amdgcn_sched_barrier(0)
__device__ __forceinline__ int v_st(int k, int c) { const int kk = (k & ~0xC) | ((k & 4) << 1) | ((k & 8) >> 1); return ((kk >> 3) * 4 + (c >> 5)) * 512 + ((kk & 7) * 32 + (c & 31)) * 2; }
__device__ __forceinline__ int v_rd_base(int lane) { return ((lane & 3) << 3) | (((lane >> 2) & 3) << 6) | (((lane >> 4) & 1) << 5) | (((lane >> 5) & 1) << 8); }
constexpr int v_rd_off(int d0, int ks, int half) { return d0 * 512 + ks * 4096 + half * 2048; }
__device__ __forceinline__ int crow(int r, int hi) { return (r & 3) + 8 * (r >> 2) + 4 * hi; }
__device__ __forceinline__ unsigned cvtpk(float lo, float hi) { unsigned r; asm volatile("v_cvt_pk_bf16_f32 %0, %1, %2" : "=v"(r) : "v"(lo), "v"(hi)); return r; }
__device__ __forceinline__ void mask_tile(f32x16& p0, f32x16& p1, int dq) {
    const float NEG = -__builtin_inff();
#pragma unroll
    for (int r = 0; r < 16; ++r) { const int c = (r & 3) + 8 * (r >> 2);
        if (dq - c < 0) p0[r] = NEG;
        if (dq - c - 32 < 0) p1[r] = NEG; }
}
__device__ __forceinline__ void partialSM(f32x16& p0, f32x16& p1, float& m_reg, float& alpha, f32x16& negm) {
    float pmax = p0[0];
#pragma unroll
    for (int r = 1; r < 16; ++r) pmax = fmaxf(pmax, p0[r]);
#pragma unroll
    for (int r = 0; r < 16; ++r) pmax = fmaxf(pmax, p1[r]);
    { auto rr = __builtin_amdgcn_permlane32_swap(__float_as_uint(pmax), __float_as_uint(pmax), false, false);
      pmax = fmaxf(__uint_as_float(rr[0]), __uint_as_float(rr[1])); }
    if (__builtin_expect(__all(pmax <= 8.0f), 1)) { alpha = 1.f; }
    else { const float dl = fmaxf(pmax, 0.f); m_reg += dl; alpha = __builtin_amdgcn_exp2f(-dl);
#pragma unroll
        for (int r = 0; r < 16; ++r) { p0[r] -= dl; p1[r] -= dl; }
#pragma unroll
        for (int r = 0; r < 16; ++r) negm[r] = -m_reg; }
#pragma unroll
    for (int r = 0; r < 16; ++r) p0[r] = __builtin_amdgcn_exp2f(p0[r]);
#pragma unroll
    for (int r = 0; r < 16; ++r) p1[r] = __builtin_amdgcn_exp2f(p1[r]);
}
__device__ __forceinline__ void finishSM(f32x16& p0, f32x16& p1, bf16x8& pa0, bf16x8& pa1, bf16x8& pa2, bf16x8& pa3) {
#define PK4(P, B_, OUT) do { unsigned a0 = cvtpk(P[B_+0], P[B_+1]), a1 = cvtpk(P[B_+2], P[B_+3]);                          \
        unsigned b0 = cvtpk(P[B_+4], P[B_+5]), b1 = cvtpk(P[B_+6], P[B_+7]);                                             \
        auto r0 = __builtin_amdgcn_permlane32_swap(a0, b0, false, false); auto r1 = __builtin_amdgcn_permlane32_swap(a1, b1, false, false); \
        u32x4 w = {r0[0], r1[0], r0[1], r1[1]}; OUT = *reinterpret_cast<bf16x8*>(&w); } while (0)
    PK4(p0, 0, pa0); PK4(p0, 8, pa1); PK4(p1, 0, pa2); PK4(p1, 8, pa3);
#undef PK4
}
__device__ __forceinline__ int kswz(int row, int colB) { return row * 384 + (colB ^ (((row >> 1) & 7) << 4)); }
__device__ __forceinline__ void qkt(f32x16& p0, f32x16& p1, const LAS unsigned char* Kb, int r32, int hi, const bf16x8* qr, const f32x16& negm) {
    const LAS unsigned char* kb[4];
#pragma unroll
    for (int dd = 0; dd < 4; ++dd) kb[dd] = Kb + kswz(r32, dd * 32 + hi * 16);
#define LDK(d0_, w_) (*(const LAS bf16x8*)(kb[(d0_) & 3] + ((d0_) >> 2) * 128 + (w_) * 32 * 384))
    bf16x8 fa[12], fb[12];
    fa[0] = LDK(0, 0); fb[0] = LDK(0, 1); fa[1] = LDK(1, 0); fb[1] = LDK(1, 1);
#pragma unroll
    for (int d0 = 0; d0 < 12; ++d0) {
        if (d0 + 2 < 12) { fa[d0 + 2] = LDK(d0 + 2, 0); fb[d0 + 2] = LDK(d0 + 2, 1); }
        SBAR();
        p0 = __builtin_amdgcn_mfma_f32_32x32x16_bf16(fa[d0], qr[d0], d0 == 0 ? negm : p0, 0, 0, 0);
        p1 = __builtin_amdgcn_mfma_f32_32x32x16_bf16(fb[d0], qr[d0], d0 == 0 ? negm : p1, 0, 0, 0);
        SBAR();
    }
#undef LDK
}
__device__ __forceinline__ void pv_tile(f32x16* o, f32x16& lacc, int vb0, bf16x8 pa0, bf16x8 pa1, bf16x8 pa2, bf16x8 pa3) {
#define TRRD(dst, off) asm volatile("ds_read_b64_tr_b16 %0, %1 offset:%2" : "=&v"(dst) : "v"(vb0), "i"(off) : "memory")
#define RD8(S, d0) do { constexpr int b_ = v_rd_off(d0, 0, 0); TRRD(S##l0, b_); TRRD(S##h0, b_ + 2048); TRRD(S##l1, b_ + 4096); TRRD(S##h1, b_ + 6144); \
        TRRD(S##l2, b_ + 8192); TRRD(S##h2, b_ + 10240); TRRD(S##l3, b_ + 12288); TRRD(S##h3, b_ + 14336); } while (0)
#define MM4(S, d0) do { \
        o[d0] = __builtin_amdgcn_mfma_f32_32x32x16_bf16(pa0, (bf16x8){S##l0[0], S##l0[1], S##l0[2], S##l0[3], S##h0[0], S##h0[1], S##h0[2], S##h0[3]}, o[d0], 0, 0, 0); \
        o[d0] = __builtin_amdgcn_mfma_f32_32x32x16_bf16(pa1, (bf16x8){S##l1[0], S##l1[1], S##l1[2], S##l1[3], S##h1[0], S##h1[1], S##h1[2], S##h1[3]}, o[d0], 0, 0, 0); \
        o[d0] = __builtin_amdgcn_mfma_f32_32x32x16_bf16(pa2, (bf16x8){S##l2[0], S##l2[1], S##l2[2], S##l2[3], S##h2[0], S##h2[1], S##h2[2], S##h2[3]}, o[d0], 0, 0, 0); \
        o[d0] = __builtin_amdgcn_mfma_f32_32x32x16_bf16(pa3, (bf16x8){S##l3[0], S##l3[1], S##l3[2], S##l3[3], S##h3[0], S##h3[1], S##h3[2], S##h3[3]}, o[d0], 0, 0, 0); } while (0)
#define WAITL(n) do { asm volatile("s_waitcnt lgkmcnt(" #n ")" ::: "memory"); SBAR(); } while (0)
    s16x4 Al0, Al1, Al2, Al3, Ah0, Ah1, Ah2, Ah3, Bl0, Bl1, Bl2, Bl3, Bh0, Bh1, Bh2, Bh3;
    RD8(A, 0); RD8(B, 1); SBAR();
    { const bf16x8 ones = {16256, 16256, 16256, 16256, 16256, 16256, 16256, 16256};
      lacc = __builtin_amdgcn_mfma_f32_32x32x16_bf16(pa0, ones, lacc, 0, 0, 0); lacc = __builtin_amdgcn_mfma_f32_32x32x16_bf16(pa1, ones, lacc, 0, 0, 0);
      lacc = __builtin_amdgcn_mfma_f32_32x32x16_bf16(pa2, ones, lacc, 0, 0, 0); lacc = __builtin_amdgcn_mfma_f32_32x32x16_bf16(pa3, ones, lacc, 0, 0, 0); } SBAR();
    WAITL(8); MM4(A, 0); SBAR();
    RD8(A, 2); SBAR();
    WAITL(8); MM4(B, 1); SBAR();
    RD8(B, 3); SBAR();
    WAITL(8); MM4(A, 2); SBAR();
    WAITL(0); MM4(B, 3);
#undef WAITL
#undef MM4
#undef RD8
#undef TRRD
}
__device__ __forceinline__ void attn_unit(unsigned char* ldsg, const bf16_t* QF, const bf16_t* KF, const bf16_t* KVRAW, bf16_t* O, int h, int qb, int tid) {
    asm volatile("" : "+v"(tid));
    LAS unsigned char* lds = (LAS unsigned char*)ldsg;
    const int wid = __builtin_amdgcn_readfirstlane(tid >> 6), lane = tid & 63, r32 = lane & 31, hi = lane >> 5;
    const int q0 = qb * 256, NT = 4 * (qb + 1);
    const int qlo = q0 + wid * 32, qm = qlo + r32 - 4 * hi;
    LAS float* ws = (LAS float*)(lds + OFF_WS) + wid * 64; LAS float* li_l = ws; LAS float* al_l = ws + 32;
    int kgo[3], vgo[2];
#pragma unroll
    for (int i = 0; i < 3; ++i) { const int off = ((wid * 3 + i) * 64 + lane) * 16, row = off / 384, c1 = (off - row * 384) >> 4, ch = (c1 & ~7) | ((c1 & 7) ^ ((row >> 1) & 7)); kgo[i] = row * 3072 + ch * 8; }
#pragma unroll
    for (int i = 0; i < 2; ++i) { const int off = ((wid * 2 + i) * 64 + lane) * 16, sub = off >> 9, kkh = sub >> 2, cb = sub & 3, w = (off & 511) >> 1, kk = kkh * 8 + (w >> 5), cc = w & 31;
        const int k = (kk & ~0xC) | ((kk & 4) << 1) | ((kk & 8) >> 1); vgo[i] = k * 4096 + cb * 32 + cc; }
    const bf16_t* Kh = KF + h * 192; const bf16_t* Vh = KVRAW + h * 256 + 128;
    const int vb_base = (int)(unsigned)(uintptr_t)(ldsg + OFF_V) + v_rd_base(lane);
    bf16x8 qr[12];
#pragma unroll
    for (int d0 = 0; d0 < 12; ++d0) qr[d0] = *(const bf16x8*)(QF + (size_t)(qlo + r32) * 3072 + h * 192 + d0 * 16 + hi * 8);
#define ADMA(kb_, slot_) do { \
        _Pragma("unroll") for (int i = 0; i < 3; ++i) __builtin_amdgcn_global_load_lds((const unsigned*)(Kh + (size_t)(kb_) * 3072 + kgo[i]), (LAS unsigned*)(lds + OFF_K + (slot_) * SHM_K + (wid * 3 + i) * 1024), 16, 0, 0); \
        _Pragma("unroll") for (int i = 0; i < 2; ++i) __builtin_amdgcn_global_load_lds((const unsigned*)(Vh + (size_t)(kb_) * 4096 + vgo[i]), (LAS unsigned*)(lds + OFF_V + (slot_) * SHM_V + (wid * 2 + i) * 1024), 16, 0, 0); } while (0)
    ADMA(0, 0); ADMA(64, 1);
    __syncthreads();
    float m_reg = 0.f; f32x16 o[4]; f32x16 lacc = f32x16{};
    f32x16 negm = f32x16{}; asm volatile("" : "+v"(negm));
#pragma unroll
    for (int d = 0; d < 4; ++d) o[d] = f32x16{};
    int sj = 0, sn = 1, s2 = 2;
    for (int j = 0; j < NT; ++j) {
        const int kb = j * 64;
        if (j + 2 < NT) ADMA(kb + 128, s2);
        if (kb <= qlo + 31) {
            f32x16 p0, p1; float alpha; bf16x8 pa0, pa1, pa2, pa3;
            qkt(p0, p1, lds + OFF_K + sj * SHM_K, r32, hi, qr, negm);
            if (kb + 63 > qlo) mask_tile(p0, p1, qm - kb);
            partialSM(p0, p1, m_reg, alpha, negm);
            finishSM(p0, p1, pa0, pa1, pa2, pa3);
            if (__any(alpha < 1.f)) { if (hi == 0) al_l[r32] = alpha; asm volatile("s_waitcnt lgkmcnt(0)" ::: "memory");
#pragma unroll
                for (int d_ = 0; d_ < 4; ++d_)
#pragma unroll
                    for (int r = 0; r < 16; ++r) o[d_][r] *= al_l[crow(r, hi)];
#pragma unroll
                for (int r = 0; r < 16; ++r) lacc[r] *= al_l[crow(r, hi)]; }
            SBAR();
            pv_tile(o, lacc, vb_base + sj * SHM_V, pa0, pa1, pa2, pa3);
        }
        { const int t_ = sj; sj = sn; sn = s2; s2 = t_; }
        __syncthreads();
    }
#undef ADMA
    float rli[16];
#pragma unroll
    for (int r = 0; r < 16; ++r) rli[r] = 1.0f / lacc[r];
    bf16_t* Ow = O + (size_t)qlo * 2048 + h * 128;
#pragma unroll
    for (int r = 0; r < 16; ++r) { const int orow = crow(r, hi);
#pragma unroll
        for (int d0 = 0; d0 < 4; ++d0) { const float v = o[d0][r] * rli[r]; const float vn = __shfl_xor(v, 1);
            if ((r32 & 1) == 0) *(unsigned*)(Ow + (size_t)orow * 2048 + d0 * 32 + r32) = cvtpk(v, vn); } }
    __syncthreads();
}
#undef SBAR
}


#define XB_TMO      128
#define XB_XCNT(j)  (256  + 64 * (j))
#define XB_XSUB(j)  (1280 + 64 * (j))
#define XB_XGEN(j)  (2304 + 64 * (j))
#define XB_TOP      3328
#define XB_TOPGEN   3392
#define XCD_BAR_WORDS 3456
#define XB_SPIN_CAP (1u << 22)
__device__ __forceinline__ unsigned xb_ld(unsigned* p)              { return __hip_atomic_load(p, __ATOMIC_RELAXED, __HIP_MEMORY_SCOPE_AGENT); }
__device__ __forceinline__ unsigned xb_add(unsigned* p, unsigned v) { return __hip_atomic_fetch_add(p, v, __ATOMIC_RELAXED, __HIP_MEMORY_SCOPE_AGENT); }
__device__ __forceinline__ unsigned xb_xcc_id() { return (unsigned)__builtin_amdgcn_s_getreg((3 << 11) | 20) & 0xFu; }
#define XB_SPIN(cond, bar) do { unsigned _sp = 0; while (cond) { __builtin_amdgcn_s_sleep(1); \
    if ((++_sp & 255u) == 0u) { if (xb_ld(&(bar)[XB_TMO])) break; if (_sp > XB_SPIN_CAP) { atomicAdd(&(bar)[XB_TMO], 1u); break; } } } } while (0)
struct XcdBarrier { unsigned* bar; unsigned x; volatile LAS unsigned* st; };
__device__ __forceinline__ XcdBarrier xcd_barrier_post(unsigned* bar, volatile LAS unsigned* st) {
    XcdBarrier b; b.bar = bar; b.x = xb_xcc_id(); b.st = st;
    if (threadIdx.x == 0) (void)xb_add(&bar[XB_XCNT(b.x)], 1u);
    return b;
}
__device__ __forceinline__ void xcd_barrier_complete(unsigned* bar, unsigned x, unsigned& nloc, unsigned& nx) {
    const unsigned G = gridDim.x * gridDim.y * gridDim.z;
    unsigned sum, cnt, mine, sp = 0u;
    for (;;) {
        sum = 0u; cnt = 0u; mine = 0u;
#pragma unroll
        for (unsigned j = 0; j < 16; ++j) { const unsigned c = xb_ld(&bar[XB_XCNT(j)]); sum += c; cnt += (c > 0u) ? 1u : 0u; mine = (j == x) ? c : mine; }
        if (sum == G) break;
        __builtin_amdgcn_s_sleep(1);
        if ((++sp & 255u) == 0u) { if (xb_ld(&bar[XB_TMO])) break; if (sp > XB_SPIN_CAP) { atomicAdd(&bar[XB_TMO], 1u); break; } }
    }
    nloc = mine > 0u ? mine : 1u; nx = cnt > 0u ? cnt : 1u;
}
__device__ __forceinline__ void xcd_barrier(const XcdBarrier& b) {
    asm volatile("s_waitcnt vmcnt(0)" ::: "memory");
    __syncthreads();
    if (threadIdx.x == 0) {
        unsigned* bar = b.bar;
        __builtin_amdgcn_s_waitcnt(0);
        unsigned nloc = b.st[0], nx = b.st[1];
        if (nloc == 0u) { xcd_barrier_complete(bar, b.x, nloc, nx); b.st[0] = nloc; b.st[1] = nx; }
        const unsigned old = xb_add(&bar[XB_XSUB(b.x)], 1u);
        const unsigned gen = old / nloc;
        if (old + 1u == (gen + 1u) * nloc) {
            __builtin_amdgcn_fence(__ATOMIC_RELEASE, "agent");
            asm volatile("s_waitcnt vmcnt(0)" ::: "memory");
            const unsigned og = xb_add(&bar[XB_TOP], 1u);
            const unsigned tg = og / nx;
            if (og + 1u == (tg + 1u) * nx) xb_add(&bar[XB_TOPGEN], 1u);
            else XB_SPIN(xb_ld(&bar[XB_TOPGEN]) == tg, bar);
            __builtin_amdgcn_fence(__ATOMIC_ACQUIRE, "agent");
            xb_add(&bar[XB_XGEN(b.x)], 1u);
            asm volatile("s_waitcnt vmcnt(0)" ::: "memory");
        } else {
            XB_SPIN(xb_ld(&bar[XB_XGEN(b.x)]) == gen, bar);
            __builtin_amdgcn_fence(__ATOMIC_ACQUIRE, "agent");
            asm volatile("s_waitcnt vmcnt(0)" ::: "memory");
        }
    }
    __syncthreads();
}

constexpr size_t MiB = (size_t)1 << 20;
constexpr size_t OFF_XN = 1 * MiB;
constexpr size_t OFF_XB = OFF_XN + 64 * MiB;
constexpr size_t OFF_WGU = OFF_XB + 64 * MiB;
constexpr size_t OFF_WD = OFF_WGU + 44 * MiB;
constexpr size_t OFF_WMIA = OFF_WD + 22 * MiB;
constexpr size_t OFF_WMIB = OFF_WMIA + 17 * MiB;
constexpr size_t OFF_WMO = OFF_WMIB + 12 * MiB;
constexpr size_t OFF_WAI = OFF_WMO + 8 * MiB;
constexpr size_t OFF_WUQ = OFF_WAI + 5 * MiB;
constexpr size_t OFF_WUKV = OFF_WUQ + 3 * MiB;
constexpr size_t OFF_WAO = OFF_WUKV + 4 * MiB;
constexpr size_t OFF_BIG = OFF_WAO + 8 * MiB;
constexpr size_t OFF_H = OFF_BIG;
constexpr size_t OFF_WGU2 = OFF_BIG + 180 * MiB;
constexpr size_t OFF_WD2 = OFF_WGU2 + 44 * MiB;
constexpr size_t OFF_SSQ = 131072;
constexpr size_t OFF_QKO = OFF_BIG;
constexpr size_t OFF_KVT = OFF_QKO + 128 * MiB;
constexpr size_t OFF_DC = OFF_KVT + 96 * MiB;
constexpr size_t OFF_DN = OFF_DC + 256 * MiB;
constexpr size_t OFF_G = OFF_DN + 1 * MiB;
constexpr size_t OFF_SC = OFF_G + 1 * MiB;
constexpr size_t OFF_MS = OFF_SC + 65536;
constexpr size_t END_MLSTM = OFF_MS + 65536;
constexpr size_t OFF_C = OFF_BIG;
constexpr size_t OFF_KF = OFF_C;
constexpr size_t OFF_CQN = OFF_KF + 96 * MiB;
constexpr size_t OFF_CKVN = OFF_CQN + 16 * MiB;
constexpr size_t OFF_Q = OFF_CKVN + 16 * MiB;
constexpr size_t OFF_KVRAW = OFF_Q + 96 * MiB;
constexpr size_t OFF_KR = OFF_KVRAW + 128 * MiB;
constexpr size_t END_MLA = OFF_KR + 4 * MiB;
constexpr size_t WS_NEED = END_MLA > END_MLSTM ? END_MLA : END_MLSTM;

struct Args {
    const float* x; const int* pos;
    const float* ffn1_norm; const float* ffn1_wgu; const float* ffn1_wd; const float* mix_norm; const float* ffn2_norm; const float* ffn2_wgu; const float* ffn2_wd;
    const float* ml_win; const float* ml_gb; const float* ml_hn; const float* ml_wout;
    const float* mla_win; const float* mla_qn; const float* mla_kvn; const float* mla_wuq; const float* mla_wukv; const float* mla_qkn; const float* mla_wout;
    float* out; unsigned char* ws;
};

__global__ void __launch_bounds__(NWAVES * 64, 2) mega_fwd(Args a) {
    extern __shared__ __attribute__((aligned(16))) unsigned char lds_g[];
    cg::grid_group grid = cg::this_grid();
    LAS unsigned char* lds = (LAS unsigned char*)lds_g;
    const int tid = threadIdx.x;
    const int G = gridDim.x, bid = blockIdx.x;
    const int vcu = (G % 8 == 0) ? (bid % 8) * (G / 8) + bid / 8 : bid;
    volatile LAS unsigned* bst = (volatile LAS unsigned*)(lds + LDS_BYTES - 64);
    if (tid < 16) bst[tid] = 0u;
    __syncthreads();
    XcdBarrier xbar = xcd_barrier_post((unsigned*)a.ws + 4096, bst);
#define GSYNC() xcd_barrier(xbar)
    unsigned char* ws = a.ws;
    bf16_t* XN = (bf16_t*)(ws + OFF_XN);
    bf16_t* WGU = (bf16_t*)(ws + OFF_WGU); bf16_t* WD = (bf16_t*)(ws + OFF_WD);
    bf16_t* WMIA = (bf16_t*)(ws + OFF_WMIA); bf16_t* WMIB = (bf16_t*)(ws + OFF_WMIB); bf16_t* WMO = (bf16_t*)(ws + OFF_WMO);
    bf16_t* WAI = (bf16_t*)(ws + OFF_WAI); bf16_t* WUQ = (bf16_t*)(ws + OFF_WUQ); bf16_t* WUKV = (bf16_t*)(ws + OFF_WUKV); bf16_t* WAO = (bf16_t*)(ws + OFF_WAO);
    bf16_t* Hb = (bf16_t*)(ws + OFF_H);
    bf16_t* QKO = (bf16_t*)(ws + OFF_QKO); bf16_t* KVT = (bf16_t*)(ws + OFF_KVT); bf16_t* DC = (bf16_t*)(ws + OFF_DC);
    float* DN = (float*)(ws + OFF_DN); float* Gt = (float*)(ws + OFF_G); float* SC = (float*)(ws + OFF_SC); float* MS = (float*)(ws + OFF_MS);
    float* Cb = (float*)(ws + OFF_C); bf16_t* KF = (bf16_t*)(ws + OFF_KF); bf16_t* CQN = (bf16_t*)(ws + OFF_CQN); bf16_t* CKVN = (bf16_t*)(ws + OFF_CKVN);
    bf16_t* Qb = (bf16_t*)(ws + OFF_Q); bf16_t* KVRAW = (bf16_t*)(ws + OFF_KVRAW); float* KR = (float*)(ws + OFF_KR);

    bf16_t* XB = (bf16_t*)(ws + OFF_XB); bf16_t* WGU2 = (bf16_t*)(ws + OFF_WGU2); bf16_t* WD2 = (bf16_t*)(ws + OFF_WD2);
    float* SSQ = (float*)(ws + OFF_SSQ);
#define SSQ_(i) (SSQ + (size_t)(i) * M)
#define CONV_FFN(wgu_, wd_, norm_, layer, WGU_, WD_) do { for (int rep_ = 0; rep_ < REP_CONV; ++rep_) { \
        conv_matrix((wgu_) + (size_t)(layer) * D * 2 * FF, D, 2 * FF, 0, 2 * FF, (WGU_), 0, 1, (norm_) + (layer) * D, lds); \
        conv_matrix((wd_) + (size_t)(layer) * FF * D, FF, D, 0, D, (WD_), 0, 0, nullptr, lds); } \
        __syncthreads();   } while (0)
#define GEMM_GU(WGU_, ssq_) do { for (int rep_ = 0; rep_ < REP_GU; ++rep_) { pg8::Gemm g{XB, (WGU_), M, 2 * FF, D}; pg8::StaticOrder S; S.init(M, 2 * FF, G, bid); pg8::EpiSwiGLU E{Hb, (ssq_)}; pg8::gemm_phase<pg8::EpiSwiGLU>(lds, g, S, E); } } while (0)
#define GEMM_DOWN(WD_, basef_, out_, xb_, ssqo_) do { pg8::Gemm g{Hb, (WD_), M, D, FF}; pg8::StaticOrder S; S.init(M, D, G, bid, 0, 4); pg8::EpiRes E{XB, (basef_), (out_), D, 0.5f, (xb_), (ssqo_)}; pg8::gemm_phase<pg8::EpiRes>(lds, g, S, E); } while (0)

    CONV_FFN(a.ffn1_wgu, a.ffn1_wd, a.ffn1_norm, 0, WGU, WD);
    conv_matrix(a.ml_win, D, 6152, 0, 2048, WMIA, 0, 0, a.mix_norm, lds);
    conv_matrix(a.ml_win, D, 6152, 4096, 2048, WMIA, 2048, 0, a.mix_norm, lds);
    conv_matrix(a.ml_win, D, 6152, 2048, 2048, WMIB, 0, 0, a.mix_norm, lds);
    { const int gt = bid * 512 + opaque_tid(), ngt = G * 512;
      for (int i = gt; i < 8 * D; i += ngt) { const int k = i >> 3, j = i & 7; WMIA[(size_t)(4096 + j) * D + k] = (bf16_t)f2bf(a.ml_win[(size_t)k * 6152 + 6144 + j] * a.mix_norm[k]); }
      u32x4 z = {0u, 0u, 0u, 0u};
      for (int i = gt; i < 248 * D / 8; i += ngt) *(u32x4*)(WMIA + (size_t)4104 * D + (size_t)i * 8) = z;
      for (int i = gt; i < 192 * D / 8; i += ngt) *(u32x4*)(WAI + (size_t)1088 * D + (size_t)i * 8) = z;
      for (int i = gt; i < 7 * M / 4; i += ngt) *(u32x4*)(SSQ_(1) + (size_t)i * 4) = z; }
    conv_matrix(a.ml_wout, D, D, 0, D, WMO, 0, 0, nullptr, lds);
    conv_matrix(a.mla_win, D, 1088, 0, 1088, WAI, 0, 0, a.mix_norm + D, lds);
    conv_matrix(a.mla_wuq, 512, 3072, 0, 3072, WUQ, 0, 0, a.mla_qn, lds);
    conv_matrix(a.mla_wukv, 512, 4096, 0, 4096, WUKV, 0, 0, a.mla_kvn, lds);
    conv_matrix(a.mla_wout, D, D, 0, D, WAO, 0, 0, nullptr, lds);
    cast_rows_ssq(a.x, XB, SSQ_(0));
    if (a.ws == nullptr) grid.sync();
    GSYNC();

    GEMM_GU(WGU, SSQ_(0)); GSYNC();
    GEMM_DOWN(WD, a.x, nullptr, XB, SSQ_(1)); GSYNC();
    CONV_FFN(a.ffn2_wgu, a.ffn2_wd, a.ffn2_norm, 0, WGU, WD);
    for (int rep_ = 0; rep_ < REP_OTHER; ++rep_) { pg8::Gemm g{XB, WMIA, M, 4352, D}; pg8::StaticOrder S; S.init(M, 4352, G, bid); pg8::EpiMlstmIn E{QKO, Gt, SSQ_(1)}; pg8::gemm_phase<pg8::EpiMlstmIn>(lds, g, S, E); }
    for (int rep_ = 0; rep_ < REP_OTHER; ++rep_) { pg8::Gemm g{WMIB, XB, 2048, M, D}; pg8::StaticOrder S; S.init(2048, M, G, bid); pg8::EpiBf16 E{KVT, M, SSQ_(1), nullptr}; pg8::gemm_phase<pg8::EpiBf16>(lds, g, S, E); }
    GSYNC();
    mlstm_stage_a(lds, QKO, KVT, Gt, a.ml_gb, DC, DN, SC, bid, G, tid);
    GSYNC();
    mlstm_stage_b(DC, DN, SC, MS, bid, G, tid);
    GSYNC();
    mlstm_stage_c(lds, QKO, KVT, Gt, a.ml_gb, DC, DN, MS, a.ml_hn, XN, bid, G, tid);
    GSYNC();
    { pg8::Gemm g{XN, WMO, M, D, D}; pg8::StaticOrder S; S.init(M, D, G, bid); pg8::EpiRes E{XB, nullptr, nullptr, D, 1.0f, XB, SSQ_(2)}; pg8::gemm_phase<pg8::EpiRes>(lds, g, S, E); }
    GSYNC();
    CONV_FFN(a.ffn1_wgu, a.ffn1_wd, a.ffn1_norm, 1, WGU2, WD2);
    GEMM_GU(WGU, SSQ_(2)); GSYNC();
    GEMM_DOWN(WD, nullptr, nullptr, XB, SSQ_(3)); GSYNC();

    GEMM_GU(WGU2, SSQ_(3)); GSYNC();
    GEMM_DOWN(WD2, nullptr, nullptr, XB, SSQ_(4)); GSYNC();
    CONV_FFN(a.ffn2_wgu, a.ffn2_wd, a.ffn2_norm, 1, WGU, WD);
    { pg8::Gemm g{XB, WAI, M, 1280, D}; pg8::StaticOrder S; S.init(M, 1280, G, bid); pg8::EpiMlaIn E{CQN, CKVN, KR, SSQ_(4), SSQ_(6), SSQ_(7)}; pg8::gemm_phase<pg8::EpiMlaIn>(lds, g, S, E); }
    GSYNC();
    for (int rep_ = 0; rep_ < REP_OTHER; ++rep_) { pg8::Gemm g{CQN, WUQ, M, 3072, 512}; pg8::StaticOrder S; S.init(M, 3072, G, bid); pg8::EpiBf16 E{Qb, 3072, nullptr, SSQ_(6)}; pg8::gemm_phase<pg8::EpiBf16>(lds, g, S, E); }
    for (int rep_ = 0; rep_ < REP_OTHER; ++rep_) { pg8::Gemm g{CKVN, WUKV, M, 4096, 512}; pg8::StaticOrder S; S.init(M, 4096, G, bid); pg8::EpiBf16 E{KVRAW, 4096, nullptr, SSQ_(7)}; pg8::gemm_phase<pg8::EpiBf16>(lds, g, S, E); }
    GSYNC();
    mla_qk_norm_rope(Qb, KVRAW, KR, a.pos, a.mla_qkn, KF, lds);
    GSYNC();
    for (int rep = 0; rep < REP_ATT; ++rep)
    for (int it = vcu; it < 256; it += G) {
        const int h = it >> 4, s = it & 15;
        for (int k = 0; k < 4; ++k) { const int qb = (k == 0) ? 63 - s : (k == 1) ? 32 + s : (k == 2) ? 31 - s : s; att::attn_unit(lds_g, Qb, KF, KVRAW, XN, h, qb, tid); }
    }
    GSYNC();
    { pg8::Gemm g{XN, WAO, M, D, D}; pg8::StaticOrder S; S.init(M, D, G, bid); pg8::EpiRes E{XB, nullptr, nullptr, D, 1.0f, XB, SSQ_(5)}; pg8::gemm_phase<pg8::EpiRes>(lds, g, S, E); }
    GSYNC();
    GEMM_GU(WGU, SSQ_(5)); GSYNC();
    GEMM_DOWN(WD, nullptr, a.out, nullptr, nullptr);
#undef CONV_FFN
#undef GEMM_GU
#undef GEMM_DOWN
#undef SSQ_
}

extern "C" void kernel_launch(void* const* d_in, const int* in_sizes, int n_in, void* d_out, int out_size, void* d_ws, size_t ws_size, hipStream_t stream) {
    static int grid_blocks = 0;
    if (grid_blocks == 0) {
        if (n_in != 20 || in_sizes[0] != M * D || out_size != M * D || ws_size < WS_NEED) {
            fprintf(stderr, "kernel_launch: unexpected shapes (n_in %d, in0 %d, out %d, ws %zu, need %zu)\n", n_in, n_in > 0 ? in_sizes[0] : -1, out_size, ws_size, (size_t)WS_NEED);
            grid_blocks = -1; return; }
        int dev = 0, cus = 0, per_cu = 0;
        hipGetDevice(&dev);
        hipDeviceGetAttribute(&cus, hipDeviceAttributeMultiprocessorCount, dev);
        hipFuncSetAttribute((const void*)mega_fwd, hipFuncAttributeMaxDynamicSharedMemorySize, LDS_BYTES);
        hipOccupancyMaxActiveBlocksPerMultiprocessor(&per_cu, (const void*)mega_fwd, NWAVES * 64, LDS_BYTES);
        if (per_cu < 1) per_cu = 1;
        grid_blocks = cus * per_cu;
        if (grid_blocks > 256) grid_blocks = 256;
    }
    if (grid_blocks < 0) return;
    Args a{};
    a.x = (const float*)d_in[0]; a.pos = (const int*)d_in[1];
    a.ffn1_norm = (const float*)d_in[2]; a.ffn1_wgu = (const float*)d_in[3]; a.ffn1_wd = (const float*)d_in[4]; a.mix_norm = (const float*)d_in[5];
    a.ffn2_norm = (const float*)d_in[6]; a.ffn2_wgu = (const float*)d_in[7]; a.ffn2_wd = (const float*)d_in[8];
    a.ml_win = (const float*)d_in[9]; a.ml_gb = (const float*)d_in[10]; a.ml_hn = (const float*)d_in[11]; a.ml_wout = (const float*)d_in[12];
    a.mla_win = (const float*)d_in[13]; a.mla_qn = (const float*)d_in[14]; a.mla_kvn = (const float*)d_in[15]; a.mla_wuq = (const float*)d_in[16];
    a.mla_wukv = (const float*)d_in[17]; a.mla_qkn = (const float*)d_in[18]; a.mla_wout = (const float*)d_in[19];
    a.out = (float*)d_out; a.ws = (unsigned char*)d_ws;
    (void)hipMemsetAsync(d_ws, 0, 65536, stream);
    void* args[] = {&a};
    hipError_t e = hipLaunchCooperativeKernel((const void*)mega_fwd, dim3(grid_blocks), dim3(NWAVES * 64), args, LDS_BYTES, stream);
    if (e != hipSuccess) fprintf(stderr, "cooperative launch failed: %s (grid %d)\n", hipGetErrorString(e), grid_blocks);
}
```
